# Optimizing an MI355X kernel written in HIP

```python
import jax
import jax.numpy as jnp
from jax import lax
import numpy as np

D_MODEL = 2048
BATCH = 4
SEQ = 4096
DEPTH = 2

D_FF = ((8 * D_MODEL // 3 + 255) // 256) * 256
EPS = 1e-6
POOL_WIDTH = D_MODEL // 4
POOL_WINDOWS = (2, 4, 8, 16)
POOL_GROUP = POOL_WIDTH // len(POOL_WINDOWS)
GLA_HEADS = 4
GLA_WIDTH = D_MODEL // 2
GLA_DK = GLA_WIDTH // 2 // GLA_HEADS
GLA_DV = GLA_WIDTH // GLA_HEADS
GLA_GATE_RANK = 16
GLA_TAU = 16.0
GLA_CHUNK = 64
SSM_WIDTH = D_MODEL // 4
SSM_GROUP = 16
SSM_GROUPS = SSM_WIDTH // SSM_GROUP
SSM_STATE = 64
DT_MIN = 1e-3
DT_MAX = 1e-1
N_BRANCH = 3
MIX_WIDTH = POOL_WIDTH + GLA_WIDTH + SSM_WIDTH
IN_SIZES = (POOL_WIDTH, GLA_HEADS * GLA_DK, GLA_HEADS * GLA_DK, GLA_WIDTH, GLA_WIDTH,
            GLA_GATE_RANK, SSM_WIDTH, N_BRANCH * D_MODEL)
IN_WIDTH = sum(IN_SIZES)

kernel_name = "hybrid_pool_gla_s5_macaron"


def rms_norm(x, g):
    xf = x.astype(jnp.float32)
    y = xf * lax.rsqrt(jnp.mean(xf * xf, axis=-1, keepdims=True) + EPS)
    return (y * g.astype(jnp.float32)).astype(x.dtype)


def swiglu(x, w_gate, w_up, w_down):
    return (jax.nn.silu(x @ w_gate) * (x @ w_up)) @ w_down


def split_columns(z):
    idx = np.cumsum(IN_SIZES)[:-1].tolist()
    return jnp.split(z, idx, axis=-1)


def pool_mixer(x, w_group, scale):
    B, S, _ = x.shape
    xf = x.astype(jnp.float32).reshape(B, S, len(POOL_WINDOWS), POOL_GROUP)
    csum = jnp.cumsum(xf, axis=1)
    pos = jnp.arange(1, S + 1, dtype=jnp.float32)
    means = []
    for i, w in enumerate(POOL_WINDOWS):
        c = csum[:, :, i]
        lagged = jnp.pad(c, ((0, 0), (w, 0), (0, 0)))[:, :S]
        means.append((c - lagged) / jnp.minimum(pos, float(w))[:, None])
    mean = jnp.stack(means, axis=2)
    mixed = jnp.einsum('bsgc,gcd->bsgd', mean - xf, w_group.astype(jnp.float32))
    return (mixed.reshape(B, S, POOL_WIDTH) * scale.astype(jnp.float32)).astype(x.dtype)


def gla_mixer(q, k, v, r, gate_lr, w_gate2, gate_bias, norm_gain):
    B, S, _ = q.shape
    H, C = GLA_HEADS, GLA_CHUNK
    N = S // C
    f32 = jnp.float32
    log_a = jax.nn.log_sigmoid((gate_lr @ w_gate2 + gate_bias).astype(f32)) / GLA_TAU

    def chunks(t, d):
        return t.reshape(B, N, C, H, d).transpose(0, 3, 1, 2, 4)

    qc = chunks(q.astype(f32), GLA_DK) * (GLA_DK ** -0.5)
    kc = chunks(k.astype(f32), GLA_DK)
    vc = chunks(v.astype(f32), GLA_DV)
    bc = jnp.cumsum(chunks(log_a, GLA_DK), axis=3)
    b_last = bc[:, :, :, C - 1:C, :]
    b_mid = bc[:, :, :, C // 2 - 1:C // 2, :]
    causal = jnp.tril(jnp.ones((C, C), dtype=bool))
    scores = jnp.einsum('bhnid,bhnjd->bhnij', qc * jnp.exp(bc - b_mid), kc * jnp.exp(b_mid - bc))
    scores = jnp.where(causal, scores, 0.0)
    o_intra = jnp.einsum('bhnij,bhnjv->bhniv', scores, vc)
    q_dec = qc * jnp.exp(bc)
    kv = jnp.einsum('bhncd,bhncv->nbhdv', kc * jnp.exp(b_last - bc), vc)
    chunk_decay = jnp.exp(b_last[:, :, :, 0, :]).transpose(2, 0, 1, 3)

    def step(state, inp):
        dec, kv_n = inp
        return dec[..., None] * state + kv_n, state

    _, states = lax.scan(step, jnp.zeros((B, H, GLA_DK, GLA_DV), f32), (chunk_decay, kv))
    o_inter = jnp.einsum('bhncd,nbhdv->bhncv', q_dec, states)
    o = (o_intra + o_inter).transpose(0, 2, 3, 1, 4).reshape(B, S, H, GLA_DV)
    o = o * lax.rsqrt(jnp.mean(o * o, axis=-1, keepdims=True) + EPS)
    o = o.reshape(B, S, GLA_WIDTH) * norm_gain.astype(f32)
    return (o * jax.nn.silu(r.astype(f32))).astype(q.dtype)


def s5_mixer(x, a_re, a_im, log_dt, b_re, b_im, c_re, c_im, d, w_glu):
    B, S, _ = x.shape
    f32 = jnp.float32
    a_re, a_im = a_re.astype(f32), a_im.astype(f32)
    b_re, b_im = b_re.astype(f32), b_im.astype(f32)
    xf = x.astype(f32)
    xg = xf.reshape(B, S, SSM_GROUPS, SSM_GROUP)
    dt = jnp.exp(log_dt.astype(f32))[:, None]
    mag = jnp.exp(dt * a_re)
    ab_re = mag * jnp.cos(dt * a_im)
    ab_im = mag * jnp.sin(dt * a_im)
    den = a_re * a_re + a_im * a_im
    f_re = ((ab_re - 1.0) * a_re + ab_im * a_im) / den
    f_im = (ab_im * a_re - (ab_re - 1.0) * a_im) / den
    bb_re = f_re[..., None] * b_re - f_im[..., None] * b_im
    bb_im = f_re[..., None] * b_im + f_im[..., None] * b_re
    u_re = jnp.einsum('bsgh,gph->bsgp', xg, bb_re)
    u_im = jnp.einsum('bsgh,gph->bsgp', xg, bb_im)

    def combine(e1, e2):
        a1r, a1i, h1r, h1i = e1
        a2r, a2i, h2r, h2i = e2
        return (a2r * a1r - a2i * a1i, a2r * a1i + a2i * a1r,
                a2r * h1r - a2i * h1i + h2r, a2r * h1i + a2i * h1r + h2i)

    def scan_one(ur, ui):
        ar = jnp.broadcast_to(ab_re, ur.shape)
        ai = jnp.broadcast_to(ab_im, ur.shape)
        _, _, hr, hi = lax.associative_scan(combine, (ar, ai, ur, ui), axis=0)
        return hr, hi

    h_re, h_im = jax.vmap(scan_one)(u_re, u_im)
    y = (jnp.einsum('bsgp,ghp->bsgh', h_re, c_re.astype(f32))
         - jnp.einsum('bsgp,ghp->bsgh', h_im, c_im.astype(f32)))
    y = y.reshape(B, S, SSM_WIDTH) + d.astype(f32) * xf
    y = jax.nn.gelu(y)
    y = y * jax.nn.sigmoid(y @ w_glu.astype(f32))
    return y.astype(x.dtype)


def _normal(key, shape, std):
    return jax.random.normal(key, shape, jnp.float32) * std


def setup_inputs(seed: int = 0) -> dict:
    key = jax.random.key(seed)
    k = jax.random.split(key, 32)
    L, D, F = DEPTH, D_MODEL, D_FF
    G, P, HG = SSM_GROUPS, SSM_STATE, SSM_GROUP
    nq = len(POOL_WINDOWS)
    a_im = jnp.pi * jnp.arange(P, dtype=jnp.float32)
    return {
        'x': _normal(k[0], (BATCH, SEQ, D), 1.0),
        'ffn1_norm': 1.0 + _normal(k[1], (L, D), 0.02),
        'ffn1_w_gate': _normal(k[2], (L, D, F), D ** -0.5),
        'ffn1_w_up': _normal(k[3], (L, D, F), D ** -0.5),
        'ffn1_w_down': _normal(k[4], (L, F, D), F ** -0.5),
        'mix_norm': 1.0 + _normal(k[5], (L, D), 0.02),
        'w_in': _normal(k[6], (L, D, IN_WIDTH), D ** -0.5),
        'pool_w': _normal(k[7], (L, nq, POOL_GROUP, POOL_GROUP), POOL_GROUP ** -0.5),
        'pool_scale': 1.0 + _normal(k[8], (L, POOL_WIDTH), 0.1),
        'gla_w_gate2': _normal(k[9], (L, GLA_GATE_RANK, GLA_HEADS * GLA_DK), GLA_GATE_RANK ** -0.5),
        'gla_gate_bias': _normal(k[10], (L, GLA_HEADS * GLA_DK), 0.01),
        'gla_norm': 1.0 + _normal(k[11], (L, GLA_WIDTH), 0.02),
        'ssm_a_re': -0.5 + _normal(k[12], (L, G, P), 0.01),
        'ssm_a_im': a_im + _normal(k[13], (L, G, P), 0.01),
        'ssm_log_dt': jax.random.uniform(k[14], (L, G), jnp.float32,
                                         float(np.log(DT_MIN)), float(np.log(DT_MAX))),
        'ssm_b_re': _normal(k[15], (L, G, P, HG), (2 * HG) ** -0.5),
        'ssm_b_im': _normal(k[16], (L, G, P, HG), (2 * HG) ** -0.5),
        'ssm_c_re': _normal(k[17], (L, G, HG, P), (2 * P) ** -0.5),
        'ssm_c_im': _normal(k[18], (L, G, HG, P), (2 * P) ** -0.5),
        'ssm_d': _normal(k[19], (L, SSM_WIDTH), 1.0),
        'ssm_w_glu': _normal(k[20], (L, SSM_WIDTH, SSM_WIDTH), SSM_WIDTH ** -0.5),
        'w_branch': _normal(k[21], (L, MIX_WIDTH, D), (MIX_WIDTH // 2) ** -0.5),
        'w_out': _normal(k[22], (L, D, D), D ** -0.5),
        'ffn2_norm': 1.0 + _normal(k[23], (L, D), 0.02),
        'ffn2_w_gate': _normal(k[24], (L, D, F), D ** -0.5),
        'ffn2_w_up': _normal(k[25], (L, D, F), D ** -0.5),
        'ffn2_w_down': _normal(k[26], (L, F, D), F ** -0.5),
        'final_norm': 1.0 + _normal(k[27], (D,), 0.02),
    }


def reference(x, ffn1_norm, ffn1_w_gate, ffn1_w_up, ffn1_w_down, mix_norm, w_in,
              pool_w, pool_scale, gla_w_gate2, gla_gate_bias, gla_norm,
              ssm_a_re, ssm_a_im, ssm_log_dt, ssm_b_re, ssm_b_im, ssm_c_re, ssm_c_im,
              ssm_d, ssm_w_glu, w_branch, w_out,
              ffn2_norm, ffn2_w_gate, ffn2_w_up, ffn2_w_down, final_norm):
    B, S, D = x.shape
    p0, p1 = POOL_WIDTH, POOL_WIDTH + GLA_WIDTH
    for l in range(DEPTH):
        x = x + 0.5 * swiglu(rms_norm(x, ffn1_norm[l]), ffn1_w_gate[l], ffn1_w_up[l], ffn1_w_down[l])
        u = rms_norm(x, mix_norm[l])
        z = u @ w_in[l]
        p_in, q, k, v, r, g_lr, s_in, gate_logits = split_columns(z)
        y_pool = pool_mixer(p_in, pool_w[l], pool_scale[l])
        y_gla = gla_mixer(q, k, v, r, g_lr, gla_w_gate2[l], gla_gate_bias[l], gla_norm[l])
        y_ssm = s5_mixer(s_in, ssm_a_re[l], ssm_a_im[l], ssm_log_dt[l], ssm_b_re[l], ssm_b_im[l],
                         ssm_c_re[l], ssm_c_im[l], ssm_d[l], ssm_w_glu[l])
        gates = jax.nn.sigmoid(gate_logits.astype(jnp.float32)).astype(x.dtype).reshape(B, S, N_BRANCH, D)
        wb = w_branch[l]
        merged = (gates[:, :, 0] * (y_pool @ wb[:p0])
                  + gates[:, :, 1] * (y_gla @ wb[p0:p1])
                  + gates[:, :, 2] * (y_ssm @ wb[p1:]))
        x = x + merged @ w_out[l]
        x = x + 0.5 * swiglu(rms_norm(x, ffn2_norm[l]), ffn2_w_gate[l], ffn2_w_up[l], ffn2_w_down[l])
    return rms_norm(x, final_norm)
```

```cpp
#include <hip/hip_runtime.h>
#include <hip/hip_cooperative_groups.h>
#include <cstdio>
#include <cstdint>
namespace cg = cooperative_groups;

#ifndef MK_MULTI_LAUNCH
#define MK_MULTI_LAUNCH 0
#endif

#define LAS __attribute__((address_space(3)))
typedef unsigned short bf16_t;
typedef short bf16x8 __attribute__((ext_vector_type(8)));
typedef float f32x4 __attribute__((ext_vector_type(4)));
typedef unsigned u32x4 __attribute__((ext_vector_type(4)));
typedef unsigned u32x2 __attribute__((ext_vector_type(2)));

constexpr int T = 16384, DM = 2048, FF = 5632, SEQ = 4096;
constexpr int ZW = 10240;
constexpr int ZC_POOL = 0, ZC_Q = 512, ZC_K = 1024, ZC_V = 1536, ZC_R = 2560, ZC_S = 3584, ZC_G = 4096;
constexpr int YC_GLA = 512, YC_SSM = 1536;
constexpr int INW = 10256;
constexpr float EPS = 1e-6f;

constexpr size_t MiB = 1u << 20;
constexpr size_t WS_RSS = 0;
constexpr size_t WS_WGT = 1 * MiB;
constexpr size_t WS_L64 = 1 * MiB + 131072;
constexpr size_t WS_GLR = 2 * MiB;
constexpr size_t WS_DEC = 3 * MiB;
constexpr size_t WS_KT = 4 * MiB;
constexpr size_t WS_E = 5 * MiB;
constexpr size_t WS_HC = 9 * MiB;
constexpr size_t WS_MET = 11 * MiB;
constexpr size_t WS_MCT = 19 * MiB;
constexpr size_t WS_YS = 27 * MiB;
constexpr size_t WS_W1U = 43 * MiB, WS_W1D = 87 * MiB, WS_WIN = 109 * MiB, WS_WBR = 149 * MiB, WS_WO = 157 * MiB, WS_WGLU = 165 * MiB;
constexpr size_t WS_W2U = 166 * MiB, WS_W2D = 210 * MiB;
constexpr size_t WS_XB = 232 * MiB, WS_Y = 296 * MiB, WS_MB = 360 * MiB, WS_KV = 424 * MiB, WS_Z = 488 * MiB, WS_END = 808 * MiB;

constexpr int LDS_BYTES = 147456;

__device__ __forceinline__ unsigned f2bf(float f) { unsigned u = __float_as_uint(f); return (u + 0x7fffu + ((u >> 16) & 1u)) >> 16; }
__device__ __forceinline__ float bf2f(unsigned short b) { return __uint_as_float(((unsigned)b) << 16); }
__device__ __forceinline__ unsigned pk2(float lo, float hi) { return f2bf(lo) | (f2bf(hi) << 16); }
__device__ __forceinline__ float bflo(unsigned w) { return __uint_as_float(w << 16); }
__device__ __forceinline__ float bfhi(unsigned w) { return __uint_as_float(w & 0xffff0000u); }
__device__ __forceinline__ float wave_sum(float v) {
#pragma unroll
    for (int o = 1; o < 64; o <<= 1) v += __shfl_xor(v, o);
    return v;
}
__device__ __forceinline__ float sigmoid_f(float x) { return __builtin_amdgcn_rcpf(1.f + __expf(-x)); }
__device__ __forceinline__ float gelu_tanh_f(float x) {
    const float u = 0.7978845608028654f * (x + 0.044715f * x * x * x);
    const float t = 1.f - 2.f * __builtin_amdgcn_rcpf(1.f + __expf(2.f * u));
    return 0.5f * x * (1.f + t);
}
#define LDS_WAIT() asm volatile("s_waitcnt lgkmcnt(0)" ::: "memory")
__device__ __forceinline__ int otid() { int t = threadIdx.x; asm volatile("" : "+v"(t)); return t; }
__device__ __forceinline__ f32x4 mfma16(bf16x8 a, bf16x8 b, f32x4 c) { return __builtin_amdgcn_mfma_f32_16x16x32_bf16(a, b, c, 0, 0, 0); }

namespace pg8 {
constexpr int BM = 256, BK = 64, HALF = 128, HTB = HALF * BK * 2, STAGE_BYTES = 8 * HTB, NXCD = 8, WGM = 8;
__host__ __device__ __forceinline__ int lds_byte(int r, int c) { const int st = (r >> 4) * 2 + (c >> 5), rr = r & 15, cc = c & 31, ob = rr * 64 + cc * 2; return st * 1024 + (ob ^ (((ob >> 9) & 1) << 5)); }
__host__ __device__ __forceinline__ void stage_rc(int b, int& R, int& C) { const int st = b / 1024, sb = b % 1024, swz = sb ^ (((sb >> 9) & 1) << 5); R = (st >> 1) * 16 + swz / 64; C = (st & 1) * 32 + (swz % 64) / 2; }
__host__ __device__ __forceinline__ int perm32(int rho) { const int n = rho >> 4, i = rho & 15; return 8 * (i >> 2) + 4 * n + (i & 3); }

struct Unit { int pm, pn; };
struct Gemm { const bf16_t* A; const bf16_t* Bt; int M, N, K, lda, ldb; };

struct StaticOrder {
    int nM, nN, nwg, G, c;
    __device__ void init(int M, int N, int G_, int c_) { nM = M / BM; nN = N / BM; nwg = nM * nN; G = G_; c = c_; }
    __device__ bool next(int i, Unit& u) const {
        const long L = (long)i * G + c; if (L >= nwg) return false;
        int wgid = (int)L; { const int q = nwg / NXCD, r = nwg % NXCD, xcd = wgid % NXCD, off = wgid / NXCD; wgid = (xcd < r ? xcd * (q + 1) : r * (q + 1) + (xcd - r) * q) + off; }
        const int nig = WGM * nN, gid = wgid / nig, fm = gid * WGM, gsz = (nM - fm) < WGM ? (nM - fm) : WGM;
        u.pm = fm + ((wgid % nig) % gsz); u.pn = (wgid % nig) / gsz; return true;
    }
};

template <class Epi>
__device__ __forceinline__ void gemm_phase(LAS unsigned char* lds, const Gemm g, const StaticOrder& S, const Epi& E) {
    const int tid = otid(), wid = __builtin_amdgcn_readfirstlane(tid >> 6), lane = tid & 63, wr = wid >> 2, wc = wid & 3, fr = lane & 15, fq = lane >> 4;
    const int nt = g.K / BK;
    unsigned voffA[2], voffB[2];
#pragma unroll
    for (int i = 0; i < 2; ++i) { int R, C; stage_rc(tid * 16 + i * 8192, R, C); const int Rb = (R & ~31) + perm32(R & 31);
        voffA[i] = (unsigned)(R * g.lda + C) * 2u; voffB[i] = (unsigned)(Rb * g.ldb + C) * 2u; }
    const size_t kstep = (size_t)(BK * 2);
    const size_t hstepA = (size_t)HALF * g.lda * 2, hstepB = (size_t)HALF * g.ldb * 2;
    const size_t tstepA = 2 * hstepA, tstepB = 2 * hstepB;
    const unsigned ldsw = (unsigned)wid * 1024u;
    const int aoff = lds_byte(wr * 64 + fr, fq * 8), boff = lds_byte(wc * 32 + fr, fq * 8);
#define PG8_SA(b, h) (((b) * 2 + (h)) * HTB)
#define PG8_SB(b, h) ((4 + (b) * 2 + (h)) * HTB)
#define PG8_STAGE(bufoff, gbase, voff) do { _Pragma("unroll") for (int _i = 0; _i < 2; ++_i) \
        __builtin_amdgcn_global_load_lds((const unsigned*)((const char*)(gbase) + (voff)[_i]), (LAS unsigned*)(lds + (bufoff) + ldsw + _i * 8192), 16, 0, 0); } while (0)
#define PG8_LDA(dst, b, h) do { _Pragma("unroll") for (int m = 0; m < 4; ++m) _Pragma("unroll") for (int k = 0; k < 2; ++k) dst[m][k] = *(const LAS bf16x8*)(lds + PG8_SA(b, h) + aoff + m * 2048 + k * 1024); } while (0)
#define PG8_LDB(dst, b, h) do { _Pragma("unroll") for (int n = 0; n < 2; ++n) _Pragma("unroll") for (int k = 0; k < 2; ++k) dst[n][k] = *(const LAS bf16x8*)(lds + PG8_SB(b, h) + boff + n * 2048 + k * 1024); } while (0)
#define PG8_MMA(ai, bj, At, Bt) do { __builtin_amdgcn_s_setprio(1); _Pragma("unroll") for (int m = 0; m < 4; ++m) _Pragma("unroll") for (int n = 0; n < 2; ++n) _Pragma("unroll") for (int k = 0; k < 2; ++k) \
        acc[ai][bj][m][n] = __builtin_amdgcn_mfma_f32_16x16x32_bf16(Bt[n][k], At[m][k], acc[ai][bj][m][n], 0, 0, 0); __builtin_amdgcn_s_setprio(0); } while (0)
#define PG8_WAIT_V(n) asm volatile("s_waitcnt vmcnt(" #n ")" ::: "memory")
#define PG8_WAIT_L(n) asm volatile("s_waitcnt lgkmcnt(" #n ")" ::: "memory")
#define PG8_BAR __builtin_amdgcn_s_barrier()
#define PG8_SCHED __builtin_amdgcn_sched_barrier(0)
    Unit cur, nxt; int ui = 0;
    if (!S.next(0, cur)) return;
    f32x4 acc[2][2][4][2];
#pragma unroll
    for (int a = 0; a < 2; ++a)
#pragma unroll
        for (int b = 0; b < 2; ++b)
#pragma unroll
            for (int m = 0; m < 4; ++m)
#pragma unroll
                for (int n = 0; n < 2; ++n) acc[a][b][m][n] = (f32x4){0.f, 0.f, 0.f, 0.f};
    bf16x8 At[4][2], B0[2][2], B1[2][2];
    const char* cA = (const char*)g.A + (size_t)cur.pm * tstepA; const char* cB = (const char*)g.Bt + (size_t)cur.pn * tstepB;
    PG8_STAGE(PG8_SB(0, 0), cB, voffB); PG8_STAGE(PG8_SB(0, 1), cB + hstepB, voffB); PG8_STAGE(PG8_SA(0, 0), cA, voffA); PG8_STAGE(PG8_SA(0, 1), cA + hstepA, voffA);
    if (wr == 1) PG8_BAR;
    PG8_WAIT_V(2); PG8_BAR;
    PG8_STAGE(PG8_SB(1, 0), cB + kstep, voffB); PG8_STAGE(PG8_SA(1, 0), cA + kstep, voffA); PG8_STAGE(PG8_SB(1, 1), cB + hstepB + kstep, voffB);
    PG8_WAIT_V(6); PG8_BAR;
    for (;;) {
        const bool has_next = S.next(ui + 1, nxt);
        const char* nA = has_next ? (const char*)g.A + (size_t)nxt.pm * tstepA : cA; const char* nB = has_next ? (const char*)g.Bt + (size_t)nxt.pn * tstepB : cB;
        for (int t = 0; t < nt; t += 2) {
            const bool last = (t == nt - 2);
            const char* a1 = cA + (size_t)(t + 1) * kstep;
            const char* a2 = last ? nA : cA + (size_t)(t + 2) * kstep; const char* b2 = last ? nB : cB + (size_t)(t + 2) * kstep;
            const char* a3 = a2 + kstep; const char* b3 = b2 + kstep;
            PG8_LDB(B0, 0, 0); PG8_LDB(B1, 0, 1); PG8_SCHED; PG8_LDA(At, 0, 0); PG8_STAGE(PG8_SA(1, 1), a1 + hstepA, voffA);
            PG8_WAIT_V(8); PG8_WAIT_L(0); PG8_BAR; PG8_MMA(0, 0, At, B0); PG8_MMA(0, 1, At, B1); PG8_BAR; PG8_SCHED;
            PG8_LDA(At, 0, 1); PG8_STAGE(PG8_SB(0, 0), b2, voffB); PG8_STAGE(PG8_SB(0, 1), b2 + hstepB, voffB); PG8_STAGE(PG8_SA(0, 0), a2, voffA);
            PG8_WAIT_V(8); PG8_WAIT_L(0); PG8_BAR; PG8_MMA(1, 0, At, B0); PG8_MMA(1, 1, At, B1); PG8_BAR; PG8_SCHED;
            PG8_LDB(B0, 1, 0); PG8_LDB(B1, 1, 1); PG8_SCHED; PG8_LDA(At, 1, 0); PG8_STAGE(PG8_SA(0, 1), a2 + hstepA, voffA);
            PG8_WAIT_V(8); PG8_WAIT_L(0); PG8_BAR; PG8_MMA(0, 0, At, B0); PG8_MMA(0, 1, At, B1); PG8_BAR; PG8_SCHED;
            PG8_LDA(At, 1, 1); PG8_STAGE(PG8_SB(1, 0), b3, voffB); PG8_STAGE(PG8_SB(1, 1), b3 + hstepB, voffB); PG8_STAGE(PG8_SA(1, 0), a3, voffA);
            PG8_WAIT_V(8); PG8_WAIT_L(0); PG8_BAR; PG8_MMA(1, 0, At, B0); PG8_MMA(1, 1, At, B1); PG8_BAR; PG8_SCHED;
        }
        if (wr == 0) PG8_BAR;
        E(acc, cur, wr, wc, fr, fq);
        if (!has_next) break;
#pragma unroll
        for (int a = 0; a < 2; ++a)
#pragma unroll
            for (int b = 0; b < 2; ++b)
#pragma unroll
                for (int m = 0; m < 4; ++m)
#pragma unroll
                    for (int n = 0; n < 2; ++n) acc[a][b][m][n] = (f32x4){0.f, 0.f, 0.f, 0.f};
        cur = nxt; cA = nA; cB = nB; ++ui;
        if (wr == 1) PG8_BAR;
    }
    PG8_WAIT_V(0);
    PG8_BAR;
#undef PG8_SA
#undef PG8_SB
#undef PG8_STAGE
#undef PG8_LDA
#undef PG8_LDB
#undef PG8_MMA
#undef PG8_WAIT_V
#undef PG8_WAIT_L
#undef PG8_BAR
#undef PG8_SCHED
}

typedef const f32x4 (&AccRef)[2][2][4][2];

struct EpiFfnUp {
    bf16_t* H; const unsigned long long* rss;
    __device__ __forceinline__ void operator()(AccRef acc, const Unit& u, int wr, int wc, int fr, int fq) const {
        const int row0 = u.pm * BM + wr * 64 + fr, col0 = u.pn * 128 + wc * 32 + 8 * fq;
#pragma unroll
        for (int ai = 0; ai < 2; ++ai)
#pragma unroll
            for (int m = 0; m < 4; ++m) {
                const int row = row0 + ai * HALF + m * 16;
                const float rinv = rsqrtf((float)rss[row] * (1.f / (16777216.f * DM)) + EPS);
                float h[8];
#pragma unroll
                for (int n = 0; n < 2; ++n)
#pragma unroll
                    for (int j = 0; j < 4; ++j) { const float gg = acc[ai][0][m][n][j] * rinv, uu = acc[ai][1][m][n][j] * rinv; h[n * 4 + j] = gg * uu * sigmoid_f(gg); }
                u32x4 o; o.x = pk2(h[0], h[1]); o.y = pk2(h[2], h[3]); o.z = pk2(h[4], h[5]); o.w = pk2(h[6], h[7]);
                *(u32x4*)(H + (size_t)row * FF + col0) = o;
            }
    }
};
struct EpiWin {
    bf16_t* Z; const unsigned long long* rss;
    __device__ __forceinline__ void operator()(AccRef acc, const Unit& u, int wr, int wc, int fr, int fq) const {
        const int row0 = u.pm * BM + wr * 64 + fr, col0 = u.pn * BM + wc * 32 + 8 * fq;
        const bool sg = u.pn >= 16;
#pragma unroll
        for (int ai = 0; ai < 2; ++ai)
#pragma unroll
            for (int m = 0; m < 4; ++m) {
                const int row = row0 + ai * HALF + m * 16;
                const float rinv = rsqrtf((float)rss[row] * (1.f / (16777216.f * DM)) + EPS);
#pragma unroll
                for (int bj = 0; bj < 2; ++bj) {
                    float h[8];
#pragma unroll
                    for (int n = 0; n < 2; ++n)
#pragma unroll
                        for (int j = 0; j < 4; ++j) { const float v = acc[ai][bj][m][n][j] * rinv; h[n * 4 + j] = sg ? sigmoid_f(v) : v; }
                    u32x4 o; o.x = pk2(h[0], h[1]); o.y = pk2(h[2], h[3]); o.z = pk2(h[4], h[5]); o.w = pk2(h[6], h[7]);
                    *(u32x4*)(Z + (size_t)row * ZW + col0 + bj * HALF) = o;
                }
            }
    }
};
struct EpiResid {
    const float* xin; float* xout; bf16_t* XB; unsigned long long* rssn; float scale;
    __device__ __forceinline__ void operator()(AccRef acc, const Unit& u, int wr, int wc, int fr, int fq) const {
        const int row0 = u.pm * BM + wr * 64 + fr, col0 = u.pn * BM + wc * 32 + 8 * fq;
#pragma unroll
        for (int ai = 0; ai < 2; ++ai)
#pragma unroll
            for (int m = 0; m < 4; ++m) {
                const int row = row0 + ai * HALF + m * 16;
                float ss = 0.f;
#pragma unroll
                for (int bj = 0; bj < 2; ++bj) {
                    const size_t off = (size_t)row * DM + col0 + bj * HALF;
                    f32x4 x0 = *(const f32x4*)(xin + off), x1 = *(const f32x4*)(xin + off + 4);
                    x0 = x0 + acc[ai][bj][m][0] * scale; x1 = x1 + acc[ai][bj][m][1] * scale;
                    *(f32x4*)(xout + off) = x0; *(f32x4*)(xout + off + 4) = x1;
                    u32x4 o; o.x = pk2(x0[0], x0[1]); o.y = pk2(x0[2], x0[3]); o.z = pk2(x1[0], x1[1]); o.w = pk2(x1[2], x1[3]);
                    *(u32x4*)(XB + off) = o;
                    ss += x0[0] * x0[0] + x0[1] * x0[1] + x0[2] * x0[2] + x0[3] * x0[3] + x1[0] * x1[0] + x1[1] * x1[1] + x1[2] * x1[2] + x1[3] * x1[3];
                }
                ss += __shfl_xor(ss, 16); ss += __shfl_xor(ss, 32);
                if (fq == 0) atomicAdd(rssn + row, (unsigned long long)(ss * 16777216.f));
            }
    }
};
struct EpiBranch {
    const bf16_t* G; bf16_t* MB; int accum;
    __device__ __forceinline__ void operator()(AccRef acc, const Unit& u, int wr, int wc, int fr, int fq) const {
        const int row0 = u.pm * BM + wr * 64 + fr, col0 = u.pn * BM + wc * 32 + 8 * fq;
#pragma unroll
        for (int ai = 0; ai < 2; ++ai)
#pragma unroll
            for (int m = 0; m < 4; ++m) {
                const int row = row0 + ai * HALF + m * 16;
#pragma unroll
                for (int bj = 0; bj < 2; ++bj) {
                    const int col = col0 + bj * HALF;
                    const u32x4 gv = *(const u32x4*)(G + (size_t)row * ZW + col);
                    u32x4 pv = (u32x4){0u, 0u, 0u, 0u};
                    if (accum) pv = *(const u32x4*)(MB + (size_t)row * DM + col);
                    const f32x4 a0 = acc[ai][bj][m][0], a1 = acc[ai][bj][m][1];
                    u32x4 o;
                    o.x = pk2(bflo(pv.x) + bflo(gv.x) * a0[0], bfhi(pv.x) + bfhi(gv.x) * a0[1]);
                    o.y = pk2(bflo(pv.y) + bflo(gv.y) * a0[2], bfhi(pv.y) + bfhi(gv.y) * a0[3]);
                    o.z = pk2(bflo(pv.z) + bflo(gv.z) * a1[0], bfhi(pv.z) + bfhi(gv.z) * a1[1]);
                    o.w = pk2(bflo(pv.w) + bflo(gv.w) * a1[2], bfhi(pv.w) + bfhi(gv.w) * a1[3]);
                    *(u32x4*)(MB + (size_t)row * DM + col) = o;
                }
            }
    }
};
struct EpiGlu {
    const bf16_t* YS; bf16_t* Y;
    __device__ __forceinline__ void operator()(AccRef acc, const Unit& u, int wr, int wc, int fr, int fq) const {
        const int row0 = u.pm * BM + wr * 64 + fr, col0 = u.pn * BM + wc * 32 + 8 * fq;
#pragma unroll
        for (int ai = 0; ai < 2; ++ai)
#pragma unroll
            for (int m = 0; m < 4; ++m) {
                const int row = row0 + ai * HALF + m * 16;
#pragma unroll
                for (int bj = 0; bj < 2; ++bj) {
                    const int col = col0 + bj * HALF;
                    const u32x4 yv = *(const u32x4*)(YS + (size_t)row * 512 + col);
                    const f32x4 a0 = acc[ai][bj][m][0], a1 = acc[ai][bj][m][1];
                    u32x4 o;
                    o.x = pk2(bflo(yv.x) * sigmoid_f(a0[0]), bfhi(yv.x) * sigmoid_f(a0[1]));
                    o.y = pk2(bflo(yv.y) * sigmoid_f(a0[2]), bfhi(yv.y) * sigmoid_f(a0[3]));
                    o.z = pk2(bflo(yv.z) * sigmoid_f(a1[0]), bfhi(yv.z) * sigmoid_f(a1[1]));
                    o.w = pk2(bflo(yv.w) * sigmoid_f(a1[2]), bfhi(yv.w) * sigmoid_f(a1[3]));
                    *(u32x4*)(Y + (size_t)row * DM + YC_SSM + col) = o;
                }
            }
    }
};
}

struct Args { const float* in[28]; float* out; unsigned char* ws; int ph_lo, ph_hi; };
enum { I_X = 0, I_F1N, I_F1G, I_F1U, I_F1D, I_MIXN, I_WIN, I_POOLW, I_POOLS, I_GW2, I_GB, I_GNORM, I_ARE, I_AIM, I_LDT, I_BRE, I_BIM, I_CRE, I_CIM,
       I_SD, I_WGLU, I_WBR, I_WOUT, I_F2N, I_F2G, I_F2U, I_F2D, I_FINN };

__device__ __forceinline__ void tr_item(const float* W, int ldw, int col0, const float* ksc, bf16_t* WT, int ldt, int drow, int k0, int n0, float* scr, int lane) {
#pragma unroll 8
    for (int i = 0; i < 32; ++i) { const int kk = 2 * i + (lane >> 5); float v = W[(size_t)(k0 + kk) * ldw + col0 + n0 + (lane & 31)]; if (ksc) v *= ksc[k0 + kk]; scr[kk * 33 + (lane & 31)] = v; }
    LDS_WAIT();
    const int c = lane & 7;
#pragma unroll
    for (int j = 0; j < 4; ++j) { const int n = (lane >> 3) + 8 * j; const float* s = scr + (8 * c) * 33 + n;
        u32x4 o; o.x = pk2(s[0 * 33], s[1 * 33]); o.y = pk2(s[2 * 33], s[3 * 33]); o.z = pk2(s[4 * 33], s[5 * 33]); o.w = pk2(s[6 * 33], s[7 * 33]);
        *(u32x4*)(WT + (size_t)(drow + n) * ldt + k0 + 8 * c) = o; }
    LDS_WAIT();
}
__device__ __forceinline__ bool tr_try(int& r, const float* W, int ldw, int K, int N, int col0, const float* ksc, bf16_t* WT, int ldt, int drow0, int mode, float* scr, int lane) {
    const int nblk = N / 32, items = (K / 64) * nblk;
    if (r >= items) { r -= items; return false; }
    const int kb = r / nblk, n0 = (r % nblk) * 32;
    const int drow = drow0 + (mode ? ((n0 >> 7) * 256 + (n0 & 127)) : n0);
    tr_item(W, ldw, col0, ksc, WT, ldt, drow, kb * 64, n0, scr, lane);
    return true;
}

__device__ __forceinline__ void cpow_d(double th, double la, int j, double& pr, double& pi) {
    const double y = th * (double)j;
    const double kq = __builtin_rint(y * 0.63661977236758134308);
    double r = __builtin_fma(-kq, 1.57079632679489655800, y); r = __builtin_fma(-kq, 6.12323399573676603587e-17, r);
    const double r2 = r * r;
    double s = 1.0 - r2 / 272.0; s = 1.0 - r2 / 210.0 * s; s = 1.0 - r2 / 156.0 * s; s = 1.0 - r2 / 110.0 * s; s = 1.0 - r2 / 72.0 * s; s = 1.0 - r2 / 42.0 * s; s = 1.0 - r2 / 20.0 * s; s = 1.0 - r2 / 6.0 * s; s *= r;
    double c = 1.0 - r2 / 240.0; c = 1.0 - r2 / 182.0 * c; c = 1.0 - r2 / 132.0 * c; c = 1.0 - r2 / 90.0 * c; c = 1.0 - r2 / 56.0 * c; c = 1.0 - r2 / 30.0 * c; c = 1.0 - r2 / 12.0 * c; c = 1.0 - r2 / 2.0 * c;
    const int q = ((int)kq) & 3;
    double sn = s, cs = c;
    if (q == 1) { sn = c; cs = -s; } else if (q == 2) { sn = -s; cs = -c; } else if (q == 3) { sn = -c; cs = s; }
    const double x = la * (double)j * (1.0 / 64.0);
    double e = 1.0 + x / 10.0; e = 1.0 + x / 9.0 * e; e = 1.0 + x / 8.0 * e; e = 1.0 + x / 7.0 * e; e = 1.0 + x / 6.0 * e; e = 1.0 + x / 5.0 * e; e = 1.0 + x / 4.0 * e; e = 1.0 + x / 3.0 * e; e = 1.0 + x / 2.0 * e; e = 1.0 + x * e;
#pragma unroll
    for (int i = 0; i < 6; ++i) e = e * e;
    pr = e * cs; pi = e * sn;
}

__device__ __forceinline__ void phase_prep(const Args& a, int l, unsigned char* lds, int G) {
    const int tid = otid(), lane = tid & 63, wave = tid >> 6;
    unsigned char* ws = a.ws;
    const int gw = blockIdx.x * 8 + wave, NGW = G * 8;
    float* scr = (float*)(lds + wave * 16384);
    const float* f1n = a.in[I_F1N] + (size_t)l * DM; const float* f2n = a.in[I_F2N] + (size_t)l * DM; const float* mxn = a.in[I_MIXN] + (size_t)l * DM;
    const float* f1g = a.in[I_F1G] + (size_t)l * DM * FF; const float* f1u = a.in[I_F1U] + (size_t)l * DM * FF; const float* f1d = a.in[I_F1D] + (size_t)l * FF * DM;
    const float* f2g = a.in[I_F2G] + (size_t)l * DM * FF; const float* f2u = a.in[I_F2U] + (size_t)l * DM * FF; const float* f2d = a.in[I_F2D] + (size_t)l * FF * DM;
    const float* win = a.in[I_WIN] + (size_t)l * DM * INW; const float* wbr = a.in[I_WBR] + (size_t)l * DM * DM; const float* wout = a.in[I_WOUT] + (size_t)l * DM * DM;
    const float* wglu = a.in[I_WGLU] + (size_t)l * 512 * 512;
    constexpr int IT_FU = (DM / 64) * (FF / 32), IT_FD = (FF / 64) * (DM / 32), IT_WA = (DM / 64) * (3584 / 32), IT_WB = (DM / 64) * (6656 / 32),
                  IT_BR = (1536 / 64) * (DM / 32), IT_WO = (DM / 64) * (DM / 32), IT_GL = (512 / 64) * (512 / 32);
    constexpr int IT_TOTAL = 4 * IT_FU + 2 * IT_FD + IT_WA + IT_WB + IT_BR + IT_WO + IT_GL;
    for (int it = gw; it < IT_TOTAL; it += NGW) {
        int r = it;
        if (tr_try(r, f1g, FF, DM, FF, 0, f1n, (bf16_t*)(ws + WS_W1U), DM, 0, 1, scr, lane)) continue;
        if (tr_try(r, f1u, FF, DM, FF, 0, f1n, (bf16_t*)(ws + WS_W1U), DM, 128, 1, scr, lane)) continue;
        if (tr_try(r, f2g, FF, DM, FF, 0, f2n, (bf16_t*)(ws + WS_W2U), DM, 0, 1, scr, lane)) continue;
        if (tr_try(r, f2u, FF, DM, FF, 0, f2n, (bf16_t*)(ws + WS_W2U), DM, 128, 1, scr, lane)) continue;
        if (tr_try(r, f1d, DM, FF, DM, 0, nullptr, (bf16_t*)(ws + WS_W1D), FF, 0, 0, scr, lane)) continue;
        if (tr_try(r, f2d, DM, FF, DM, 0, nullptr, (bf16_t*)(ws + WS_W2D), FF, 0, 0, scr, lane)) continue;
        if (tr_try(r, win, INW, DM, 3584, 0, mxn, (bf16_t*)(ws + WS_WIN), DM, 0, 0, scr, lane)) continue;
        if (tr_try(r, win, INW, DM, 6656, 3600, mxn, (bf16_t*)(ws + WS_WIN), DM, 3584, 0, scr, lane)) continue;
        if (tr_try(r, wbr + (size_t)512 * DM, DM, 1536, DM, 0, nullptr, (bf16_t*)(ws + WS_WBR) + 512, DM, 0, 0, scr, lane)) continue;
        if (tr_try(r, wout, DM, DM, DM, 0, nullptr, (bf16_t*)(ws + WS_WO), DM, 0, 0, scr, lane)) continue;
        tr_try(r, wglu, 512, 512, 512, 0, nullptr, (bf16_t*)(ws + WS_WGLU), 512, 0, 0, scr, lane);
    }
    {
        const float* pw = a.in[I_POOLW] + (size_t)l * 4 * 128 * 128; const float* ps = a.in[I_POOLS] + (size_t)l * 512;
        bf16_t* WbT = (bf16_t*)(ws + WS_WBR);
        for (int n = blockIdx.x; n < DM; n += G) {
            const int k = tid, g = k >> 7;
            const float* pr = pw + (size_t)k * 128;
            float s = 0.f;
#pragma unroll 8
            for (int d = 0; d < 128; ++d) s += pr[d] * ps[g * 128 + d] * wbr[(size_t)(g * 128 + d) * DM + n];
            WbT[(size_t)n * DM + k] = (bf16_t)f2bf(s);
        }
    }
    {
        bf16_t* WGT = (bf16_t*)(ws + WS_WGT);
        for (int i = blockIdx.x * 512 + tid; i < 16 * DM; i += G * 512) { const int j = i >> 11, k = i & 2047; WGT[i] = (bf16_t)f2bf(mxn[k] * win[(size_t)k * INW + 3584 + j]); }
    }
    {
        const float* are = a.in[I_ARE] + (size_t)l * 32 * 64; const float* aim = a.in[I_AIM] + (size_t)l * 32 * 64; const float* ldt = a.in[I_LDT] + (size_t)l * 32;
        const float* bre = a.in[I_BRE] + (size_t)l * 32 * 64 * 16; const float* bim = a.in[I_BIM] + (size_t)l * 32 * 64 * 16;
        const float* cre = a.in[I_CRE] + (size_t)l * 32 * 16 * 64; const float* cim = a.in[I_CIM] + (size_t)l * 32 * 16 * 64;
        const float* sd = a.in[I_SD] + (size_t)l * 512;
        bf16_t* KT = (bf16_t*)(ws + WS_KT); bf16_t* MET = (bf16_t*)(ws + WS_MET); bf16_t* MCT = (bf16_t*)(ws + WS_MCT); float* L64 = (float*)(ws + WS_L64);
        float* s_pw = (float*)lds;
        float* s_f = s_pw + 128;
        float* s_bbr = s_f + 128;
        float* s_bbi = s_bbr + 1024;
        __syncthreads();
        for (int it = blockIdx.x; it < 32 * 65; it += G) {
            const int g = it / 65, j = it % 65;
            if (tid < 64) {
                const int p = tid;
                const double dt = (double)expf(ldt[g]);
                const double ar = (double)are[g * 64 + p], ai = (double)aim[g * 64 + p];
                double pr, pi, l1r, l1i;
                cpow_d(dt * ai, dt * ar, j, pr, pi);
                cpow_d(dt * ai, dt * ar, 1, l1r, l1i);
                const double den = ar * ar + ai * ai;
                const double fr = ((l1r - 1.0) * ar + l1i * ai) / den, fi = (l1i * ar - (l1r - 1.0) * ai) / den;
                s_pw[2 * p] = (float)pr; s_pw[2 * p + 1] = (float)pi; s_f[2 * p] = (float)fr; s_f[2 * p + 1] = (float)fi;
                if (j == 64) { L64[(g * 64 + p) * 2] = (float)pr; L64[(g * 64 + p) * 2 + 1] = (float)pi; }
            }
            __syncthreads();
#pragma unroll
            for (int i = 0; i < 2; ++i) { const int idx = tid + i * 512, p = idx >> 4; const float fr = s_f[2 * p], fi = s_f[2 * p + 1];
                const float br = bre[(size_t)g * 1024 + idx], bi = bim[(size_t)g * 1024 + idx];
                s_bbr[idx] = fr * br - fi * bi; s_bbi[idx] = fr * bi + fi * br; }
            __syncthreads();
            if (j < 64) {
                if (tid < 256) {
                    const int h = tid >> 4, hp = tid & 15; float s = 0.f;
                    for (int p = 0; p < 64; ++p) { const float cr = cre[(size_t)(g * 16 + h) * 64 + p], ci = cim[(size_t)(g * 16 + h) * 64 + p], pr = s_pw[2 * p], pi = s_pw[2 * p + 1];
                        const float wr = cr * pr - ci * pi, wi = cr * pi + ci * pr; s += wr * s_bbr[p * 16 + hp] - wi * s_bbi[p * 16 + hp]; }
                    if (j == 0 && h == hp) s += sd[g * 16 + h];
                    KT[((size_t)(g * 64 + j) * 16 + h) * 16 + hp] = (bf16_t)f2bf(s);
                }
#pragma unroll
                for (int i = 0; i < 2; ++i) { const int idx = tid + i * 512, p = idx >> 4, hp = idx & 15; const float pr = s_pw[2 * p], pi = s_pw[2 * p + 1], br = s_bbr[idx], bi = s_bbi[idx];
                    const int jp = 63 - j;
                    MET[((size_t)(g * 128 + p) * 64 + jp) * 16 + hp] = (bf16_t)f2bf(pr * br - pi * bi);
                    MET[((size_t)(g * 128 + 64 + p) * 64 + jp) * 16 + hp] = (bf16_t)f2bf(pr * bi + pi * br); }
            }
            if (j >= 1) {
                const int sp = j - 1;
#pragma unroll
                for (int i = 0; i < 2; ++i) { const int idx = tid + i * 512, h = idx >> 6, p = idx & 63; const float cr = cre[(size_t)(g * 16 + h) * 64 + p], ci = cim[(size_t)(g * 16 + h) * 64 + p], pr = s_pw[2 * p], pi = s_pw[2 * p + 1];
                    const size_t base = ((size_t)g * 1024 + sp * 16 + h) * 128;
                    MCT[base + p] = (bf16_t)f2bf(cr * pr - ci * pi); MCT[base + 64 + p] = (bf16_t)f2bf(-(cr * pi + ci * pr)); }
            }
            __syncthreads();
        }
    }
    if (l == 0) {
        const float* x = a.in[I_X]; bf16_t* XB = (bf16_t*)(ws + WS_XB); unsigned long long* rss = (unsigned long long*)(ws + WS_RSS);
        for (int row = gw; row < T; row += NGW) {
            const f32x4* xr = (const f32x4*)(x + (size_t)row * DM) + lane; u32x2* o = (u32x2*)(XB + (size_t)row * DM) + lane;
            float ss = 0.f;
#pragma unroll
            for (int i = 0; i < 8; ++i) { const f32x4 v = xr[64 * i]; ss += v[0] * v[0] + v[1] * v[1] + v[2] * v[2] + v[3] * v[3]; u32x2 w; w.x = pk2(v[0], v[1]); w.y = pk2(v[2], v[3]); o[64 * i] = w; }
            ss = wave_sum(ss);
            if (lane == 0) rss[row] = (unsigned long long)(ss * 16777216.f);
        }
        for (int i = blockIdx.x * 512 + tid; i < 6 * T; i += G * 512) rss[T + i] = 0ull;
    }
}

__device__ __forceinline__ void phase_glr(const Args& a, const unsigned long long* rss, int G) {
    const int tid = otid(), lane = tid & 63, wave = tid >> 6, r16 = lane & 15, quad = lane >> 4;
    const int gw = blockIdx.x * 8 + wave, NGW = G * 8;
    const bf16_t* XB = (const bf16_t*)(a.ws + WS_XB); const bf16_t* WGT = (const bf16_t*)(a.ws + WS_WGT); float* GLR = (float*)(a.ws + WS_GLR);
    for (int task = gw; task < T / 16; task += NGW) {
        const int r0 = task * 16;
        f32x4 acc = (f32x4){0.f, 0.f, 0.f, 0.f};
        const bf16_t* ap = XB + (size_t)(r0 + r16) * DM + quad * 8; const bf16_t* bp = WGT + (size_t)r16 * DM + quad * 8;
#pragma unroll 8
        for (int kb = 0; kb < 64; ++kb) acc = mfma16(*(const bf16x8*)(ap + kb * 32), *(const bf16x8*)(bp + kb * 32), acc);
#pragma unroll
        for (int i = 0; i < 4; ++i) { const int row = r0 + quad * 4 + i; GLR[(size_t)row * 16 + r16] = acc[i] * rsqrtf((float)rss[row] * (1.f / (16777216.f * DM)) + EPS); }
    }
}

__device__ __forceinline__ void phase_pool(const Args& a, int G) {
    const bf16_t* Z = (const bf16_t*)(a.ws + WS_Z); bf16_t* Y = (bf16_t*)(a.ws + WS_Y);
    for (int idx = blockIdx.x * 512 + otid(); idx < T * 64; idx += G * 512) {
        const int t = idx >> 6, c0 = (idx & 63) * 8, w = 2 << (c0 >> 7), s = t & (SEQ - 1);
        const int cnt = (s + 1) < w ? (s + 1) : w;
        float sum[8], x0[8];
#pragma unroll
        for (int i = 0; i < 8; ++i) sum[i] = 0.f;
        for (int j = 0; j < cnt; ++j) {
            const u32x4 v = *(const u32x4*)(Z + (size_t)(t - j) * ZW + ZC_POOL + c0);
            const float f[8] = {bflo(v.x), bfhi(v.x), bflo(v.y), bfhi(v.y), bflo(v.z), bfhi(v.z), bflo(v.w), bfhi(v.w)};
#pragma unroll
            for (int i = 0; i < 8; ++i) { sum[i] += f[i]; if (j == 0) x0[i] = f[i]; }
        }
        const float inv = 1.f / (float)cnt;
        u32x4 o; o.x = pk2(sum[0] * inv - x0[0], sum[1] * inv - x0[1]); o.y = pk2(sum[2] * inv - x0[2], sum[3] * inv - x0[3]);
        o.z = pk2(sum[4] * inv - x0[4], sum[5] * inv - x0[5]); o.w = pk2(sum[6] * inv - x0[6], sum[7] * inv - x0[7]);
        *(u32x4*)(Y + (size_t)t * DM + c0) = o;
    }
}

constexpr int OFF_BC = 0, OFF_QP = 32768, OFF_KP = 50176, OFF_OB = 0, OFF_QD = 67584, OFF_VT = 84992, OFF_PB = 121856, OFF_GL = 131072, OFF_TOT = 135168;
constexpr int PQ = 136, PV = 72, POB = 260;

__device__ __forceinline__ void gla_bc(const Args& a, int l, unsigned char* lds, int t0, int h) {
    const int tid = otid(), d = tid & 127, jq = tid >> 7;
    float* BC = (float*)(lds + OFF_BC); float* GL = (float*)(lds + OFF_GL); float* TOT = (float*)(lds + OFF_TOT);
    const float* GLR = (const float*)(a.ws + WS_GLR);
    const float* w2 = a.in[I_GW2] + (size_t)l * 16 * 512; const float* gb = a.in[I_GB] + (size_t)l * 512;
    for (int i = tid; i < 1024; i += 512) GL[i] = GLR[(size_t)t0 * 16 + i];
    float w[16];
#pragma unroll
    for (int r = 0; r < 16; ++r) w[r] = w2[r * 512 + h * 128 + d];
    const float bias = gb[h * 128 + d];
    __syncthreads();
    float run = 0.f;
#pragma unroll 4
    for (int jj = 0; jj < 16; ++jj) {
        const int j = jq * 16 + jj;
        float z = bias;
#pragma unroll
        for (int r = 0; r < 16; ++r) z += GL[j * 16 + r] * w[r];
        const float la = (fminf(z, 0.f) - __logf(1.f + __expf(-fabsf(z)))) * (1.f / 16.f);
        run += la; BC[j * 128 + d] = run;
    }
    TOT[jq * 128 + d] = run;
    __syncthreads();
    float off = 0.f;
    for (int q = 0; q < jq; ++q) off += TOT[q * 128 + d];
    if (jq > 0) {
#pragma unroll 4
        for (int jj = 0; jj < 16; ++jj) BC[(jq * 16 + jj) * 128 + d] += off;
    }
    __syncthreads();
}

__device__ __forceinline__ void gla_kv_unit(const Args& a, int l, unsigned char* lds, int unit) {
    const int tid = otid(), lane = tid & 63, wave = tid >> 6, r16 = lane & 15, quad = lane >> 4;
    const int bh = unit >> 6, n = unit & 63, b = bh >> 2, h = bh & 3, t0 = b * SEQ + n * 64;
    const bf16_t* Z = (const bf16_t*)(a.ws + WS_Z); bf16_t* KV = (bf16_t*)(a.ws + WS_KV); float* DEC = (float*)(a.ws + WS_DEC);
    gla_bc(a, l, lds, t0, h);
    const float* BC = (const float*)(lds + OFF_BC); bf16_t* KTl = (bf16_t*)(lds + OFF_QP); bf16_t* VT = (bf16_t*)(lds + OFF_VT);
    {
        const int d = tid & 127, jq = tid >> 7; const float bl = BC[63 * 128 + d];
#pragma unroll 4
        for (int jj = 0; jj < 16; ++jj) { const int j = jq * 16 + jj; const float kv = bf2f(Z[(size_t)(t0 + j) * ZW + ZC_K + h * 128 + d]);
            KTl[d * PV + j] = (bf16_t)f2bf(kv * __expf(bl - BC[j * 128 + d])); }
        if (jq == 0) DEC[(size_t)unit * 128 + d] = __expf(bl);
        const int v = tid & 255, jh = tid >> 8;
#pragma unroll 4
        for (int jj = 0; jj < 32; ++jj) { const int j = jh * 32 + jj; VT[v * PV + j] = Z[(size_t)(t0 + j) * ZW + ZC_V + h * 256 + v]; }
    }
    __syncthreads();
    f32x4 acc[8][2];
#pragma unroll
    for (int i = 0; i < 8; ++i) { acc[i][0] = (f32x4){0.f, 0.f, 0.f, 0.f}; acc[i][1] = (f32x4){0.f, 0.f, 0.f, 0.f}; }
#pragma unroll
    for (int kb = 0; kb < 2; ++kb) {
        bf16x8 bf[2];
#pragma unroll
        for (int v2 = 0; v2 < 2; ++v2) bf[v2] = *(const bf16x8*)(VT + ((wave * 2 + v2) * 16 + r16) * PV + kb * 32 + quad * 8);
#pragma unroll
        for (int db = 0; db < 8; ++db) { const bf16x8 af = *(const bf16x8*)(KTl + (db * 16 + r16) * PV + kb * 32 + quad * 8);
            acc[db][0] = mfma16(af, bf[0], acc[db][0]); acc[db][1] = mfma16(af, bf[1], acc[db][1]); }
    }
#pragma unroll
    for (int db = 0; db < 8; ++db)
#pragma unroll
        for (int v2 = 0; v2 < 2; ++v2) { const int v = (wave * 2 + v2) * 16 + r16; u32x2 o; o.x = pk2(acc[db][v2][0], acc[db][v2][1]); o.y = pk2(acc[db][v2][2], acc[db][v2][3]);
            *(u32x2*)(KV + ((size_t)unit * 256 + v) * 128 + db * 16 + quad * 4) = o; }
    __syncthreads();
}

__device__ __forceinline__ void gla_scan(const Args& a, int G) {
    bf16_t* KV = (bf16_t*)(a.ws + WS_KV); const float* DEC = (const float*)(a.ws + WS_DEC);
    for (int id = blockIdx.x * 512 + otid(); id < 16 * 256 * 32; id += G * 512) {
        const int bh = id >> 13, v = (id >> 5) & 255, d0 = (id & 31) * 4;
        float s0 = 0.f, s1 = 0.f, s2 = 0.f, s3 = 0.f;
#pragma unroll 8
        for (int n = 0; n < 64; ++n) {
            const int unit = bh * 64 + n;
            u32x2* p = (u32x2*)(KV + ((size_t)unit * 256 + v) * 128 + d0);
            const u32x2 kv = *p; const f32x4 dc = *(const f32x4*)(DEC + (size_t)unit * 128 + d0);
            u32x2 o; o.x = pk2(s0, s1); o.y = pk2(s2, s3); *p = o;
            s0 = dc[0] * s0 + bflo(kv.x); s1 = dc[1] * s1 + bfhi(kv.x); s2 = dc[2] * s2 + bflo(kv.y); s3 = dc[3] * s3 + bfhi(kv.y);
        }
    }
}

__device__ __forceinline__ void gla_out_unit(const Args& a, int l, unsigned char* lds, int unit) {
    const int tid = otid(), lane = tid & 63, wave = tid >> 6, r16 = lane & 15, quad = lane >> 4;
    const int bh = unit >> 6, n = unit & 63, b = bh >> 2, h = bh & 3, t0 = b * SEQ + n * 64;
    const bf16_t* Z = (const bf16_t*)(a.ws + WS_Z); const bf16_t* KV = (const bf16_t*)(a.ws + WS_KV); bf16_t* Y = (bf16_t*)(a.ws + WS_Y);
    gla_bc(a, l, lds, t0, h);
    const float* BC = (const float*)(lds + OFF_BC);
    bf16_t* QP = (bf16_t*)(lds + OFF_QP); bf16_t* KP = (bf16_t*)(lds + OFF_KP); bf16_t* QD = (bf16_t*)(lds + OFF_QD); bf16_t* VT = (bf16_t*)(lds + OFF_VT); bf16_t* PB = (bf16_t*)(lds + OFF_PB);
    float* OB = (float*)(lds + OFF_OB);
    {
        const int d = tid & 127, jq = tid >> 7; const float bm = BC[31 * 128 + d];
#pragma unroll 4
        for (int jj = 0; jj < 16; ++jj) { const int j = jq * 16 + jj; const float bcv = BC[j * 128 + d];
            const float qv = bf2f(Z[(size_t)(t0 + j) * ZW + ZC_Q + h * 128 + d]) * 0.08838834764831845f, kv = bf2f(Z[(size_t)(t0 + j) * ZW + ZC_K + h * 128 + d]);
            QP[j * PQ + d] = (bf16_t)f2bf(qv * __expf(bcv - bm)); KP[j * PQ + d] = (bf16_t)f2bf(kv * __expf(bm - bcv)); QD[j * PQ + d] = (bf16_t)f2bf(qv * __expf(bcv)); }
        const int v = tid & 255, jh = tid >> 8;
#pragma unroll 4
        for (int jj = 0; jj < 32; ++jj) { const int j = jh * 32 + jj; VT[v * PV + j] = Z[(size_t)(t0 + j) * ZW + ZC_V + h * 256 + v]; }
    }
    __syncthreads();
    {
        const int ib = wave >> 1;
#pragma unroll
        for (int jbi = 0; jbi < 2; ++jbi) {
            const int jb = (wave & 1) * 2 + jbi;
            f32x4 sc = (f32x4){0.f, 0.f, 0.f, 0.f};
            if (jb <= ib) {
#pragma unroll
                for (int kb = 0; kb < 4; ++kb) sc = mfma16(*(const bf16x8*)(QP + (ib * 16 + r16) * PQ + kb * 32 + quad * 8), *(const bf16x8*)(KP + (jb * 16 + r16) * PQ + kb * 32 + quad * 8), sc);
            }
#pragma unroll
            for (int i = 0; i < 4; ++i) { const int row = ib * 16 + quad * 4 + i, col = jb * 16 + r16; PB[row * PV + col] = (bf16_t)f2bf(col <= row ? sc[i] : 0.f); }
        }
    }
    __syncthreads();
    f32x4 acc[4][2];
#pragma unroll
    for (int i = 0; i < 4; ++i) { acc[i][0] = (f32x4){0.f, 0.f, 0.f, 0.f}; acc[i][1] = (f32x4){0.f, 0.f, 0.f, 0.f}; }
#pragma unroll
    for (int kb = 0; kb < 2; ++kb) {
        bf16x8 bf[2];
#pragma unroll
        for (int v2 = 0; v2 < 2; ++v2) bf[v2] = *(const bf16x8*)(VT + ((wave * 2 + v2) * 16 + r16) * PV + kb * 32 + quad * 8);
#pragma unroll
        for (int ib = 0; ib < 4; ++ib) { const bf16x8 af = *(const bf16x8*)(PB + (ib * 16 + r16) * PV + kb * 32 + quad * 8);
            acc[ib][0] = mfma16(af, bf[0], acc[ib][0]); acc[ib][1] = mfma16(af, bf[1], acc[ib][1]); }
    }
#pragma unroll
    for (int kb = 0; kb < 4; ++kb) {
        bf16x8 bf[2];
#pragma unroll
        for (int v2 = 0; v2 < 2; ++v2) bf[v2] = *(const bf16x8*)(KV + ((size_t)unit * 256 + (wave * 2 + v2) * 16 + r16) * 128 + kb * 32 + quad * 8);
#pragma unroll
        for (int ib = 0; ib < 4; ++ib) { const bf16x8 af = *(const bf16x8*)(QD + (ib * 16 + r16) * PQ + kb * 32 + quad * 8);
            acc[ib][0] = mfma16(af, bf[0], acc[ib][0]); acc[ib][1] = mfma16(af, bf[1], acc[ib][1]); }
    }
#pragma unroll
    for (int ib = 0; ib < 4; ++ib)
#pragma unroll
        for (int v2 = 0; v2 < 2; ++v2)
#pragma unroll
            for (int i = 0; i < 4; ++i) OB[(ib * 16 + quad * 4 + i) * POB + (wave * 2 + v2) * 16 + r16] = acc[ib][v2][i];
    __syncthreads();
    {
        const float* gn = a.in[I_GNORM] + (size_t)l * 1024 + h * 256 + lane * 4;
        const f32x4 gain = *(const f32x4*)gn;
#pragma unroll 2
        for (int rr = 0; rr < 8; ++rr) {
            const int i = wave * 8 + rr;
            const f32x4 v = *(const f32x4*)(OB + i * POB + lane * 4);
            const float ss = wave_sum(v[0] * v[0] + v[1] * v[1] + v[2] * v[2] + v[3] * v[3]);
            const float rinv = rsqrtf(ss * (1.f / 256.f) + EPS);
            const u32x2 rv = *(const u32x2*)(Z + (size_t)(t0 + i) * ZW + ZC_R + h * 256 + lane * 4);
            const float r0 = bflo(rv.x), r1 = bfhi(rv.x), r2 = bflo(rv.y), r3 = bfhi(rv.y);
            u32x2 o; o.x = pk2(v[0] * rinv * gain[0] * r0 * sigmoid_f(r0), v[1] * rinv * gain[1] * r1 * sigmoid_f(r1));
            o.y = pk2(v[2] * rinv * gain[2] * r2 * sigmoid_f(r2), v[3] * rinv * gain[3] * r3 * sigmoid_f(r3));
            *(u32x2*)(Y + (size_t)(t0 + i) * DM + YC_GLA + h * 256 + lane * 4) = o;
        }
    }
    __syncthreads();
}

__device__ __forceinline__ void ssm_end_unit(const Args& a, int unit) {
    const int tid = otid(), lane = tid & 63, wave = tid >> 6, r16 = lane & 15, quad = lane >> 4;
    const int g = unit >> 2, rb = unit & 3;
    const bf16_t* Z = (const bf16_t*)(a.ws + WS_Z); const bf16_t* MET = (const bf16_t*)(a.ws + WS_MET); float* E = (float*)(a.ws + WS_E);
    const int crow = rb * 64 + (wave & 3) * 16, qg = (wave >> 2) * 64;
    const int ch = (quad & 1) * 8, jo = quad >> 1;
    f32x4 acc[4];
#pragma unroll
    for (int i = 0; i < 4; ++i) acc[i] = (f32x4){0.f, 0.f, 0.f, 0.f};
    const bf16_t* ap = Z + (size_t)((crow + r16) * 64 + jo) * ZW + ZC_S + g * 16 + ch;
    const bf16_t* bp = MET + ((size_t)(g * 128 + qg + r16) * 64 + jo) * 16 + ch;
#pragma unroll 4
    for (int kb = 0; kb < 32; ++kb) {
        const bf16x8 af = *(const bf16x8*)(ap + (size_t)kb * 2 * ZW);
#pragma unroll
        for (int nb = 0; nb < 4; ++nb) acc[nb] = mfma16(af, *(const bf16x8*)(bp + (size_t)nb * 16 * 1024 + kb * 32), acc[nb]);
    }
#pragma unroll
    for (int nb = 0; nb < 4; ++nb)
#pragma unroll
        for (int i = 0; i < 4; ++i) E[((size_t)(crow + quad * 4 + i) * 32 + g) * 128 + qg + nb * 16 + r16] = acc[nb][i];
}
__device__ __forceinline__ void ssm_scan(const Args& a, int id) {
    const int b = id >> 11, g = (id >> 6) & 31, p = id & 63;
    const float* E = (const float*)(a.ws + WS_E); bf16_t* HC = (bf16_t*)(a.ws + WS_HC); const float* L64 = (const float*)(a.ws + WS_L64);
    const float lr = L64[(g * 64 + p) * 2], li = L64[(g * 64 + p) * 2 + 1];
    float hr = 0.f, hi = 0.f;
#pragma unroll 8
    for (int n = 0; n < 64; ++n) {
        const size_t base = ((size_t)(b * 64 + n) * 32 + g) * 128;
        HC[base + p] = (bf16_t)f2bf(hr); HC[base + 64 + p] = (bf16_t)f2bf(hi);
        const float er = E[base + p], ei = E[base + 64 + p];
        const float nr = lr * hr - li * hi + er, ni = lr * hi + li * hr + ei;
        hr = nr; hi = ni;
    }
}
__device__ __forceinline__ void ssm_out_unit(const Args& a, int unit) {
    const int tid = otid(), lane = tid & 63, wave = tid >> 6, r16 = lane & 15, quad = lane >> 4;
    const int g = unit >> 4, cb = unit & 15;
    const bf16_t* Z = (const bf16_t*)(a.ws + WS_Z); const bf16_t* KT = (const bf16_t*)(a.ws + WS_KT); const bf16_t* MCT = (const bf16_t*)(a.ws + WS_MCT);
    const bf16_t* HC = (const bf16_t*)(a.ws + WS_HC); bf16_t* YS = (bf16_t*)(a.ws + WS_YS);
    const int ch = (quad & 1) * 8, jo = quad >> 1;
    f32x4 acc[2][4];
#pragma unroll
    for (int i = 0; i < 2; ++i)
#pragma unroll
        for (int k = 0; k < 4; ++k) acc[i][k] = (f32x4){0.f, 0.f, 0.f, 0.f};
    const int kbn = cb * 2 + 2;
    for (int kb = 0; kb < kbn; ++kb) {
        const int jp = kb * 2 + jo;
        bf16x8 af[2];
#pragma unroll
        for (int rk = 0; rk < 2; ++rk) af[rk] = *(const bf16x8*)(Z + (size_t)((wave * 32 + rk * 16 + r16) * 64 + jp) * ZW + ZC_S + g * 16 + ch);
#pragma unroll
        for (int nb = 0; nb < 4; ++nb) {
            const int sp = cb * 4 + nb, dl = sp - jp;
            if (kb * 2 > sp) continue;
            bf16x8 bf = (bf16x8){0, 0, 0, 0, 0, 0, 0, 0};
            if (dl >= 0) bf = *(const bf16x8*)(KT + ((size_t)(g * 64 + dl) * 16 + r16) * 16 + ch);
            acc[0][nb] = mfma16(af[0], bf, acc[0][nb]); acc[1][nb] = mfma16(af[1], bf, acc[1][nb]);
        }
    }
#pragma unroll
    for (int kb = 0; kb < 4; ++kb) {
        bf16x8 af[2];
#pragma unroll
        for (int rk = 0; rk < 2; ++rk) af[rk] = *(const bf16x8*)(HC + ((size_t)(wave * 32 + rk * 16 + r16) * 32 + g) * 128 + kb * 32 + quad * 8);
#pragma unroll
        for (int nb = 0; nb < 4; ++nb) { const bf16x8 bf = *(const bf16x8*)(MCT + ((size_t)g * 1024 + (cb * 4 + nb) * 16 + r16) * 128 + kb * 32 + quad * 8);
            acc[0][nb] = mfma16(af[0], bf, acc[0][nb]); acc[1][nb] = mfma16(af[1], bf, acc[1][nb]); }
    }
#pragma unroll
    for (int rk = 0; rk < 2; ++rk)
#pragma unroll
        for (int nb = 0; nb < 4; ++nb)
#pragma unroll
            for (int i = 0; i < 4; ++i) { const int chunk = wave * 32 + rk * 16 + quad * 4 + i, t = chunk * 64 + cb * 4 + nb;
                YS[(size_t)t * 512 + g * 16 + r16] = (bf16_t)f2bf(gelu_tanh_f(acc[rk][nb][i])); }
}

__device__ __forceinline__ void phase_final(const Args& a, int G) {
    const int tid = otid(), lane = tid & 63, wave = tid >> 6;
    const int gw = blockIdx.x * 8 + wave, NGW = G * 8;
    const unsigned long long* rss = (const unsigned long long*)(a.ws + WS_RSS) + (size_t)6 * T; const float* gf = a.in[I_FINN];
    for (int row = gw; row < T; row += NGW) {
        const float rinv = rsqrtf((float)rss[row] * (1.f / (16777216.f * DM)) + EPS);
        f32x4* xr = (f32x4*)(a.out + (size_t)row * DM) + lane; const f32x4* gr = (const f32x4*)gf + lane;
#pragma unroll
        for (int i = 0; i < 8; ++i) { f32x4 v = xr[64 * i]; const f32x4 gg = gr[64 * i]; v = v * rinv * gg; xr[64 * i] = v; }
    }
}

constexpr int PH_PER_LAYER = 12, N_PHASES = 2 * PH_PER_LAYER + 1;

__global__ void __launch_bounds__(512, 2) mega_fwd(Args a) {
    extern __shared__ __attribute__((aligned(16))) unsigned char lds[];
    cg::grid_group grid = cg::this_grid();
    const int G = gridDim.x;
    unsigned char* ws = a.ws;
    LAS unsigned char* ldsl = (LAS unsigned char*)lds;
    unsigned long long* rssb = (unsigned long long*)(ws + WS_RSS);
    for (int ph = a.ph_lo; ph < a.ph_hi; ++ph) {
        if (ph != a.ph_lo) {
            __builtin_amdgcn_fence(__ATOMIC_RELEASE, "agent");
            asm volatile("s_waitcnt vmcnt(0)" ::: "memory");
            grid.sync();
            __builtin_amdgcn_fence(__ATOMIC_ACQUIRE, "agent");
            asm volatile("s_waitcnt vmcnt(0)" ::: "memory");
        }
        if (ph == N_PHASES - 1) { phase_final(a, G); continue; }
        const int l = ph / PH_PER_LAYER, k = ph % PH_PER_LAYER;
        if (k == 0) {
#ifndef NO_PREP
            phase_prep(a, l, lds, G);
#endif
        } else if (k == 1 || k == 10) {
            const int second = (k == 10);
            pg8::Gemm g{(const bf16_t*)(ws + WS_XB), (const bf16_t*)(ws + (second ? WS_W2U : WS_W1U)), T, 2 * FF, DM, DM, DM};
            pg8::StaticOrder S; S.init(T, 2 * FF, G, (int)blockIdx.x);
            pg8::EpiFfnUp E{(bf16_t*)(ws + WS_Z), rssb + (size_t)(3 * l + (second ? 2 : 0)) * T};
            pg8::gemm_phase(ldsl, g, S, E);
        } else if (k == 2 || k == 11) {
            const int second = (k == 11);
            pg8::Gemm g{(const bf16_t*)(ws + WS_Z), (const bf16_t*)(ws + (second ? WS_W2D : WS_W1D)), T, DM, FF, FF, FF};
            pg8::StaticOrder S; S.init(T, DM, G, (int)blockIdx.x);
            const float* xin = (l == 0 && !second) ? a.in[I_X] : a.out;
            pg8::EpiResid E{xin, a.out, (bf16_t*)(ws + WS_XB), rssb + (size_t)(3 * l + (second ? 3 : 1)) * T, 0.5f};
            pg8::gemm_phase(ldsl, g, S, E);
        } else if (k == 3) {
            pg8::Gemm g{(const bf16_t*)(ws + WS_XB), (const bf16_t*)(ws + WS_WIN), T, ZW, DM, DM, DM};
            pg8::StaticOrder S; S.init(T, ZW, G, (int)blockIdx.x);
            pg8::EpiWin E{(bf16_t*)(ws + WS_Z), rssb + (size_t)(3 * l + 1) * T};
            pg8::gemm_phase(ldsl, g, S, E);
#ifndef NO_GLR
            phase_glr(a, rssb + (size_t)(3 * l + 1) * T, G);
#endif
        } else if (k == 4) {
#ifndef NO_GLA
            for (int u = blockIdx.x; u < 1024; u += G) gla_kv_unit(a, l, lds, u);
#endif
#ifndef NO_SSM
            for (int u = G - 1 - (int)blockIdx.x; u < 128; u += G) ssm_end_unit(a, u);
#endif
#ifndef NO_POOL
            phase_pool(a, G);
#endif
        } else if (k == 5) {
#ifndef NO_GLA
            gla_scan(a, G);
#endif
#ifndef NO_SSM
            { const int id = (G - 1 - (int)blockIdx.x) * 512 + otid(); if (id < 8192) ssm_scan(a, id); }
#endif
        } else if (k == 6) {
#ifndef NO_GLA
            for (int u = blockIdx.x; u < 1024; u += G) gla_out_unit(a, l, lds, u);
#endif
#ifndef NO_SSM
            for (int u = blockIdx.x; u < 512; u += G) ssm_out_unit(a, u);
#endif
        } else if (k == 7) {
            pg8::Gemm g{(const bf16_t*)(ws + WS_YS), (const bf16_t*)(ws + WS_WGLU), T, 512, 512, 512, 512};
            pg8::StaticOrder S; S.init(T, 512, G, (int)blockIdx.x);
            pg8::EpiGlu E{(const bf16_t*)(ws + WS_YS), (bf16_t*)(ws + WS_Y)};
            pg8::gemm_phase(ldsl, g, S, E);
        } else if (k == 8) {
            const bf16_t* Y = (const bf16_t*)(ws + WS_Y); const bf16_t* Wb = (const bf16_t*)(ws + WS_WBR); const bf16_t* Zg = (const bf16_t*)(ws + WS_Z) + ZC_G;
            pg8::StaticOrder S; S.init(T, DM, G, (int)blockIdx.x);
            { pg8::Gemm g{Y, Wb, T, DM, 512, DM, DM}; pg8::EpiBranch E{Zg, (bf16_t*)(ws + WS_MB), 0}; pg8::gemm_phase(ldsl, g, S, E); }
            { pg8::Gemm g{Y + 512, Wb + 512, T, DM, 1024, DM, DM}; pg8::EpiBranch E{Zg + 2048, (bf16_t*)(ws + WS_MB), 1}; pg8::gemm_phase(ldsl, g, S, E); }
            { pg8::Gemm g{Y + 1536, Wb + 1536, T, DM, 512, DM, DM}; pg8::EpiBranch E{Zg + 4096, (bf16_t*)(ws + WS_MB), 1}; pg8::gemm_phase(ldsl, g, S, E); }
        } else if (k == 9) {
            pg8::Gemm g{(const bf16_t*)(ws + WS_MB), (const bf16_t*)(ws + WS_WO), T, DM, DM, DM, DM};
            pg8::StaticOrder S; S.init(T, DM, G, (int)blockIdx.x);
            pg8::EpiResid E{a.out, a.out, (bf16_t*)(ws + WS_XB), rssb + (size_t)(3 * l + 2) * T, 1.0f};
            pg8::gemm_phase(ldsl, g, S, E);
        }
    }
}

extern "C" void kernel_launch(void* const* d_in, const int* in_sizes, int n_in, void* d_out, int out_size, void* d_ws, size_t ws_size, hipStream_t stream) {
    static int grid = 0;
    if (grid == 0) {
        if (n_in != 28 || in_sizes[0] != T * DM || out_size != T * DM || ws_size < WS_END) {
            fprintf(stderr, "kernel_launch: unexpected problem (n_in %d, in0 %d, out %d, ws %zu, need %zu)\n", n_in, n_in > 0 ? in_sizes[0] : -1, out_size, ws_size, (size_t)WS_END);
            grid = -1; return;
        }
        int dev = 0, cus = 0, per_cu = 0;
        hipGetDevice(&dev);
        hipDeviceGetAttribute(&cus, hipDeviceAttributeMultiprocessorCount, dev);
        hipFuncSetAttribute((const void*)mega_fwd, hipFuncAttributeMaxDynamicSharedMemorySize, LDS_BYTES);
        hipOccupancyMaxActiveBlocksPerMultiprocessor(&per_cu, (const void*)mega_fwd, 512, LDS_BYTES);
        if (per_cu < 1) per_cu = 1;
        if (per_cu > 1) per_cu = 1;
        grid = cus * per_cu;
        (void)hipGetLastError();
    }
    if (grid < 0) return;
    Args a{};
    for (int i = 0; i < 28; ++i) a.in[i] = (const float*)d_in[i];
    a.out = (float*)d_out; a.ws = (unsigned char*)d_ws;
#if MK_MULTI_LAUNCH
    for (int ph = 0; ph < N_PHASES; ++ph) {
        a.ph_lo = ph; a.ph_hi = ph + 1;
        hipLaunchKernelGGL(mega_fwd, dim3(grid), dim3(512), LDS_BYTES, stream, a);
    }
#else
    a.ph_lo = 0; a.ph_hi = N_PHASES;
    void* args[] = {&a};
    hipError_t e = hipLaunchCooperativeKernel((const void*)mega_fwd, dim3(grid), dim3(512), args, LDS_BYTES, stream);
    if (e != hipSuccess) fprintf(stderr, "cooperative launch failed: %s (grid %d)\n", hipGetErrorString(e), grid);
#endif
}
```

```cpp
#include <hip/hip_runtime.h>
#include <hip/hip_cooperative_groups.h>
#include <cstdio>
#include <cstdint>
namespace cg = cooperative_groups;

#ifndef MK_MULTI_LAUNCH
#define MK_MULTI_LAUNCH 0
#endif

#define LAS __attribute__((address_space(3)))
typedef unsigned short bf16_t;
typedef short bf16x8 __attribute__((ext_vector_type(8)));
typedef float f32x4 __attribute__((ext_vector_type(4)));
typedef unsigned u32x4 __attribute__((ext_vector_type(4)));
typedef unsigned u32x2 __attribute__((ext_vector_type(2)));

constexpr int T = 16384, DM = 2048, FF = 5632, SEQ = 4096;
constexpr int ZW = 10240;
constexpr int ZC_POOL = 0, ZC_Q = 512, ZC_K = 1024, ZC_V = 1536, ZC_R = 2560, ZC_S = 3584, ZC_G = 4096;
constexpr int YC_GLA = 512, YC_SSM = 1536;
constexpr int INW = 10256;
constexpr float EPS = 1e-6f;

constexpr size_t MiB = 1u << 20;
constexpr size_t WS_RSS = 0;
constexpr size_t WS_BAR = 917504;
constexpr size_t WS_WGT = 1 * MiB;
constexpr size_t WS_L64 = 1 * MiB + 131072;
constexpr size_t WS_GLR = 2 * MiB;
constexpr size_t WS_DEC = 3 * MiB;
constexpr size_t WS_KT = 4 * MiB;
constexpr size_t WS_E = 5 * MiB;
constexpr size_t WS_HC = 9 * MiB;
constexpr size_t WS_MET = 11 * MiB;
constexpr size_t WS_MCT = 19 * MiB;
constexpr size_t WS_YS = 27 * MiB;
constexpr size_t WS_W1U = 43 * MiB, WS_W1D = 87 * MiB, WS_WIN = 109 * MiB, WS_WBR = 149 * MiB, WS_WO = 157 * MiB, WS_WGLU = 165 * MiB;
constexpr size_t WS_W2U = 166 * MiB, WS_W2D = 210 * MiB;
constexpr size_t WS_XB = 232 * MiB, WS_Y = 296 * MiB, WS_MB = 360 * MiB, WS_KV = 424 * MiB, WS_Z = 488 * MiB, WS_END = 808 * MiB;

constexpr int LDS_BYTES = 147456;

__device__ __forceinline__ unsigned f2bf(float f) { unsigned u = __float_as_uint(f); return (u + 0x7fffu + ((u >> 16) & 1u)) >> 16; }
__device__ __forceinline__ float bf2f(unsigned short b) { return __uint_as_float(((unsigned)b) << 16); }
__device__ __forceinline__ unsigned pk2(float lo, float hi) { return f2bf(lo) | (f2bf(hi) << 16); }
__device__ __forceinline__ float bflo(unsigned w) { return __uint_as_float(w << 16); }
__device__ __forceinline__ float bfhi(unsigned w) { return __uint_as_float(w & 0xffff0000u); }
__device__ __forceinline__ float wave_sum(float v) {
#pragma unroll
    for (int o = 1; o < 64; o <<= 1) v += __shfl_xor(v, o);
    return v;
}
__device__ __forceinline__ float sigmoid_f(float x) { return __builtin_amdgcn_rcpf(1.f + __expf(-x)); }
__device__ __forceinline__ float gelu_tanh_f(float x) {
    const float u = 0.7978845608028654f * (x + 0.044715f * x * x * x);
    const float t = 1.f - 2.f * __builtin_amdgcn_rcpf(1.f + __expf(2.f * u));
    return 0.5f * x * (1.f + t);
}
#define LDS_WAIT() asm volatile("s_waitcnt lgkmcnt(0)" ::: "memory")
__device__ __forceinline__ int otid() { int t = threadIdx.x; asm volatile("" : "+v"(t)); return t; }
__device__ __forceinline__ f32x4 mfma16(bf16x8 a, bf16x8 b, f32x4 c) { return __builtin_amdgcn_mfma_f32_16x16x32_bf16(a, b, c, 0, 0, 0); }

namespace pg8 {
constexpr int BM = 256, BK = 64, HALF = 128, HTB = HALF * BK * 2, STAGE_BYTES = 8 * HTB, NXCD = 8, WGM = 8;
__host__ __device__ __forceinline__ int lds_byte(int r, int c) { const int st = (r >> 4) * 2 + (c >> 5), rr = r & 15, cc = c & 31, ob = rr * 64 + cc * 2; return st * 1024 + (ob ^ (((ob >> 9) & 1) << 5)); }
__host__ __device__ __forceinline__ void stage_rc(int b, int& R, int& C) { const int st = b / 1024, sb = b % 1024, swz = sb ^ (((sb >> 9) & 1) << 5); R = (st >> 1) * 16 + swz / 64; C = (st & 1) * 32 + (swz % 64) / 2; }
__host__ __device__ __forceinline__ int perm32(int rho) { const int n = rho >> 4, i = rho & 15; return 8 * (i >> 2) + 4 * n + (i & 3); }

struct Unit { int pm, pn; };
struct Gemm { const bf16_t* A; const bf16_t* Bt; int M, N, K, lda, ldb; };

struct StaticOrder {
    int nM, nN, nwg, G, c;
    __device__ void init(int M, int N, int G_, int c_) { nM = M / BM; nN = N / BM; nwg = nM * nN; G = G_; c = c_; }
    __device__ bool next(int i, Unit& u) const {
        const long L = (long)i * G + c; if (L >= nwg) return false;
        int wgid = (int)L; { const int q = nwg / NXCD, r = nwg % NXCD, xcd = wgid % NXCD, off = wgid / NXCD; wgid = (xcd < r ? xcd * (q + 1) : r * (q + 1) + (xcd - r) * q) + off; }
        const int nig = WGM * nN, gid = wgid / nig, fm = gid * WGM, gsz = (nM - fm) < WGM ? (nM - fm) : WGM;
        u.pm = fm + ((wgid % nig) % gsz); u.pn = (wgid % nig) / gsz; return true;
    }
};

template <class Epi>
__device__ __forceinline__ void gemm_phase(LAS unsigned char* lds, const Gemm g, const StaticOrder& S, const Epi& E) {
    const int tid = otid(), wid = __builtin_amdgcn_readfirstlane(tid >> 6), lane = tid & 63, wr = wid >> 2, wc = wid & 3, fr = lane & 15, fq = lane >> 4;
    const int nt = g.K / BK;
    unsigned voffA[2], voffB[2];
#pragma unroll
    for (int i = 0; i < 2; ++i) { int R, C; stage_rc(tid * 16 + i * 8192, R, C); const int Rb = (R & ~31) + perm32(R & 31);
        voffA[i] = (unsigned)(R * g.lda + C) * 2u; voffB[i] = (unsigned)(Rb * g.ldb + C) * 2u; }
    const size_t kstep = (size_t)(BK * 2);
    const size_t hstepA = (size_t)HALF * g.lda * 2, hstepB = (size_t)HALF * g.ldb * 2;
    const size_t tstepA = 2 * hstepA, tstepB = 2 * hstepB;
    const unsigned ldsw = (unsigned)wid * 1024u;
    const int aoff = lds_byte(wr * 64 + fr, fq * 8), boff = lds_byte(wc * 32 + fr, fq * 8);
#define PG8_SA(b, h) (((b) * 2 + (h)) * HTB)
#define PG8_SB(b, h) ((4 + (b) * 2 + (h)) * HTB)
#define PG8_STAGE(bufoff, gbase, voff) do { _Pragma("unroll") for (int _i = 0; _i < 2; ++_i) \
        __builtin_amdgcn_global_load_lds((const unsigned*)((const char*)(gbase) + (voff)[_i]), (LAS unsigned*)(lds + (bufoff) + ldsw + _i * 8192), 16, 0, 0); } while (0)
#define PG8_LDA(dst, b, h) do { _Pragma("unroll") for (int m = 0; m < 4; ++m) _Pragma("unroll") for (int k = 0; k < 2; ++k) dst[m][k] = *(const LAS bf16x8*)(lds + PG8_SA(b, h) + aoff + m * 2048 + k * 1024); } while (0)
#define PG8_LDB(dst, b, h) do { _Pragma("unroll") for (int n = 0; n < 2; ++n) _Pragma("unroll") for (int k = 0; k < 2; ++k) dst[n][k] = *(const LAS bf16x8*)(lds + PG8_SB(b, h) + boff + n * 2048 + k * 1024); } while (0)
#define PG8_MMA(ai, bj, At, Bt) do { __builtin_amdgcn_s_setprio(1); _Pragma("unroll") for (int m = 0; m < 4; ++m) _Pragma("unroll") for (int n = 0; n < 2; ++n) _Pragma("unroll") for (int k = 0; k < 2; ++k) \
        acc[ai][bj][m][n] = __builtin_amdgcn_mfma_f32_16x16x32_bf16(Bt[n][k], At[m][k], acc[ai][bj][m][n], 0, 0, 0); __builtin_amdgcn_s_setprio(0); } while (0)
#define PG8_WAIT_V(n) asm volatile("s_waitcnt vmcnt(" #n ")" ::: "memory")
#define PG8_WAIT_L(n) asm volatile("s_waitcnt lgkmcnt(" #n ")" ::: "memory")
#define PG8_BAR __builtin_amdgcn_s_barrier()
#define PG8_SCHED __builtin_amdgcn_sched_barrier(0)
    Unit cur, nxt; int ui = 0;
    if (!S.next(0, cur)) return;
    f32x4 acc[2][2][4][2];
#pragma unroll
    for (int a = 0; a < 2; ++a)
#pragma unroll
        for (int b = 0; b < 2; ++b)
#pragma unroll
            for (int m = 0; m < 4; ++m)
#pragma unroll
                for (int n = 0; n < 2; ++n) acc[a][b][m][n] = (f32x4){0.f, 0.f, 0.f, 0.f};
    bf16x8 At[4][2], B0[2][2], B1[2][2];
    const char* cA = (const char*)g.A + (size_t)cur.pm * tstepA; const char* cB = (const char*)g.Bt + (size_t)cur.pn * tstepB;
    PG8_STAGE(PG8_SB(0, 0), cB, voffB); PG8_STAGE(PG8_SB(0, 1), cB + hstepB, voffB); PG8_STAGE(PG8_SA(0, 0), cA, voffA); PG8_STAGE(PG8_SA(0, 1), cA + hstepA, voffA);
    if (wr == 1) PG8_BAR;
    PG8_WAIT_V(2); PG8_BAR;
    PG8_STAGE(PG8_SB(1, 0), cB + kstep, voffB); PG8_STAGE(PG8_SA(1, 0), cA + kstep, voffA); PG8_STAGE(PG8_SB(1, 1), cB + hstepB + kstep, voffB);
    PG8_WAIT_V(6); PG8_BAR;
    for (;;) {
        const bool has_next = S.next(ui + 1, nxt);
        const char* nA = has_next ? (const char*)g.A + (size_t)nxt.pm * tstepA : cA; const char* nB = has_next ? (const char*)g.Bt + (size_t)nxt.pn * tstepB : cB;
        for (int t = 0; t < nt; t += 2) {
            const bool last = (t == nt - 2);
            const char* a1 = cA + (size_t)(t + 1) * kstep;
            const char* a2 = last ? nA : cA + (size_t)(t + 2) * kstep; const char* b2 = last ? nB : cB + (size_t)(t + 2) * kstep;
            const char* a3 = a2 + kstep; const char* b3 = b2 + kstep;
            PG8_LDB(B0, 0, 0); PG8_LDB(B1, 0, 1); PG8_SCHED; PG8_LDA(At, 0, 0); PG8_STAGE(PG8_SA(1, 1), a1 + hstepA, voffA);
            PG8_WAIT_V(8); PG8_WAIT_L(0); PG8_BAR; PG8_MMA(0, 0, At, B0); PG8_MMA(0, 1, At, B1); PG8_BAR; PG8_SCHED;
            PG8_LDA(At, 0, 1); PG8_STAGE(PG8_SB(0, 0), b2, voffB); PG8_STAGE(PG8_SB(0, 1), b2 + hstepB, voffB); PG8_STAGE(PG8_SA(0, 0), a2, voffA);
            PG8_WAIT_V(8); PG8_WAIT_L(0); PG8_BAR; PG8_MMA(1, 0, At, B0); PG8_MMA(1, 1, At, B1); PG8_BAR; PG8_SCHED;
            PG8_LDB(B0, 1, 0); PG8_LDB(B1, 1, 1); PG8_SCHED; PG8_LDA(At, 1, 0); PG8_STAGE(PG8_SA(0, 1), a2 + hstepA, voffA);
            PG8_WAIT_V(8); PG8_WAIT_L(0); PG8_BAR; PG8_MMA(0, 0, At, B0); PG8_MMA(0, 1, At, B1); PG8_BAR; PG8_SCHED;
            PG8_LDA(At, 1, 1); PG8_STAGE(PG8_SB(1, 0), b3, voffB); PG8_STAGE(PG8_SB(1, 1), b3 + hstepB, voffB); PG8_STAGE(PG8_SA(1, 0), a3, voffA);
            PG8_WAIT_V(8); PG8_WAIT_L(0); PG8_BAR; PG8_MMA(1, 0, At, B0); PG8_MMA(1, 1, At, B1); PG8_BAR; PG8_SCHED;
        }
        if (wr == 0) PG8_BAR;
        E(acc, cur, wr, wc, fr, fq);
        if (!has_next) break;
#pragma unroll
        for (int a = 0; a < 2; ++a)
#pragma unroll
            for (int b = 0; b < 2; ++b)
#pragma unroll
                for (int m = 0; m < 4; ++m)
#pragma unroll
                    for (int n = 0; n < 2; ++n) acc[a][b][m][n] = (f32x4){0.f, 0.f, 0.f, 0.f};
        cur = nxt; cA = nA; cB = nB; ++ui;
        if (wr == 1) PG8_BAR;
    }
    PG8_WAIT_V(0);
    PG8_BAR;
#undef PG8_SA
#undef PG8_SB
#undef PG8_STAGE
#undef PG8_LDA
#undef PG8_LDB
#undef PG8_MMA
#undef PG8_WAIT_V
#undef PG8_WAIT_L
#undef PG8_BAR
#undef PG8_SCHED
}

typedef const f32x4 (&AccRef)[2][2][4][2];

struct EpiFfnUp {
    bf16_t* H; const unsigned long long* rss;
    __device__ __forceinline__ void operator()(AccRef acc, const Unit& u, int wr, int wc, int fr, int fq) const {
        const int row0 = u.pm * BM + wr * 64 + fr, col0 = u.pn * 128 + wc * 32 + 8 * fq;
#pragma unroll
        for (int ai = 0; ai < 2; ++ai)
#pragma unroll
            for (int m = 0; m < 4; ++m) {
                const int row = row0 + ai * HALF + m * 16;
                const float rinv = rsqrtf((float)rss[row] * (1.f / (16777216.f * DM)) + EPS);
                float h[8];
#pragma unroll
                for (int n = 0; n < 2; ++n)
#pragma unroll
                    for (int j = 0; j < 4; ++j) { const float gg = acc[ai][0][m][n][j] * rinv, uu = acc[ai][1][m][n][j] * rinv; h[n * 4 + j] = gg * uu * sigmoid_f(gg); }
                u32x4 o; o.x = pk2(h[0], h[1]); o.y = pk2(h[2], h[3]); o.z = pk2(h[4], h[5]); o.w = pk2(h[6], h[7]);
                *(u32x4*)(H + (size_t)row * FF + col0) = o;
            }
    }
};
struct EpiWin {
    bf16_t* Z; const unsigned long long* rss;
    __device__ __forceinline__ void operator()(AccRef acc, const Unit& u, int wr, int wc, int fr, int fq) const {
        const int row0 = u.pm * BM + wr * 64 + fr, col0 = u.pn * BM + wc * 32 + 8 * fq;
        const bool sg = u.pn >= 16;
#pragma unroll
        for (int ai = 0; ai < 2; ++ai)
#pragma unroll
            for (int m = 0; m < 4; ++m) {
                const int row = row0 + ai * HALF + m * 16;
                const float rinv = rsqrtf((float)rss[row] * (1.f / (16777216.f * DM)) + EPS);
#pragma unroll
                for (int bj = 0; bj < 2; ++bj) {
                    float h[8];
#pragma unroll
                    for (int n = 0; n < 2; ++n)
#pragma unroll
                        for (int j = 0; j < 4; ++j) { const float v = acc[ai][bj][m][n][j] * rinv; h[n * 4 + j] = sg ? sigmoid_f(v) : v; }
                    u32x4 o; o.x = pk2(h[0], h[1]); o.y = pk2(h[2], h[3]); o.z = pk2(h[4], h[5]); o.w = pk2(h[6], h[7]);
                    *(u32x4*)(Z + (size_t)row * ZW + col0 + bj * HALF) = o;
                }
            }
    }
};
struct EpiResid {
    const float* xin; float* xout; bf16_t* XB; unsigned long long* rssn; float scale;
    __device__ __forceinline__ void operator()(AccRef acc, const Unit& u, int wr, int wc, int fr, int fq) const {
        const int row0 = u.pm * BM + wr * 64 + fr, col0 = u.pn * BM + wc * 32 + 8 * fq;
#pragma unroll
        for (int ai = 0; ai < 2; ++ai)
#pragma unroll
            for (int m = 0; m < 4; ++m) {
                const int row = row0 + ai * HALF + m * 16;
                float ss = 0.f;
#pragma unroll
                for (int bj = 0; bj < 2; ++bj) {
                    const size_t off = (size_t)row * DM + col0 + bj * HALF;
                    f32x4 x0 = *(const f32x4*)(xin + off), x1 = *(const f32x4*)(xin + off + 4);
                    x0 = x0 + acc[ai][bj][m][0] * scale; x1 = x1 + acc[ai][bj][m][1] * scale;
                    *(f32x4*)(xout + off) = x0; *(f32x4*)(xout + off + 4) = x1;
                    u32x4 o; o.x = pk2(x0[0], x0[1]); o.y = pk2(x0[2], x0[3]); o.z = pk2(x1[0], x1[1]); o.w = pk2(x1[2], x1[3]);
                    *(u32x4*)(XB + off) = o;
                    ss += x0[0] * x0[0] + x0[1] * x0[1] + x0[2] * x0[2] + x0[3] * x0[3] + x1[0] * x1[0] + x1[1] * x1[1] + x1[2] * x1[2] + x1[3] * x1[3];
                }
                ss += __shfl_xor(ss, 16); ss += __shfl_xor(ss, 32);
                if (fq == 0) atomicAdd(rssn + row, (unsigned long long)(ss * 16777216.f));
            }
    }
};
struct EpiBranch {
    const bf16_t* G; bf16_t* MB; int accum;
    __device__ __forceinline__ void operator()(AccRef acc, const Unit& u, int wr, int wc, int fr, int fq) const {
        const int row0 = u.pm * BM + wr * 64 + fr, col0 = u.pn * BM + wc * 32 + 8 * fq;
#pragma unroll
        for (int ai = 0; ai < 2; ++ai)
#pragma unroll
            for (int m = 0; m < 4; ++m) {
                const int row = row0 + ai * HALF + m * 16;
#pragma unroll
                for (int bj = 0; bj < 2; ++bj) {
                    const int col = col0 + bj * HALF;
                    const u32x4 gv = *(const u32x4*)(G + (size_t)row * ZW + col);
                    u32x4 pv = (u32x4){0u, 0u, 0u, 0u};
                    if (accum) pv = *(const u32x4*)(MB + (size_t)row * DM + col);
                    const f32x4 a0 = acc[ai][bj][m][0], a1 = acc[ai][bj][m][1];
                    u32x4 o;
                    o.x = pk2(bflo(pv.x) + bflo(gv.x) * a0[0], bfhi(pv.x) + bfhi(gv.x) * a0[1]);
                    o.y = pk2(bflo(pv.y) + bflo(gv.y) * a0[2], bfhi(pv.y) + bfhi(gv.y) * a0[3]);
                    o.z = pk2(bflo(pv.z) + bflo(gv.z) * a1[0], bfhi(pv.z) + bfhi(gv.z) * a1[1]);
                    o.w = pk2(bflo(pv.w) + bflo(gv.w) * a1[2], bfhi(pv.w) + bfhi(gv.w) * a1[3]);
                    *(u32x4*)(MB + (size_t)row * DM + col) = o;
                }
            }
    }
};
struct EpiGlu {
    const bf16_t* YS; bf16_t* Y;
    __device__ __forceinline__ void operator()(AccRef acc, const Unit& u, int wr, int wc, int fr, int fq) const {
        const int row0 = u.pm * BM + wr * 64 + fr, col0 = u.pn * BM + wc * 32 + 8 * fq;
#pragma unroll
        for (int ai = 0; ai < 2; ++ai)
#pragma unroll
            for (int m = 0; m < 4; ++m) {
                const int row = row0 + ai * HALF + m * 16;
#pragma unroll
                for (int bj = 0; bj < 2; ++bj) {
                    const int col = col0 + bj * HALF;
                    const u32x4 yv = *(const u32x4*)(YS + (size_t)row * 512 + col);
                    const f32x4 a0 = acc[ai][bj][m][0], a1 = acc[ai][bj][m][1];
                    u32x4 o;
                    o.x = pk2(bflo(yv.x) * sigmoid_f(a0[0]), bfhi(yv.x) * sigmoid_f(a0[1]));
                    o.y = pk2(bflo(yv.y) * sigmoid_f(a0[2]), bfhi(yv.y) * sigmoid_f(a0[3]));
                    o.z = pk2(bflo(yv.z) * sigmoid_f(a1[0]), bfhi(yv.z) * sigmoid_f(a1[1]));
                    o.w = pk2(bflo(yv.w) * sigmoid_f(a1[2]), bfhi(yv.w) * sigmoid_f(a1[3]));
                    *(u32x4*)(Y + (size_t)row * DM + YC_SSM + col) = o;
                }
            }
    }
};
}

struct Args { const float* in[28]; float* out; unsigned char* ws; int ph_lo, ph_hi; };
enum { I_X = 0, I_F1N, I_F1G, I_F1U, I_F1D, I_MIXN, I_WIN, I_POOLW, I_POOLS, I_GW2, I_GB, I_GNORM, I_ARE, I_AIM, I_LDT, I_BRE, I_BIM, I_CRE, I_CIM,
       I_SD, I_WGLU, I_WBR, I_WOUT, I_F2N, I_F2G, I_F2U, I_F2D, I_FINN };

__device__ __forceinline__ void tr_item(const float* W, int ldw, int col0, const float* ksc, bf16_t* WT, int ldt, int drow, int k0, int n0, float* scr, int lane) {
#pragma unroll 8
    for (int i = 0; i < 32; ++i) { const int kk = 2 * i + (lane >> 5); float v = W[(size_t)(k0 + kk) * ldw + col0 + n0 + (lane & 31)]; if (ksc) v *= ksc[k0 + kk]; scr[kk * 33 + (lane & 31)] = v; }
    LDS_WAIT();
    const int c = lane & 7;
#pragma unroll
    for (int j = 0; j < 4; ++j) { const int n = (lane >> 3) + 8 * j; const float* s = scr + (8 * c) * 33 + n;
        u32x4 o; o.x = pk2(s[0 * 33], s[1 * 33]); o.y = pk2(s[2 * 33], s[3 * 33]); o.z = pk2(s[4 * 33], s[5 * 33]); o.w = pk2(s[6 * 33], s[7 * 33]);
        *(u32x4*)(WT + (size_t)(drow + n) * ldt + k0 + 8 * c) = o; }
    LDS_WAIT();
}
__device__ __forceinline__ bool tr_try(int& r, const float* W, int ldw, int K, int N, int col0, const float* ksc, bf16_t* WT, int ldt, int drow0, int mode, float* scr, int lane) {
    const int nblk = N / 32, items = (K / 64) * nblk;
    if (r >= items) { r -= items; return false; }
    const int kb = r / nblk, n0 = (r % nblk) * 32;
    const int drow = drow0 + (mode ? ((n0 >> 7) * 256 + (n0 & 127)) : n0);
    tr_item(W, ldw, col0, ksc, WT, ldt, drow, kb * 64, n0, scr, lane);
    return true;
}

__device__ __forceinline__ void cpow_d(double th, double la, int j, double& pr, double& pi) {
    const double y = th * (double)j;
    const double kq = __builtin_rint(y * 0.63661977236758134308);
    double r = __builtin_fma(-kq, 1.57079632679489655800, y); r = __builtin_fma(-kq, 6.12323399573676603587e-17, r);
    const double r2 = r * r;
    double s = 1.0 - r2 / 272.0; s = 1.0 - r2 / 210.0 * s; s = 1.0 - r2 / 156.0 * s; s = 1.0 - r2 / 110.0 * s; s = 1.0 - r2 / 72.0 * s; s = 1.0 - r2 / 42.0 * s; s = 1.0 - r2 / 20.0 * s; s = 1.0 - r2 / 6.0 * s; s *= r;
    double c = 1.0 - r2 / 240.0; c = 1.0 - r2 / 182.0 * c; c = 1.0 - r2 / 132.0 * c; c = 1.0 - r2 / 90.0 * c; c = 1.0 - r2 / 56.0 * c; c = 1.0 - r2 / 30.0 * c; c = 1.0 - r2 / 12.0 * c; c = 1.0 - r2 / 2.0 * c;
    const int q = ((int)kq) & 3;
    double sn = s, cs = c;
    if (q == 1) { sn = c; cs = -s; } else if (q == 2) { sn = -s; cs = -c; } else if (q == 3) { sn = -c; cs = s; }
    const double x = la * (double)j * (1.0 / 64.0);
    double e = 1.0 + x / 10.0; e = 1.0 + x / 9.0 * e; e = 1.0 + x / 8.0 * e; e = 1.0 + x / 7.0 * e; e = 1.0 + x / 6.0 * e; e = 1.0 + x / 5.0 * e; e = 1.0 + x / 4.0 * e; e = 1.0 + x / 3.0 * e; e = 1.0 + x / 2.0 * e; e = 1.0 + x * e;
#pragma unroll
    for (int i = 0; i < 6; ++i) e = e * e;
    pr = e * cs; pi = e * sn;
}

__device__ __forceinline__ void phase_prep(const Args& a, int l, unsigned char* lds, int G) {
    const int tid = otid(), lane = tid & 63, wave = tid >> 6;
    unsigned char* ws = a.ws;
    const int gw = blockIdx.x * 8 + wave, NGW = G * 8;
    float* scr = (float*)(lds + wave * 16384);
    const float* f1n = a.in[I_F1N] + (size_t)l * DM; const float* f2n = a.in[I_F2N] + (size_t)l * DM; const float* mxn = a.in[I_MIXN] + (size_t)l * DM;
    const float* f1g = a.in[I_F1G] + (size_t)l * DM * FF; const float* f1u = a.in[I_F1U] + (size_t)l * DM * FF; const float* f1d = a.in[I_F1D] + (size_t)l * FF * DM;
    const float* f2g = a.in[I_F2G] + (size_t)l * DM * FF; const float* f2u = a.in[I_F2U] + (size_t)l * DM * FF; const float* f2d = a.in[I_F2D] + (size_t)l * FF * DM;
    const float* win = a.in[I_WIN] + (size_t)l * DM * INW; const float* wbr = a.in[I_WBR] + (size_t)l * DM * DM; const float* wout = a.in[I_WOUT] + (size_t)l * DM * DM;
    const float* wglu = a.in[I_WGLU] + (size_t)l * 512 * 512;
    constexpr int IT_FU = (DM / 64) * (FF / 32), IT_FD = (FF / 64) * (DM / 32), IT_WA = (DM / 64) * (3584 / 32), IT_WB = (DM / 64) * (6656 / 32),
                  IT_BR = (1536 / 64) * (DM / 32), IT_WO = (DM / 64) * (DM / 32), IT_GL = (512 / 64) * (512 / 32);
    constexpr int IT_TOTAL = 4 * IT_FU + 2 * IT_FD + IT_WA + IT_WB + IT_BR + IT_WO + IT_GL;
    for (int it = gw; it < IT_TOTAL; it += NGW) {
        int r = it;
        if (tr_try(r, f1g, FF, DM, FF, 0, f1n, (bf16_t*)(ws + WS_W1U), DM, 0, 1, scr, lane)) continue;
        if (tr_try(r, f1u, FF, DM, FF, 0, f1n, (bf16_t*)(ws + WS_W1U), DM, 128, 1, scr, lane)) continue;
        if (tr_try(r, f2g, FF, DM, FF, 0, f2n, (bf16_t*)(ws + WS_W2U), DM, 0, 1, scr, lane)) continue;
        if (tr_try(r, f2u, FF, DM, FF, 0, f2n, (bf16_t*)(ws + WS_W2U), DM, 128, 1, scr, lane)) continue;
        if (tr_try(r, f1d, DM, FF, DM, 0, nullptr, (bf16_t*)(ws + WS_W1D), FF, 0, 0, scr, lane)) continue;
        if (tr_try(r, f2d, DM, FF, DM, 0, nullptr, (bf16_t*)(ws + WS_W2D), FF, 0, 0, scr, lane)) continue;
        if (tr_try(r, win, INW, DM, 3584, 0, mxn, (bf16_t*)(ws + WS_WIN), DM, 0, 0, scr, lane)) continue;
        if (tr_try(r, win, INW, DM, 6656, 3600, mxn, (bf16_t*)(ws + WS_WIN), DM, 3584, 0, scr, lane)) continue;
        if (tr_try(r, wbr + (size_t)512 * DM, DM, 1536, DM, 0, nullptr, (bf16_t*)(ws + WS_WBR) + 512, DM, 0, 0, scr, lane)) continue;
        if (tr_try(r, wout, DM, DM, DM, 0, nullptr, (bf16_t*)(ws + WS_WO), DM, 0, 0, scr, lane)) continue;
        tr_try(r, wglu, 512, 512, 512, 0, nullptr, (bf16_t*)(ws + WS_WGLU), 512, 0, 0, scr, lane);
    }
    {
        const float* pw = a.in[I_POOLW] + (size_t)l * 4 * 128 * 128; const float* ps = a.in[I_POOLS] + (size_t)l * 512;
        bf16_t* WbT = (bf16_t*)(ws + WS_WBR);
        for (int n = blockIdx.x; n < DM; n += G) {
            const int k = tid, g = k >> 7;
            const float* pr = pw + (size_t)k * 128;
            float s = 0.f;
#pragma unroll 8
            for (int d = 0; d < 128; ++d) s += pr[d] * ps[g * 128 + d] * wbr[(size_t)(g * 128 + d) * DM + n];
            WbT[(size_t)n * DM + k] = (bf16_t)f2bf(s);
        }
    }
    {
        bf16_t* WGT = (bf16_t*)(ws + WS_WGT);
        for (int i = blockIdx.x * 512 + tid; i < 16 * DM; i += G * 512) { const int j = i >> 11, k = i & 2047; WGT[i] = (bf16_t)f2bf(mxn[k] * win[(size_t)k * INW + 3584 + j]); }
    }
    {
        const float* are = a.in[I_ARE] + (size_t)l * 32 * 64; const float* aim = a.in[I_AIM] + (size_t)l * 32 * 64; const float* ldt = a.in[I_LDT] + (size_t)l * 32;
        const float* bre = a.in[I_BRE] + (size_t)l * 32 * 64 * 16; const float* bim = a.in[I_BIM] + (size_t)l * 32 * 64 * 16;
        const float* cre = a.in[I_CRE] + (size_t)l * 32 * 16 * 64; const float* cim = a.in[I_CIM] + (size_t)l * 32 * 16 * 64;
        const float* sd = a.in[I_SD] + (size_t)l * 512;
        bf16_t* KT = (bf16_t*)(ws + WS_KT); bf16_t* MET = (bf16_t*)(ws + WS_MET); bf16_t* MCT = (bf16_t*)(ws + WS_MCT); float* L64 = (float*)(ws + WS_L64);
        float* s_pw = (float*)lds;
        float* s_f = s_pw + 128;
        float* s_bbr = s_f + 128;
        float* s_bbi = s_bbr + 1024;
        __syncthreads();
        for (int it = blockIdx.x; it < 32 * 65; it += G) {
            const int g = it / 65, j = it % 65;
            if (tid < 64) {
                const int p = tid;
                const double dt = (double)expf(ldt[g]);
                const double ar = (double)are[g * 64 + p], ai = (double)aim[g * 64 + p];
                double pr, pi, l1r, l1i;
                cpow_d(dt * ai, dt * ar, j, pr, pi);
                cpow_d(dt * ai, dt * ar, 1, l1r, l1i);
                const double den = ar * ar + ai * ai;
                const double fr = ((l1r - 1.0) * ar + l1i * ai) / den, fi = (l1i * ar - (l1r - 1.0) * ai) / den;
                s_pw[2 * p] = (float)pr; s_pw[2 * p + 1] = (float)pi; s_f[2 * p] = (float)fr; s_f[2 * p + 1] = (float)fi;
                if (j == 64) { L64[(g * 64 + p) * 2] = (float)pr; L64[(g * 64 + p) * 2 + 1] = (float)pi; }
            }
            __syncthreads();
#pragma unroll
            for (int i = 0; i < 2; ++i) { const int idx = tid + i * 512, p = idx >> 4; const float fr = s_f[2 * p], fi = s_f[2 * p + 1];
                const float br = bre[(size_t)g * 1024 + idx], bi = bim[(size_t)g * 1024 + idx];
                s_bbr[idx] = fr * br - fi * bi; s_bbi[idx] = fr * bi + fi * br; }
            __syncthreads();
            if (j < 64) {
                if (tid < 256) {
                    const int h = tid >> 4, hp = tid & 15; float s = 0.f;
                    for (int p = 0; p < 64; ++p) { const float cr = cre[(size_t)(g * 16 + h) * 64 + p], ci = cim[(size_t)(g * 16 + h) * 64 + p], pr = s_pw[2 * p], pi = s_pw[2 * p + 1];
                        const float wr = cr * pr - ci * pi, wi = cr * pi + ci * pr; s += wr * s_bbr[p * 16 + hp] - wi * s_bbi[p * 16 + hp]; }
                    if (j == 0 && h == hp) s += sd[g * 16 + h];
                    KT[((size_t)(g * 64 + j) * 16 + h) * 16 + hp] = (bf16_t)f2bf(s);
                }
#pragma unroll
                for (int i = 0; i < 2; ++i) { const int idx = tid + i * 512, p = idx >> 4, hp = idx & 15; const float pr = s_pw[2 * p], pi = s_pw[2 * p + 1], br = s_bbr[idx], bi = s_bbi[idx];
                    const int jp = 63 - j;
                    MET[((size_t)(g * 128 + p) * 64 + jp) * 16 + hp] = (bf16_t)f2bf(pr * br - pi * bi);
                    MET[((size_t)(g * 128 + 64 + p) * 64 + jp) * 16 + hp] = (bf16_t)f2bf(pr * bi + pi * br); }
            }
            if (j >= 1) {
                const int sp = j - 1;
#pragma unroll
                for (int i = 0; i < 2; ++i) { const int idx = tid + i * 512, h = idx >> 6, p = idx & 63; const float cr = cre[(size_t)(g * 16 + h) * 64 + p], ci = cim[(size_t)(g * 16 + h) * 64 + p], pr = s_pw[2 * p], pi = s_pw[2 * p + 1];
                    const size_t base = ((size_t)g * 1024 + sp * 16 + h) * 128;
                    MCT[base + p] = (bf16_t)f2bf(cr * pr - ci * pi); MCT[base + 64 + p] = (bf16_t)f2bf(-(cr * pi + ci * pr)); }
            }
            __syncthreads();
        }
    }
    if (l == 0) {
        const float* x = a.in[I_X]; bf16_t* XB = (bf16_t*)(ws + WS_XB); unsigned long long* rss = (unsigned long long*)(ws + WS_RSS);
        for (int row = gw; row < T; row += NGW) {
            const f32x4* xr = (const f32x4*)(x + (size_t)row * DM) + lane; u32x2* o = (u32x2*)(XB + (size_t)row * DM) + lane;
            float ss = 0.f;
#pragma unroll
            for (int i = 0; i < 8; ++i) { const f32x4 v = xr[64 * i]; ss += v[0] * v[0] + v[1] * v[1] + v[2] * v[2] + v[3] * v[3]; u32x2 w; w.x = pk2(v[0], v[1]); w.y = pk2(v[2], v[3]); o[64 * i] = w; }
            ss = wave_sum(ss);
            if (lane == 0) rss[row] = (unsigned long long)(ss * 16777216.f);
        }
        for (int i = blockIdx.x * 512 + tid; i < 6 * T; i += G * 512) rss[T + i] = 0ull;
    }
}

__device__ __forceinline__ void phase_glr(const Args& a, const unsigned long long* rss, int G) {
    const int tid = otid(), lane = tid & 63, wave = tid >> 6, r16 = lane & 15, quad = lane >> 4;
    const int gw = blockIdx.x * 8 + wave, NGW = G * 8;
    const bf16_t* XB = (const bf16_t*)(a.ws + WS_XB); const bf16_t* WGT = (const bf16_t*)(a.ws + WS_WGT); float* GLR = (float*)(a.ws + WS_GLR);
    for (int task = gw; task < T / 16; task += NGW) {
        const int r0 = task * 16;
        f32x4 acc = (f32x4){0.f, 0.f, 0.f, 0.f};
        const bf16_t* ap = XB + (size_t)(r0 + r16) * DM + quad * 8; const bf16_t* bp = WGT + (size_t)r16 * DM + quad * 8;
#pragma unroll 8
        for (int kb = 0; kb < 64; ++kb) acc = mfma16(*(const bf16x8*)(ap + kb * 32), *(const bf16x8*)(bp + kb * 32), acc);
#pragma unroll
        for (int i = 0; i < 4; ++i) { const int row = r0 + quad * 4 + i; GLR[(size_t)row * 16 + r16] = acc[i] * rsqrtf((float)rss[row] * (1.f / (16777216.f * DM)) + EPS); }
    }
}

__device__ __forceinline__ void phase_pool(const Args& a, int G) {
    const bf16_t* Z = (const bf16_t*)(a.ws + WS_Z); bf16_t* Y = (bf16_t*)(a.ws + WS_Y);
    for (int idx = blockIdx.x * 512 + otid(); idx < T * 64; idx += G * 512) {
        const int t = idx >> 6, c0 = (idx & 63) * 8, w = 2 << (c0 >> 7), s = t & (SEQ - 1);
        const int cnt = (s + 1) < w ? (s + 1) : w;
        float sum[8], x0[8];
#pragma unroll
        for (int i = 0; i < 8; ++i) sum[i] = 0.f;
        for (int j = 0; j < cnt; ++j) {
            const u32x4 v = *(const u32x4*)(Z + (size_t)(t - j) * ZW + ZC_POOL + c0);
            const float f[8] = {bflo(v.x), bfhi(v.x), bflo(v.y), bfhi(v.y), bflo(v.z), bfhi(v.z), bflo(v.w), bfhi(v.w)};
#pragma unroll
            for (int i = 0; i < 8; ++i) { sum[i] += f[i]; if (j == 0) x0[i] = f[i]; }
        }
        const float inv = 1.f / (float)cnt;
        u32x4 o; o.x = pk2(sum[0] * inv - x0[0], sum[1] * inv - x0[1]); o.y = pk2(sum[2] * inv - x0[2], sum[3] * inv - x0[3]);
        o.z = pk2(sum[4] * inv - x0[4], sum[5] * inv - x0[5]); o.w = pk2(sum[6] * inv - x0[6], sum[7] * inv - x0[7]);
        *(u32x4*)(Y + (size_t)t * DM + c0) = o;
    }
}

constexpr int OFF_BC = 0, OFF_QP = 32768, OFF_KP = 50176, OFF_OB = 0, OFF_QD = 67584, OFF_VT = 84992, OFF_PB = 121856, OFF_GL = 131072, OFF_TOT = 135168;
constexpr int PQ = 136, PV = 72, POB = 260;

__device__ __forceinline__ void gla_bc(const Args& a, int l, unsigned char* lds, int t0, int h) {
    const int tid = otid(), d = tid & 127, jq = tid >> 7;
    float* BC = (float*)(lds + OFF_BC); float* GL = (float*)(lds + OFF_GL); float* TOT = (float*)(lds + OFF_TOT);
    const float* GLR = (const float*)(a.ws + WS_GLR);
    const float* w2 = a.in[I_GW2] + (size_t)l * 16 * 512; const float* gb = a.in[I_GB] + (size_t)l * 512;
    for (int i = tid; i < 1024; i += 512) GL[i] = GLR[(size_t)t0 * 16 + i];
    float w[16];
#pragma unroll
    for (int r = 0; r < 16; ++r) w[r] = w2[r * 512 + h * 128 + d];
    const float bias = gb[h * 128 + d];
    __syncthreads();
    float run = 0.f;
#pragma unroll 4
    for (int jj = 0; jj < 16; ++jj) {
        const int j = jq * 16 + jj;
        float z = bias;
#pragma unroll
        for (int r = 0; r < 16; ++r) z += GL[j * 16 + r] * w[r];
        const float la = (fminf(z, 0.f) - __logf(1.f + __expf(-fabsf(z)))) * (1.f / 16.f);
        run += la; BC[j * 128 + d] = run;
    }
    TOT[jq * 128 + d] = run;
    __syncthreads();
    float off = 0.f;
    for (int q = 0; q < jq; ++q) off += TOT[q * 128 + d];
    if (jq > 0) {
#pragma unroll 4
        for (int jj = 0; jj < 16; ++jj) BC[(jq * 16 + jj) * 128 + d] += off;
    }
    __syncthreads();
}

__device__ __forceinline__ void gla_kv_unit(const Args& a, int l, unsigned char* lds, int unit) {
    const int tid = otid(), lane = tid & 63, wave = tid >> 6, r16 = lane & 15, quad = lane >> 4;
    const int bh = unit >> 6, n = unit & 63, b = bh >> 2, h = bh & 3, t0 = b * SEQ + n * 64;
    const bf16_t* Z = (const bf16_t*)(a.ws + WS_Z); bf16_t* KV = (bf16_t*)(a.ws + WS_KV); float* DEC = (float*)(a.ws + WS_DEC);
    gla_bc(a, l, lds, t0, h);
    const float* BC = (const float*)(lds + OFF_BC); bf16_t* KTl = (bf16_t*)(lds + OFF_QP); bf16_t* VT = (bf16_t*)(lds + OFF_VT);
    {
        const int d = tid & 127, jq = tid >> 7; const float bl = BC[63 * 128 + d];
#pragma unroll 4
        for (int jj = 0; jj < 16; ++jj) { const int j = jq * 16 + jj; const float kv = bf2f(Z[(size_t)(t0 + j) * ZW + ZC_K + h * 128 + d]);
            KTl[d * PV + j] = (bf16_t)f2bf(kv * __expf(bl - BC[j * 128 + d])); }
        if (jq == 0) DEC[(size_t)unit * 128 + d] = __expf(bl);
        const int v = tid & 255, jh = tid >> 8;
#pragma unroll 4
        for (int jj = 0; jj < 32; ++jj) { const int j = jh * 32 + jj; VT[v * PV + j] = Z[(size_t)(t0 + j) * ZW + ZC_V + h * 256 + v]; }
    }
    __syncthreads();
    f32x4 acc[8][2];
#pragma unroll
    for (int i = 0; i < 8; ++i) { acc[i][0] = (f32x4){0.f, 0.f, 0.f, 0.f}; acc[i][1] = (f32x4){0.f, 0.f, 0.f, 0.f}; }
#pragma unroll
    for (int kb = 0; kb < 2; ++kb) {
        bf16x8 bf[2];
#pragma unroll
        for (int v2 = 0; v2 < 2; ++v2) bf[v2] = *(const bf16x8*)(VT + ((wave * 2 + v2) * 16 + r16) * PV + kb * 32 + quad * 8);
#pragma unroll
        for (int db = 0; db < 8; ++db) { const bf16x8 af = *(const bf16x8*)(KTl + (db * 16 + r16) * PV + kb * 32 + quad * 8);
            acc[db][0] = mfma16(af, bf[0], acc[db][0]); acc[db][1] = mfma16(af, bf[1], acc[db][1]); }
    }
#pragma unroll
    for (int db = 0; db < 8; ++db)
#pragma unroll
        for (int v2 = 0; v2 < 2; ++v2) { const int v = (wave * 2 + v2) * 16 + r16; u32x2 o; o.x = pk2(acc[db][v2][0], acc[db][v2][1]); o.y = pk2(acc[db][v2][2], acc[db][v2][3]);
            *(u32x2*)(KV + ((size_t)unit * 256 + v) * 128 + db * 16 + quad * 4) = o; }
    __syncthreads();
}

__device__ __forceinline__ void gla_scan(const Args& a, int G) {
    bf16_t* KV = (bf16_t*)(a.ws + WS_KV); const float* DEC = (const float*)(a.ws + WS_DEC);
    for (int id = blockIdx.x * 512 + otid(); id < 16 * 256 * 32; id += G * 512) {
        const int bh = id >> 13, v = (id >> 5) & 255, d0 = (id & 31) * 4;
        float s0 = 0.f, s1 = 0.f, s2 = 0.f, s3 = 0.f;
#pragma unroll 8
        for (int n = 0; n < 64; ++n) {
            const int unit = bh * 64 + n;
            u32x2* p = (u32x2*)(KV + ((size_t)unit * 256 + v) * 128 + d0);
            const u32x2 kv = *p; const f32x4 dc = *(const f32x4*)(DEC + (size_t)unit * 128 + d0);
            u32x2 o; o.x = pk2(s0, s1); o.y = pk2(s2, s3); *p = o;
            s0 = dc[0] * s0 + bflo(kv.x); s1 = dc[1] * s1 + bfhi(kv.x); s2 = dc[2] * s2 + bflo(kv.y); s3 = dc[3] * s3 + bfhi(kv.y);
        }
    }
}

__device__ __forceinline__ void gla_out_unit(const Args& a, int l, unsigned char* lds, int unit) {
    const int tid = otid(), lane = tid & 63, wave = tid >> 6, r16 = lane & 15, quad = lane >> 4;
    const int bh = unit >> 6, n = unit & 63, b = bh >> 2, h = bh & 3, t0 = b * SEQ + n * 64;
    const bf16_t* Z = (const bf16_t*)(a.ws + WS_Z); const bf16_t* KV = (const bf16_t*)(a.ws + WS_KV); bf16_t* Y = (bf16_t*)(a.ws + WS_Y);
    gla_bc(a, l, lds, t0, h);
    const float* BC = (const float*)(lds + OFF_BC);
    bf16_t* QP = (bf16_t*)(lds + OFF_QP); bf16_t* KP = (bf16_t*)(lds + OFF_KP); bf16_t* QD = (bf16_t*)(lds + OFF_QD); bf16_t* VT = (bf16_t*)(lds + OFF_VT); bf16_t* PB = (bf16_t*)(lds + OFF_PB);
    float* OB = (float*)(lds + OFF_OB);
    {
        const int d = tid & 127, jq = tid >> 7; const float bm = BC[31 * 128 + d];
#pragma unroll 4
        for (int jj = 0; jj < 16; ++jj) { const int j = jq * 16 + jj; const float bcv = BC[j * 128 + d];
            const float qv = bf2f(Z[(size_t)(t0 + j) * ZW + ZC_Q + h * 128 + d]) * 0.08838834764831845f, kv = bf2f(Z[(size_t)(t0 + j) * ZW + ZC_K + h * 128 + d]);
            QP[j * PQ + d] = (bf16_t)f2bf(qv * __expf(bcv - bm)); KP[j * PQ + d] = (bf16_t)f2bf(kv * __expf(bm - bcv)); QD[j * PQ + d] = (bf16_t)f2bf(qv * __expf(bcv)); }
        const int v = tid & 255, jh = tid >> 8;
#pragma unroll 4
        for (int jj = 0; jj < 32; ++jj) { const int j = jh * 32 + jj; VT[v * PV + j] = Z[(size_t)(t0 + j) * ZW + ZC_V + h * 256 + v]; }
    }
    __syncthreads();
    {
        const int ib = wave >> 1;
#pragma unroll
        for (int jbi = 0; jbi < 2; ++jbi) {
            const int jb = (wave & 1) * 2 + jbi;
            f32x4 sc = (f32x4){0.f, 0.f, 0.f, 0.f};
            if (jb <= ib) {
#pragma unroll
                for (int kb = 0; kb < 4; ++kb) sc = mfma16(*(const bf16x8*)(QP + (ib * 16 + r16) * PQ + kb * 32 + quad * 8), *(const bf16x8*)(KP + (jb * 16 + r16) * PQ + kb * 32 + quad * 8), sc);
            }
#pragma unroll
            for (int i = 0; i < 4; ++i) { const int row = ib * 16 + quad * 4 + i, col = jb * 16 + r16; PB[row * PV + col] = (bf16_t)f2bf(col <= row ? sc[i] : 0.f); }
        }
    }
    __syncthreads();
    f32x4 acc[4][2];
#pragma unroll
    for (int i = 0; i < 4; ++i) { acc[i][0] = (f32x4){0.f, 0.f, 0.f, 0.f}; acc[i][1] = (f32x4){0.f, 0.f, 0.f, 0.f}; }
#pragma unroll
    for (int kb = 0; kb < 2; ++kb) {
        bf16x8 bf[2];
#pragma unroll
        for (int v2 = 0; v2 < 2; ++v2) bf[v2] = *(const bf16x8*)(VT + ((wave * 2 + v2) * 16 + r16) * PV + kb * 32 + quad * 8);
#pragma unroll
        for (int ib = 0; ib < 4; ++ib) { const bf16x8 af = *(const bf16x8*)(PB + (ib * 16 + r16) * PV + kb * 32 + quad * 8);
            acc[ib][0] = mfma16(af, bf[0], acc[ib][0]); acc[ib][1] = mfma16(af, bf[1], acc[ib][1]); }
    }
#pragma unroll
    for (int kb = 0; kb < 4; ++kb) {
        bf16x8 bf[2];
#pragma unroll
        for (int v2 = 0; v2 < 2; ++v2) bf[v2] = *(const bf16x8*)(KV + ((size_t)unit * 256 + (wave * 2 + v2) * 16 + r16) * 128 + kb * 32 + quad * 8);
#pragma unroll
        for (int ib = 0; ib < 4; ++ib) { const bf16x8 af = *(const bf16x8*)(QD + (ib * 16 + r16) * PQ + kb * 32 + quad * 8);
            acc[ib][0] = mfma16(af, bf[0], acc[ib][0]); acc[ib][1] = mfma16(af, bf[1], acc[ib][1]); }
    }
#pragma unroll
    for (int ib = 0; ib < 4; ++ib)
#pragma unroll
        for (int v2 = 0; v2 < 2; ++v2)
#pragma unroll
            for (int i = 0; i < 4; ++i) OB[(ib * 16 + quad * 4 + i) * POB + (wave * 2 + v2) * 16 + r16] = acc[ib][v2][i];
    __syncthreads();
    {
        const float* gn = a.in[I_GNORM] + (size_t)l * 1024 + h * 256 + lane * 4;
        const f32x4 gain = *(const f32x4*)gn;
#pragma unroll 2
        for (int rr = 0; rr < 8; ++rr) {
            const int i = wave * 8 + rr;
            const f32x4 v = *(const f32x4*)(OB + i * POB + lane * 4);
            const float ss = wave_sum(v[0] * v[0] + v[1] * v[1] + v[2] * v[2] + v[3] * v[3]);
            const float rinv = rsqrtf(ss * (1.f / 256.f) + EPS);
            const u32x2 rv = *(const u32x2*)(Z + (size_t)(t0 + i) * ZW + ZC_R + h * 256 + lane * 4);
            const float r0 = bflo(rv.x), r1 = bfhi(rv.x), r2 = bflo(rv.y), r3 = bfhi(rv.y);
            u32x2 o; o.x = pk2(v[0] * rinv * gain[0] * r0 * sigmoid_f(r0), v[1] * rinv * gain[1] * r1 * sigmoid_f(r1));
            o.y = pk2(v[2] * rinv * gain[2] * r2 * sigmoid_f(r2), v[3] * rinv * gain[3] * r3 * sigmoid_f(r3));
            *(u32x2*)(Y + (size_t)(t0 + i) * DM + YC_GLA + h * 256 + lane * 4) = o;
        }
    }
    __syncthreads();
}

__device__ __forceinline__ void ssm_end_unit(const Args& a, int unit) {
    const int tid = otid(), lane = tid & 63, wave = tid >> 6, r16 = lane & 15, quad = lane >> 4;
    const int g = unit >> 2, rb = unit & 3;
    const bf16_t* Z = (const bf16_t*)(a.ws + WS_Z); const bf16_t* MET = (const bf16_t*)(a.ws + WS_MET); float* E = (float*)(a.ws + WS_E);
    const int crow = rb * 64 + (wave & 3) * 16, qg = (wave >> 2) * 64;
    const int ch = (quad & 1) * 8, jo = quad >> 1;
    f32x4 acc[4];
#pragma unroll
    for (int i = 0; i < 4; ++i) acc[i] = (f32x4){0.f, 0.f, 0.f, 0.f};
    const bf16_t* ap = Z + (size_t)((crow + r16) * 64 + jo) * ZW + ZC_S + g * 16 + ch;
    const bf16_t* bp = MET + ((size_t)(g * 128 + qg + r16) * 64 + jo) * 16 + ch;
#pragma unroll 4
    for (int kb = 0; kb < 32; ++kb) {
        const bf16x8 af = *(const bf16x8*)(ap + (size_t)kb * 2 * ZW);
#pragma unroll
        for (int nb = 0; nb < 4; ++nb) acc[nb] = mfma16(af, *(const bf16x8*)(bp + (size_t)nb * 16 * 1024 + kb * 32), acc[nb]);
    }
#pragma unroll
    for (int nb = 0; nb < 4; ++nb)
#pragma unroll
        for (int i = 0; i < 4; ++i) E[((size_t)(crow + quad * 4 + i) * 32 + g) * 128 + qg + nb * 16 + r16] = acc[nb][i];
}
__device__ __forceinline__ void ssm_scan(const Args& a, int id) {
    const int b = id >> 11, g = (id >> 6) & 31, p = id & 63;
    const float* E = (const float*)(a.ws + WS_E); bf16_t* HC = (bf16_t*)(a.ws + WS_HC); const float* L64 = (const float*)(a.ws + WS_L64);
    const float lr = L64[(g * 64 + p) * 2], li = L64[(g * 64 + p) * 2 + 1];
    float hr = 0.f, hi = 0.f;
#pragma unroll 8
    for (int n = 0; n < 64; ++n) {
        const size_t base = ((size_t)(b * 64 + n) * 32 + g) * 128;
        HC[base + p] = (bf16_t)f2bf(hr); HC[base + 64 + p] = (bf16_t)f2bf(hi);
        const float er = E[base + p], ei = E[base + 64 + p];
        const float nr = lr * hr - li * hi + er, ni = lr * hi + li * hr + ei;
        hr = nr; hi = ni;
    }
}
__device__ __forceinline__ void ssm_out_unit(const Args& a, int unit) {
    const int tid = otid(), lane = tid & 63, wave = tid >> 6, r16 = lane & 15, quad = lane >> 4;
    const int g = unit >> 4, cb = unit & 15;
    const bf16_t* Z = (const bf16_t*)(a.ws + WS_Z); const bf16_t* KT = (const bf16_t*)(a.ws + WS_KT); const bf16_t* MCT = (const bf16_t*)(a.ws + WS_MCT);
    const bf16_t* HC = (const bf16_t*)(a.ws + WS_HC); bf16_t* YS = (bf16_t*)(a.ws + WS_YS);
    const int ch = (quad & 1) * 8, jo = quad >> 1;
    f32x4 acc[2][4];
#pragma unroll
    for (int i = 0; i < 2; ++i)
#pragma unroll
        for (int k = 0; k < 4; ++k) acc[i][k] = (f32x4){0.f, 0.f, 0.f, 0.f};
    const int kbn = cb * 2 + 2;
    for (int kb = 0; kb < kbn; ++kb) {
        const int jp = kb * 2 + jo;
        bf16x8 af[2];
#pragma unroll
        for (int rk = 0; rk < 2; ++rk) af[rk] = *(const bf16x8*)(Z + (size_t)((wave * 32 + rk * 16 + r16) * 64 + jp) * ZW + ZC_S + g * 16 + ch);
#pragma unroll
        for (int nb = 0; nb < 4; ++nb) {
            const int sp = cb * 4 + nb, dl = sp - jp;
            if (kb * 2 > sp) continue;
            bf16x8 bf = (bf16x8){0, 0, 0, 0, 0, 0, 0, 0};
            if (dl >= 0) bf = *(const bf16x8*)(KT + ((size_t)(g * 64 + dl) * 16 + r16) * 16 + ch);
            acc[0][nb] = mfma16(af[0], bf, acc[0][nb]); acc[1][nb] = mfma16(af[1], bf, acc[1][nb]);
        }
    }
#pragma unroll
    for (int kb = 0; kb < 4; ++kb) {
        bf16x8 af[2];
#pragma unroll
        for (int rk = 0; rk < 2; ++rk) af[rk] = *(const bf16x8*)(HC + ((size_t)(wave * 32 + rk * 16 + r16) * 32 + g) * 128 + kb * 32 + quad * 8);
#pragma unroll
        for (int nb = 0; nb < 4; ++nb) { const bf16x8 bf = *(const bf16x8*)(MCT + ((size_t)g * 1024 + (cb * 4 + nb) * 16 + r16) * 128 + kb * 32 + quad * 8);
            acc[0][nb] = mfma16(af[0], bf, acc[0][nb]); acc[1][nb] = mfma16(af[1], bf, acc[1][nb]); }
    }
#pragma unroll
    for (int rk = 0; rk < 2; ++rk)
#pragma unroll
        for (int nb = 0; nb < 4; ++nb)
#pragma unroll
            for (int i = 0; i < 4; ++i) { const int chunk = wave * 32 + rk * 16 + quad * 4 + i, t = chunk * 64 + cb * 4 + nb;
                YS[(size_t)t * 512 + g * 16 + r16] = (bf16_t)f2bf(gelu_tanh_f(acc[rk][nb][i])); }
}

__device__ __forceinline__ void phase_final(const Args& a, int G) {
    const int tid = otid(), lane = tid & 63, wave = tid >> 6;
    const int gw = blockIdx.x * 8 + wave, NGW = G * 8;
    const unsigned long long* rss = (const unsigned long long*)(a.ws + WS_RSS) + (size_t)6 * T; const float* gf = a.in[I_FINN];
    for (int row = gw; row < T; row += NGW) {
        const float rinv = rsqrtf((float)rss[row] * (1.f / (16777216.f * DM)) + EPS);
        f32x4* xr = (f32x4*)(a.out + (size_t)row * DM) + lane; const f32x4* gr = (const f32x4*)gf + lane;
#pragma unroll
        for (int i = 0; i < 8; ++i) { f32x4 v = xr[64 * i]; const f32x4 gg = gr[64 * i]; v = v * rinv * gg; xr[64 * i] = v; }
    }
}


#define XB_TMO      128
#define XB_XCNT(j)  (256  + 64 * (j))
#define XB_XSUB(j)  (1280 + 64 * (j))
#define XB_XGEN(j)  (2304 + 64 * (j))
#define XB_TOP      3328
#define XB_TOPGEN   3392
#define XCD_BAR_WORDS 3456
#define XB_SPIN_CAP (1u << 18)
__device__ __forceinline__ unsigned xb_ld(unsigned* p)              { return __hip_atomic_load(p, __ATOMIC_RELAXED, __HIP_MEMORY_SCOPE_AGENT); }
__device__ __forceinline__ unsigned xb_add(unsigned* p, unsigned v) { return __hip_atomic_fetch_add(p, v, __ATOMIC_RELAXED, __HIP_MEMORY_SCOPE_AGENT); }
__device__ __forceinline__ unsigned xb_xcc_id() { return (unsigned)__builtin_amdgcn_s_getreg((3 << 11) | 20) & 0xFu; }
#define XB_SPIN(cond, bar) do { unsigned _sp = 0; while (cond) { __builtin_amdgcn_s_sleep(1); \
    if ((++_sp & 255u) == 0u) { if (xb_ld(&(bar)[XB_TMO])) break; if (_sp > XB_SPIN_CAP) { atomicAdd(&(bar)[XB_TMO], 1u); break; } } } } while (0)
struct XcdBarrier { unsigned* bar; unsigned x; volatile LAS unsigned* st; };
__device__ __forceinline__ XcdBarrier xcd_barrier_post(unsigned* bar, volatile LAS unsigned* st) {
    XcdBarrier b; b.bar = bar; b.x = xb_xcc_id(); b.st = st;
    if (threadIdx.x == 0) (void)xb_add(&bar[XB_XCNT(b.x)], 1u);
    return b;
}
__device__ __forceinline__ void xcd_barrier_complete(unsigned* bar, unsigned x, unsigned& nloc, unsigned& nx) {
    const unsigned G = gridDim.x * gridDim.y * gridDim.z;
    unsigned sum, cnt, mine, sp = 0u;
    for (;;) {
        sum = 0u; cnt = 0u; mine = 0u;
#pragma unroll
        for (unsigned j = 0; j < 16; ++j) { const unsigned c = xb_ld(&bar[XB_XCNT(j)]); sum += c; cnt += (c > 0u) ? 1u : 0u; mine = (j == x) ? c : mine; }
        if (sum == G) break;
        __builtin_amdgcn_s_sleep(1);
        if ((++sp & 255u) == 0u) { if (xb_ld(&bar[XB_TMO])) break; if (sp > XB_SPIN_CAP) { atomicAdd(&bar[XB_TMO], 1u); break; } }
    }
    nloc = mine > 0u ? mine : 1u; nx = cnt > 0u ? cnt : 1u;
}
__device__ __forceinline__ void xcd_barrier(const XcdBarrier& b) {
    asm volatile("s_waitcnt vmcnt(0)" ::: "memory");
    __syncthreads();
    if (threadIdx.x == 0) {
        unsigned* bar = b.bar;
        __builtin_amdgcn_s_waitcnt(0);
        unsigned nloc = b.st[0], nx = b.st[1];
        if (nloc == 0u) { xcd_barrier_complete(bar, b.x, nloc, nx); b.st[0] = nloc; b.st[1] = nx; }
        const unsigned old = xb_add(&bar[XB_XSUB(b.x)], 1u);
        const unsigned gen = old / nloc;
        if (old + 1u == (gen + 1u) * nloc) {
            __builtin_amdgcn_fence(__ATOMIC_RELEASE, "agent");
            asm volatile("s_waitcnt vmcnt(0)" ::: "memory");
            const unsigned og = xb_add(&bar[XB_TOP], 1u);
            const unsigned tg = og / nx;
            if (og + 1u == (tg + 1u) * nx) xb_add(&bar[XB_TOPGEN], 1u);
            else XB_SPIN(xb_ld(&bar[XB_TOPGEN]) == tg, bar);
            __builtin_amdgcn_fence(__ATOMIC_ACQUIRE, "agent");
            xb_add(&bar[XB_XGEN(b.x)], 1u);
            asm volatile("s_waitcnt vmcnt(0)" ::: "memory");
        } else {
            XB_SPIN(xb_ld(&bar[XB_XGEN(b.x)]) == gen, bar);
            __builtin_amdgcn_fence(__ATOMIC_ACQUIRE, "agent");
            asm volatile("s_waitcnt vmcnt(0)" ::: "memory");
        }
    }
    __syncthreads();
}

constexpr int PH_PER_LAYER = 12, N_PHASES = 2 * PH_PER_LAYER + 1;

__global__ void __launch_bounds__(512, 2) mega_fwd(Args a) {
    extern __shared__ __attribute__((aligned(16))) unsigned char lds[];
    cg::grid_group grid = cg::this_grid();
    const int G = gridDim.x;
    unsigned char* ws = a.ws;
    LAS unsigned char* ldsl = (LAS unsigned char*)lds;
    unsigned long long* rssb = (unsigned long long*)(ws + WS_RSS);
    volatile LAS unsigned* bst = (volatile LAS unsigned*)(ldsl + (LDS_BYTES - 64));
    if (threadIdx.x < 2) bst[threadIdx.x] = 0u;
    __syncthreads();
    XcdBarrier bar = xcd_barrier_post((unsigned*)(ws + WS_BAR), bst);
#if !MK_MULTI_LAUNCH
    if (a.ph_hi - a.ph_lo > 1) grid.sync();
#endif
    for (int ph = a.ph_lo; ph < a.ph_hi; ++ph) {
        if (ph != a.ph_lo) xcd_barrier(bar);
        if (ph == N_PHASES - 1) { phase_final(a, G); continue; }
        const int l = ph / PH_PER_LAYER, k = ph % PH_PER_LAYER;
#ifdef PROBE_K
        for (int rep = 0; rep < ((k == PROBE_K) ? 2 : 1); ++rep) {
        if (rep) xcd_barrier(bar);
#endif
        if (k == 0) {
#ifndef NO_PREP
            phase_prep(a, l, lds, G);
#endif
        } else if (k == 1 || k == 10) {
            const int second = (k == 10);
            pg8::Gemm g{(const bf16_t*)(ws + WS_XB), (const bf16_t*)(ws + (second ? WS_W2U : WS_W1U)), T, 2 * FF, DM, DM, DM};
            pg8::StaticOrder S; S.init(T, 2 * FF, G, (int)blockIdx.x);
            pg8::EpiFfnUp E{(bf16_t*)(ws + WS_Z), rssb + (size_t)(3 * l + (second ? 2 : 0)) * T};
            pg8::gemm_phase(ldsl, g, S, E);
        } else if (k == 2 || k == 11) {
            const int second = (k == 11);
            pg8::Gemm g{(const bf16_t*)(ws + WS_Z), (const bf16_t*)(ws + (second ? WS_W2D : WS_W1D)), T, DM, FF, FF, FF};
            pg8::StaticOrder S; S.init(T, DM, G, (int)blockIdx.x);
            const float* xin = (l == 0 && !second) ? a.in[I_X] : a.out;
            pg8::EpiResid E{xin, a.out, (bf16_t*)(ws + WS_XB), rssb + (size_t)(3 * l + (second ? 3 : 1)) * T, 0.5f};
            pg8::gemm_phase(ldsl, g, S, E);
        } else if (k == 3) {
            pg8::Gemm g{(const bf16_t*)(ws + WS_XB), (const bf16_t*)(ws + WS_WIN), T, ZW, DM, DM, DM};
            pg8::StaticOrder S; S.init(T, ZW, G, (int)blockIdx.x);
            pg8::EpiWin E{(bf16_t*)(ws + WS_Z), rssb + (size_t)(3 * l + 1) * T};
            pg8::gemm_phase(ldsl, g, S, E);
#ifndef NO_GLR
            phase_glr(a, rssb + (size_t)(3 * l + 1) * T, G);
#endif
        } else if (k == 4) {
#ifndef NO_GLA
            for (int u = blockIdx.x; u < 1024; u += G) gla_kv_unit(a, l, lds, u);
#endif
#ifndef NO_SSM
            for (int u = G - 1 - (int)blockIdx.x; u < 128; u += G) ssm_end_unit(a, u);
#endif
#ifndef NO_POOL
            phase_pool(a, G);
#endif
        } else if (k == 5) {
#ifndef NO_GLA
            gla_scan(a, G);
#endif
#ifndef NO_SSM
            { const int id = (G - 1 - (int)blockIdx.x) * 512 + otid(); if (id < 8192) ssm_scan(a, id); }
#endif
        } else if (k == 6) {
#ifndef NO_GLA
            for (int u = blockIdx.x; u < 1024; u += G) gla_out_unit(a, l, lds, u);
#endif
#ifndef NO_SSM
            for (int u = blockIdx.x; u < 512; u += G) ssm_out_unit(a, u);
#endif
        } else if (k == 7) {
            pg8::Gemm g{(const bf16_t*)(ws + WS_YS), (const bf16_t*)(ws + WS_WGLU), T, 512, 512, 512, 512};
            pg8::StaticOrder S; S.init(T, 512, G, (int)blockIdx.x);
            pg8::EpiGlu E{(const bf16_t*)(ws + WS_YS), (bf16_t*)(ws + WS_Y)};
            pg8::gemm_phase(ldsl, g, S, E);
        } else if (k == 8) {
            const bf16_t* Y = (const bf16_t*)(ws + WS_Y); const bf16_t* Wb = (const bf16_t*)(ws + WS_WBR); const bf16_t* Zg = (const bf16_t*)(ws + WS_Z) + ZC_G;
            pg8::StaticOrder S; S.init(T, DM, G, (int)blockIdx.x);
            { pg8::Gemm g{Y, Wb, T, DM, 512, DM, DM}; pg8::EpiBranch E{Zg, (bf16_t*)(ws + WS_MB), 0}; pg8::gemm_phase(ldsl, g, S, E); }
            { pg8::Gemm g{Y + 512, Wb + 512, T, DM, 1024, DM, DM}; pg8::EpiBranch E{Zg + 2048, (bf16_t*)(ws + WS_MB), 1}; pg8::gemm_phase(ldsl, g, S, E); }
            { pg8::Gemm g{Y + 1536, Wb + 1536, T, DM, 512, DM, DM}; pg8::EpiBranch E{Zg + 4096, (bf16_t*)(ws + WS_MB), 1}; pg8::gemm_phase(ldsl, g, S, E); }
        } else if (k == 9) {
            pg8::Gemm g{(const bf16_t*)(ws + WS_MB), (const bf16_t*)(ws + WS_WO), T, DM, DM, DM, DM};
            pg8::StaticOrder S; S.init(T, DM, G, (int)blockIdx.x);
            pg8::EpiResid E{a.out, a.out, (bf16_t*)(ws + WS_XB), rssb + (size_t)(3 * l + 2) * T, 1.0f};
            pg8::gemm_phase(ldsl, g, S, E);
        }
#ifdef PROBE_K
        }
#endif
    }
}

extern "C" void kernel_launch(void* const* d_in, const int* in_sizes, int n_in, void* d_out, int out_size, void* d_ws, size_t ws_size, hipStream_t stream) {
    static int grid = 0;
    if (grid == 0) {
        if (n_in != 28 || in_sizes[0] != T * DM || out_size != T * DM || ws_size < WS_END) {
            fprintf(stderr, "kernel_launch: unexpected problem (n_in %d, in0 %d, out %d, ws %zu, need %zu)\n", n_in, n_in > 0 ? in_sizes[0] : -1, out_size, ws_size, (size_t)WS_END);
            grid = -1; return;
        }
        int dev = 0, cus = 0, per_cu = 0;
        hipGetDevice(&dev);
        hipDeviceGetAttribute(&cus, hipDeviceAttributeMultiprocessorCount, dev);
        hipFuncSetAttribute((const void*)mega_fwd, hipFuncAttributeMaxDynamicSharedMemorySize, LDS_BYTES);
        hipOccupancyMaxActiveBlocksPerMultiprocessor(&per_cu, (const void*)mega_fwd, 512, LDS_BYTES);
        if (per_cu < 1) per_cu = 1;
        if (per_cu > 1) per_cu = 1;
        grid = cus * per_cu;
        (void)hipGetLastError();
    }
    if (grid < 0) return;
    Args a{};
    for (int i = 0; i < 28; ++i) a.in[i] = (const float*)d_in[i];
    a.out = (float*)d_out; a.ws = (unsigned char*)d_ws;
    (void)hipMemsetAsync((char*)d_ws + WS_BAR, 0, 16384, stream);
#if MK_MULTI_LAUNCH
    for (int ph = 0; ph < N_PHASES; ++ph) {
        a.ph_lo = ph; a.ph_hi = ph + 1;
        hipLaunchKernelGGL(mega_fwd, dim3(grid), dim3(512), LDS_BYTES, stream, a);
    }
#else
    a.ph_lo = 0; a.ph_hi = N_PHASES;
    void* args[] = {&a};
    hipError_t e = hipLaunchCooperativeKernel((const void*)mega_fwd, dim3(grid), dim3(512), args, LDS_BYTES, stream);
    if (e != hipSuccess) fprintf(stderr, "cooperative launch failed: %s (grid %d)\n", hipGetErrorString(e), grid);
#endif
}
```

```cpp
#include <hip/hip_runtime.h>
#include <hip/hip_cooperative_groups.h>
#include <cstdio>
#include <cstdint>
namespace cg = cooperative_groups;

#ifndef MK_MULTI_LAUNCH
#define MK_MULTI_LAUNCH 0
#endif

#define LAS __attribute__((address_space(3)))
typedef unsigned short bf16_t;
typedef short bf16x8 __attribute__((ext_vector_type(8)));
typedef float f32x4 __attribute__((ext_vector_type(4)));
typedef unsigned u32x4 __attribute__((ext_vector_type(4)));
typedef unsigned u32x2 __attribute__((ext_vector_type(2)));

constexpr int T = 16384, DM = 2048, FF = 5632, SEQ = 4096;
constexpr int ZW = 10240;
constexpr int ZC_POOL = 0, ZC_Q = 512, ZC_K = 1024, ZC_V = 1536, ZC_R = 2560, ZC_S = 3584, ZC_G = 4096;
constexpr int YC_GLA = 512, YC_SSM = 1536;
constexpr int INW = 10256;
constexpr float EPS = 1e-6f;

constexpr size_t MiB = 1u << 20;
constexpr size_t WS_RSS = 0;
constexpr size_t WS_BAR = 917504;
constexpr size_t WS_WGT = 1 * MiB;
constexpr size_t WS_L64 = 1 * MiB + 131072;
constexpr size_t WS_GLR = 2 * MiB;
constexpr size_t WS_DEC = 3 * MiB;
constexpr size_t WS_KT = 4 * MiB;
constexpr size_t WS_E = 5 * MiB;
constexpr size_t WS_HC = 9 * MiB;
constexpr size_t WS_MET = 11 * MiB;
constexpr size_t WS_MCT = 19 * MiB;
constexpr size_t WS_YS = 27 * MiB;
constexpr size_t WS_W1U = 43 * MiB, WS_W1D = 87 * MiB, WS_WIN = 109 * MiB, WS_WBR = 149 * MiB, WS_WO = 157 * MiB, WS_WGLU = 165 * MiB;
constexpr size_t WS_W2U = 166 * MiB, WS_W2D = 210 * MiB;
constexpr size_t WS_XB = 232 * MiB, WS_Y = 296 * MiB, WS_MB = 360 * MiB, WS_KV = 424 * MiB, WS_Z = 488 * MiB, WS_END = 808 * MiB;

constexpr int LDS_BYTES = 147456;

__device__ __forceinline__ unsigned f2bf(float f) { unsigned u = __float_as_uint(f); return (u + 0x7fffu + ((u >> 16) & 1u)) >> 16; }
__device__ __forceinline__ float bf2f(unsigned short b) { return __uint_as_float(((unsigned)b) << 16); }
__device__ __forceinline__ unsigned pk2(float lo, float hi) { return f2bf(lo) | (f2bf(hi) << 16); }
__device__ __forceinline__ float bflo(unsigned w) { return __uint_as_float(w << 16); }
__device__ __forceinline__ float bfhi(unsigned w) { return __uint_as_float(w & 0xffff0000u); }
__device__ __forceinline__ float wave_sum(float v) {
#pragma unroll
    for (int o = 1; o < 64; o <<= 1) v += __shfl_xor(v, o);
    return v;
}
__device__ __forceinline__ float sigmoid_f(float x) { return __builtin_amdgcn_rcpf(1.f + __expf(-x)); }
__device__ __forceinline__ float gelu_tanh_f(float x) {
    const float u = 0.7978845608028654f * (x + 0.044715f * x * x * x);
    const float t = 1.f - 2.f * __builtin_amdgcn_rcpf(1.f + __expf(2.f * u));
    return 0.5f * x * (1.f + t);
}
#define LDS_WAIT() asm volatile("s_waitcnt lgkmcnt(0)" ::: "memory")
__device__ __forceinline__ int otid() { int t = threadIdx.x; asm volatile("" : "+v"(t)); return t; }
__device__ __forceinline__ f32x4 mfma16(bf16x8 a, bf16x8 b, f32x4 c) { return __builtin_amdgcn_mfma_f32_16x16x32_bf16(a, b, c, 0, 0, 0); }

namespace pg8 {
constexpr int BM = 256, BK = 64, HALF = 128, HTB = HALF * BK * 2, STAGE_BYTES = 8 * HTB, NXCD = 8, WGM = 8;
__host__ __device__ __forceinline__ int lds_byte(int r, int c) { const int st = (r >> 4) * 2 + (c >> 5), rr = r & 15, cc = c & 31, ob = rr * 64 + cc * 2; return st * 1024 + (ob ^ (((ob >> 9) & 1) << 5)); }
__host__ __device__ __forceinline__ void stage_rc(int b, int& R, int& C) { const int st = b / 1024, sb = b % 1024, swz = sb ^ (((sb >> 9) & 1) << 5); R = (st >> 1) * 16 + swz / 64; C = (st & 1) * 32 + (swz % 64) / 2; }
__host__ __device__ __forceinline__ int perm32(int rho) { const int n = rho >> 4, i = rho & 15; return 8 * (i >> 2) + 4 * n + (i & 3); }

struct Unit { int pm, pn; };
struct Gemm { const bf16_t* A; const bf16_t* Bt; int M, N, K, lda, ldb; };

struct StaticOrder {
    int nM, nN, nwg, G, c;
    __device__ void init(int M, int N, int G_, int c_) { nM = M / BM; nN = N / BM; nwg = nM * nN; G = G_; c = c_; }
    __device__ bool next(int i, Unit& u) const {
        const long L = (long)i * G + c; if (L >= nwg) return false;
        int wgid = (int)L; { const int q = nwg / NXCD, r = nwg % NXCD, xcd = wgid % NXCD, off = wgid / NXCD; wgid = (xcd < r ? xcd * (q + 1) : r * (q + 1) + (xcd - r) * q) + off; }
        const int nig = WGM * nN, gid = wgid / nig, fm = gid * WGM, gsz = (nM - fm) < WGM ? (nM - fm) : WGM;
        u.pm = fm + ((wgid % nig) % gsz); u.pn = (wgid % nig) / gsz; return true;
    }
};

template <class Epi>
__device__ __forceinline__ void gemm_phase(LAS unsigned char* lds, const Gemm g, const StaticOrder& S, const Epi& E) {
    const int tid = otid(), wid = __builtin_amdgcn_readfirstlane(tid >> 6), lane = tid & 63, wr = wid >> 2, wc = wid & 3, fr = lane & 15, fq = lane >> 4;
    const int nt = g.K / BK;
    unsigned voffA[2], voffB[2];
#pragma unroll
    for (int i = 0; i < 2; ++i) { int R, C; stage_rc(tid * 16 + i * 8192, R, C); const int Rb = (R & ~31) + perm32(R & 31);
        voffA[i] = (unsigned)(R * g.lda + C) * 2u; voffB[i] = (unsigned)(Rb * g.ldb + C) * 2u; }
    const size_t kstep = (size_t)(BK * 2);
    const size_t hstepA = (size_t)HALF * g.lda * 2, hstepB = (size_t)HALF * g.ldb * 2;
    const size_t tstepA = 2 * hstepA, tstepB = 2 * hstepB;
    const unsigned ldsw = (unsigned)wid * 1024u;
    const int aoff = lds_byte(wr * 64 + fr, fq * 8), boff = lds_byte(wc * 32 + fr, fq * 8);
#define PG8_SA(b, h) (((b) * 2 + (h)) * HTB)
#define PG8_SB(b, h) ((4 + (b) * 2 + (h)) * HTB)
#define PG8_STAGE(bufoff, gbase, voff) do { _Pragma("unroll") for (int _i = 0; _i < 2; ++_i) \
        __builtin_amdgcn_global_load_lds((const unsigned*)((const char*)(gbase) + (voff)[_i]), (LAS unsigned*)(lds + (bufoff) + ldsw + _i * 8192), 16, 0, 0); } while (0)
#define PG8_LDA(dst, b, h) do { _Pragma("unroll") for (int m = 0; m < 4; ++m) _Pragma("unroll") for (int k = 0; k < 2; ++k) dst[m][k] = *(const LAS bf16x8*)(lds + PG8_SA(b, h) + aoff + m * 2048 + k * 1024); } while (0)
#define PG8_LDB(dst, b, h) do { _Pragma("unroll") for (int n = 0; n < 2; ++n) _Pragma("unroll") for (int k = 0; k < 2; ++k) dst[n][k] = *(const LAS bf16x8*)(lds + PG8_SB(b, h) + boff + n * 2048 + k * 1024); } while (0)
#define PG8_MMA(ai, bj, At, Bt) do { __builtin_amdgcn_s_setprio(1); _Pragma("unroll") for (int m = 0; m < 4; ++m) _Pragma("unroll") for (int n = 0; n < 2; ++n) _Pragma("unroll") for (int k = 0; k < 2; ++k) \
        acc[ai][bj][m][n] = __builtin_amdgcn_mfma_f32_16x16x32_bf16(Bt[n][k], At[m][k], acc[ai][bj][m][n], 0, 0, 0); __builtin_amdgcn_s_setprio(0); } while (0)
#define PG8_WAIT_V(n) asm volatile("s_waitcnt vmcnt(" #n ")" ::: "memory")
#define PG8_WAIT_L(n) asm volatile("s_waitcnt lgkmcnt(" #n ")" ::: "memory")
#define PG8_BAR __builtin_amdgcn_s_barrier()
#define PG8_SCHED __builtin_amdgcn_sched_barrier(0)
    Unit cur, nxt; int ui = 0;
    if (!S.next(0, cur)) return;
    f32x4 acc[2][2][4][2];
#pragma unroll
    for (int a = 0; a < 2; ++a)
#pragma unroll
        for (int b = 0; b < 2; ++b)
#pragma unroll
            for (int m = 0; m < 4; ++m)
#pragma unroll
                for (int n = 0; n < 2; ++n) acc[a][b][m][n] = (f32x4){0.f, 0.f, 0.f, 0.f};
    bf16x8 At[4][2], B0[2][2], B1[2][2];
    const char* cA = (const char*)g.A + (size_t)cur.pm * tstepA; const char* cB = (const char*)g.Bt + (size_t)cur.pn * tstepB;
    PG8_STAGE(PG8_SB(0, 0), cB, voffB); PG8_STAGE(PG8_SB(0, 1), cB + hstepB, voffB); PG8_STAGE(PG8_SA(0, 0), cA, voffA); PG8_STAGE(PG8_SA(0, 1), cA + hstepA, voffA);
    if (wr == 1) PG8_BAR;
    PG8_WAIT_V(2); PG8_BAR;
    PG8_STAGE(PG8_SB(1, 0), cB + kstep, voffB); PG8_STAGE(PG8_SA(1, 0), cA + kstep, voffA); PG8_STAGE(PG8_SB(1, 1), cB + hstepB + kstep, voffB);
    PG8_WAIT_V(6); PG8_BAR;
    for (;;) {
        const bool has_next = S.next(ui + 1, nxt);
        const char* nA = has_next ? (const char*)g.A + (size_t)nxt.pm * tstepA : cA; const char* nB = has_next ? (const char*)g.Bt + (size_t)nxt.pn * tstepB : cB;
        for (int t = 0; t < nt; t += 2) {
            const bool last = (t == nt - 2);
            const char* a1 = cA + (size_t)(t + 1) * kstep;
            const char* a2 = last ? nA : cA + (size_t)(t + 2) * kstep; const char* b2 = last ? nB : cB + (size_t)(t + 2) * kstep;
            const char* a3 = a2 + kstep; const char* b3 = b2 + kstep;
            PG8_LDB(B0, 0, 0); PG8_LDB(B1, 0, 1); PG8_SCHED; PG8_LDA(At, 0, 0); PG8_STAGE(PG8_SA(1, 1), a1 + hstepA, voffA);
            PG8_WAIT_V(8); PG8_WAIT_L(0); PG8_BAR; PG8_MMA(0, 0, At, B0); PG8_MMA(0, 1, At, B1); PG8_BAR; PG8_SCHED;
            PG8_LDA(At, 0, 1); PG8_STAGE(PG8_SB(0, 0), b2, voffB); PG8_STAGE(PG8_SB(0, 1), b2 + hstepB, voffB); PG8_STAGE(PG8_SA(0, 0), a2, voffA);
            PG8_WAIT_V(8); PG8_WAIT_L(0); PG8_BAR; PG8_MMA(1, 0, At, B0); PG8_MMA(1, 1, At, B1); PG8_BAR; PG8_SCHED;
            PG8_LDB(B0, 1, 0); PG8_LDB(B1, 1, 1); PG8_SCHED; PG8_LDA(At, 1, 0); PG8_STAGE(PG8_SA(0, 1), a2 + hstepA, voffA);
            PG8_WAIT_V(8); PG8_WAIT_L(0); PG8_BAR; PG8_MMA(0, 0, At, B0); PG8_MMA(0, 1, At, B1); PG8_BAR; PG8_SCHED;
            PG8_LDA(At, 1, 1); PG8_STAGE(PG8_SB(1, 0), b3, voffB); PG8_STAGE(PG8_SB(1, 1), b3 + hstepB, voffB); PG8_STAGE(PG8_SA(1, 0), a3, voffA);
            PG8_WAIT_V(8); PG8_WAIT_L(0); PG8_BAR; PG8_MMA(1, 0, At, B0); PG8_MMA(1, 1, At, B1); PG8_BAR; PG8_SCHED;
        }
        if (wr == 0) PG8_BAR;
        E(acc, cur, wr, wc, fr, fq);
        if (!has_next) break;
#pragma unroll
        for (int a = 0; a < 2; ++a)
#pragma unroll
            for (int b = 0; b < 2; ++b)
#pragma unroll
                for (int m = 0; m < 4; ++m)
#pragma unroll
                    for (int n = 0; n < 2; ++n) acc[a][b][m][n] = (f32x4){0.f, 0.f, 0.f, 0.f};
        cur = nxt; cA = nA; cB = nB; ++ui;
        if (wr == 1) PG8_BAR;
    }
    PG8_WAIT_V(0);
    PG8_BAR;
#undef PG8_SA
#undef PG8_SB
#undef PG8_STAGE
#undef PG8_LDA
#undef PG8_LDB
#undef PG8_MMA
#undef PG8_WAIT_V
#undef PG8_WAIT_L
#undef PG8_BAR
#undef PG8_SCHED
}

typedef const f32x4 (&AccRef)[2][2][4][2];

struct EpiFfnUp {
    bf16_t* H; const unsigned long long* rss;
    __device__ __forceinline__ void operator()(AccRef acc, const Unit& u, int wr, int wc, int fr, int fq) const {
        const int row0 = u.pm * BM + wr * 64 + fr, col0 = u.pn * 128 + wc * 32 + 8 * fq;
#pragma unroll
        for (int ai = 0; ai < 2; ++ai)
#pragma unroll
            for (int m = 0; m < 4; ++m) {
                const int row = row0 + ai * HALF + m * 16;
                const float rinv = rsqrtf((float)rss[row] * (1.f / (16777216.f * DM)) + EPS);
                float h[8];
#pragma unroll
                for (int n = 0; n < 2; ++n)
#pragma unroll
                    for (int j = 0; j < 4; ++j) { const float gg = acc[ai][0][m][n][j] * rinv, uu = acc[ai][1][m][n][j] * rinv; h[n * 4 + j] = gg * uu * sigmoid_f(gg); }
                u32x4 o; o.x = pk2(h[0], h[1]); o.y = pk2(h[2], h[3]); o.z = pk2(h[4], h[5]); o.w = pk2(h[6], h[7]);
                *(u32x4*)(H + (size_t)row * FF + col0) = o;
            }
    }
};
struct EpiWin {
    bf16_t* Z; const unsigned long long* rss;
    __device__ __forceinline__ void operator()(AccRef acc, const Unit& u, int wr, int wc, int fr, int fq) const {
        const int row0 = u.pm * BM + wr * 64 + fr, col0 = u.pn * BM + wc * 32 + 8 * fq;
        const bool sg = u.pn >= 16;
#pragma unroll
        for (int ai = 0; ai < 2; ++ai)
#pragma unroll
            for (int m = 0; m < 4; ++m) {
                const int row = row0 + ai * HALF + m * 16;
                const float rinv = rsqrtf((float)rss[row] * (1.f / (16777216.f * DM)) + EPS);
#pragma unroll
                for (int bj = 0; bj < 2; ++bj) {
                    float h[8];
#pragma unroll
                    for (int n = 0; n < 2; ++n)
#pragma unroll
                        for (int j = 0; j < 4; ++j) { const float v = acc[ai][bj][m][n][j] * rinv; h[n * 4 + j] = sg ? sigmoid_f(v) : v; }
                    u32x4 o; o.x = pk2(h[0], h[1]); o.y = pk2(h[2], h[3]); o.z = pk2(h[4], h[5]); o.w = pk2(h[6], h[7]);
                    *(u32x4*)(Z + (size_t)row * ZW + col0 + bj * HALF) = o;
                }
            }
    }
};
struct EpiResid {
    const float* xin; float* xout; bf16_t* XB; unsigned long long* rssn; float scale;
    __device__ __forceinline__ void operator()(AccRef acc, const Unit& u, int wr, int wc, int fr, int fq) const {
        const int row0 = u.pm * BM + wr * 64 + fr, col0 = u.pn * BM + wc * 32 + 8 * fq;
#pragma unroll
        for (int ai = 0; ai < 2; ++ai)
#pragma unroll
            for (int m = 0; m < 4; ++m) {
                const int row = row0 + ai * HALF + m * 16;
                float ss = 0.f;
#pragma unroll
                for (int bj = 0; bj < 2; ++bj) {
                    const size_t off = (size_t)row * DM + col0 + bj * HALF;
                    f32x4 x0 = *(const f32x4*)(xin + off), x1 = *(const f32x4*)(xin + off + 4);
                    x0 = x0 + acc[ai][bj][m][0] * scale; x1 = x1 + acc[ai][bj][m][1] * scale;
                    *(f32x4*)(xout + off) = x0; *(f32x4*)(xout + off + 4) = x1;
                    u32x4 o; o.x = pk2(x0[0], x0[1]); o.y = pk2(x0[2], x0[3]); o.z = pk2(x1[0], x1[1]); o.w = pk2(x1[2], x1[3]);
                    *(u32x4*)(XB + off) = o;
                    ss += x0[0] * x0[0] + x0[1] * x0[1] + x0[2] * x0[2] + x0[3] * x0[3] + x1[0] * x1[0] + x1[1] * x1[1] + x1[2] * x1[2] + x1[3] * x1[3];
                }
                ss += __shfl_xor(ss, 16); ss += __shfl_xor(ss, 32);
                if (fq == 0) atomicAdd(rssn + row, (unsigned long long)(ss * 16777216.f));
            }
    }
};
struct EpiBranch {
    const bf16_t* G; bf16_t* MB; int accum;
    __device__ __forceinline__ void operator()(AccRef acc, const Unit& u, int wr, int wc, int fr, int fq) const {
        const int row0 = u.pm * BM + wr * 64 + fr, col0 = u.pn * BM + wc * 32 + 8 * fq;
#pragma unroll
        for (int ai = 0; ai < 2; ++ai)
#pragma unroll
            for (int m = 0; m < 4; ++m) {
                const int row = row0 + ai * HALF + m * 16;
#pragma unroll
                for (int bj = 0; bj < 2; ++bj) {
                    const int col = col0 + bj * HALF;
                    const u32x4 gv = *(const u32x4*)(G + (size_t)row * ZW + col);
                    u32x4 pv = (u32x4){0u, 0u, 0u, 0u};
                    if (accum) pv = *(const u32x4*)(MB + (size_t)row * DM + col);
                    const f32x4 a0 = acc[ai][bj][m][0], a1 = acc[ai][bj][m][1];
                    u32x4 o;
                    o.x = pk2(bflo(pv.x) + bflo(gv.x) * a0[0], bfhi(pv.x) + bfhi(gv.x) * a0[1]);
                    o.y = pk2(bflo(pv.y) + bflo(gv.y) * a0[2], bfhi(pv.y) + bfhi(gv.y) * a0[3]);
                    o.z = pk2(bflo(pv.z) + bflo(gv.z) * a1[0], bfhi(pv.z) + bfhi(gv.z) * a1[1]);
                    o.w = pk2(bflo(pv.w) + bflo(gv.w) * a1[2], bfhi(pv.w) + bfhi(gv.w) * a1[3]);
                    *(u32x4*)(MB + (size_t)row * DM + col) = o;
                }
            }
    }
};
struct EpiGlu {
    const bf16_t* YS; bf16_t* Y;
    __device__ __forceinline__ void operator()(AccRef acc, const Unit& u, int wr, int wc, int fr, int fq) const {
        const int row0 = u.pm * BM + wr * 64 + fr, col0 = u.pn * BM + wc * 32 + 8 * fq;
#pragma unroll
        for (int ai = 0; ai < 2; ++ai)
#pragma unroll
            for (int m = 0; m < 4; ++m) {
                const int row = row0 + ai * HALF + m * 16;
#pragma unroll
                for (int bj = 0; bj < 2; ++bj) {
                    const int col = col0 + bj * HALF;
                    const u32x4 yv = *(const u32x4*)(YS + (size_t)row * 512 + col);
                    const f32x4 a0 = acc[ai][bj][m][0], a1 = acc[ai][bj][m][1];
                    u32x4 o;
                    o.x = pk2(bflo(yv.x) * sigmoid_f(a0[0]), bfhi(yv.x) * sigmoid_f(a0[1]));
                    o.y = pk2(bflo(yv.y) * sigmoid_f(a0[2]), bfhi(yv.y) * sigmoid_f(a0[3]));
                    o.z = pk2(bflo(yv.z) * sigmoid_f(a1[0]), bfhi(yv.z) * sigmoid_f(a1[1]));
                    o.w = pk2(bflo(yv.w) * sigmoid_f(a1[2]), bfhi(yv.w) * sigmoid_f(a1[3]));
                    *(u32x4*)(Y + (size_t)row * DM + YC_SSM + col) = o;
                }
            }
    }
};
}

struct Args { const float* in[28]; float* out; unsigned char* ws; int ph_lo, ph_hi; };
enum { I_X = 0, I_F1N, I_F1G, I_F1U, I_F1D, I_MIXN, I_WIN, I_POOLW, I_POOLS, I_GW2, I_GB, I_GNORM, I_ARE, I_AIM, I_LDT, I_BRE, I_BIM, I_CRE, I_CIM,
       I_SD, I_WGLU, I_WBR, I_WOUT, I_F2N, I_F2G, I_F2U, I_F2D, I_FINN };

__device__ __forceinline__ void tr_item(const float* W, int ldw, int col0, const float* ksc, bf16_t* WT, int ldt, int drow, int k0, int n0, unsigned* scr, int lane) {
    const int a = lane & 15, b = lane >> 4;
    const float* src = W + (size_t)(k0 + 2 * b) * ldw + col0 + n0 + a * 4;
    f32x4 v[16];
#pragma unroll
    for (int m = 0; m < 8; ++m) { v[2 * m] = *(const f32x4*)(src + (size_t)(8 * m) * ldw); v[2 * m + 1] = *(const f32x4*)(src + (size_t)(8 * m + 1) * ldw); }
#pragma unroll
    for (int m = 0; m < 8; ++m) {
        const float s0 = ksc ? ksc[k0 + 8 * m + 2 * b] : 1.f, s1 = ksc ? ksc[k0 + 8 * m + 2 * b + 1] : 1.f;
#pragma unroll
        for (int e = 0; e < 4; ++e) scr[(4 * a + e) * 32 + (((m ^ (a & 7)) << 2) | b)] = pk2(v[2 * m][e] * s0, v[2 * m + 1][e] * s1);
    }
    LDS_WAIT();
#pragma unroll
    for (int j = 0; j < 8; ++j) { const int n = (lane >> 3) + 8 * j, c = lane & 7;
        const u32x4 o = *(const u32x4*)(scr + n * 32 + ((c ^ ((n >> 2) & 7)) << 2));
        *(u32x4*)(WT + (size_t)(drow + n) * ldt + k0 + c * 8) = o; }
    LDS_WAIT();
}
__device__ __forceinline__ bool tr_try(int& r, const float* W, int ldw, int K, int N, int col0, const float* ksc, bf16_t* WT, int ldt, int drow0, int mode, unsigned* scr, int lane) {
    const int nblk = N / 64, items = (K / 64) * nblk;
    if (r >= items) { r -= items; return false; }
    const int kb = r / nblk, n0 = (r % nblk) * 64;
    const int drow = drow0 + (mode ? ((n0 >> 7) * 256 + (n0 & 127)) : n0);
    tr_item(W, ldw, col0, ksc, WT, ldt, drow, kb * 64, n0, scr, lane);
    return true;
}

__device__ __forceinline__ void cpow_d(double th, double la, int j, double& pr, double& pi) {
    const double y = th * (double)j;
    const double kq = __builtin_rint(y * 0.63661977236758134308);
    double r = __builtin_fma(-kq, 1.57079632679489655800, y); r = __builtin_fma(-kq, 6.12323399573676603587e-17, r);
    const double r2 = r * r;
    double s = 1.0 - r2 * (1.0 / 272.0); s = 1.0 - r2 * (1.0 / 210.0) * s; s = 1.0 - r2 * (1.0 / 156.0) * s; s = 1.0 - r2 * (1.0 / 110.0) * s; s = 1.0 - r2 * (1.0 / 72.0) * s; s = 1.0 - r2 * (1.0 / 42.0) * s; s = 1.0 - r2 * (1.0 / 20.0) * s; s = 1.0 - r2 * (1.0 / 6.0) * s; s *= r;
    double c = 1.0 - r2 * (1.0 / 240.0); c = 1.0 - r2 * (1.0 / 182.0) * c; c = 1.0 - r2 * (1.0 / 132.0) * c; c = 1.0 - r2 * (1.0 / 90.0) * c; c = 1.0 - r2 * (1.0 / 56.0) * c; c = 1.0 - r2 * (1.0 / 30.0) * c; c = 1.0 - r2 * (1.0 / 12.0) * c; c = 1.0 - r2 * (1.0 / 2.0) * c;
    const int q = ((int)kq) & 3;
    double sn = s, cs = c;
    if (q == 1) { sn = c; cs = -s; } else if (q == 2) { sn = -s; cs = -c; } else if (q == 3) { sn = -c; cs = s; }
    const double x = la * (double)j * (1.0 * (1.0 / 64.0));
    double e = 1.0 + x * (1.0 / 10.0); e = 1.0 + x * (1.0 / 9.0) * e; e = 1.0 + x * (1.0 / 8.0) * e; e = 1.0 + x * (1.0 / 7.0) * e; e = 1.0 + x * (1.0 / 6.0) * e; e = 1.0 + x * (1.0 / 5.0) * e; e = 1.0 + x * (1.0 / 4.0) * e; e = 1.0 + x * (1.0 / 3.0) * e; e = 1.0 + x * (1.0 / 2.0) * e; e = 1.0 + x * e;
#pragma unroll
    for (int i = 0; i < 6; ++i) e = e * e;
    pr = e * cs; pi = e * sn;
}

__device__ __forceinline__ void phase_prep(const Args& a, int l, unsigned char* lds, int G) {
    const int tid = otid(), lane = tid & 63, wave = tid >> 6;
    unsigned char* ws = a.ws;
    const int gw = blockIdx.x * 8 + wave, NGW = G * 8;
    unsigned* scr = (unsigned*)(lds + wave * 16384);
    const float* f1n = a.in[I_F1N] + (size_t)l * DM; const float* f2n = a.in[I_F2N] + (size_t)l * DM; const float* mxn = a.in[I_MIXN] + (size_t)l * DM;
    const float* f1g = a.in[I_F1G] + (size_t)l * DM * FF; const float* f1u = a.in[I_F1U] + (size_t)l * DM * FF; const float* f1d = a.in[I_F1D] + (size_t)l * FF * DM;
    const float* f2g = a.in[I_F2G] + (size_t)l * DM * FF; const float* f2u = a.in[I_F2U] + (size_t)l * DM * FF; const float* f2d = a.in[I_F2D] + (size_t)l * FF * DM;
    const float* win = a.in[I_WIN] + (size_t)l * DM * INW; const float* wbr = a.in[I_WBR] + (size_t)l * DM * DM; const float* wout = a.in[I_WOUT] + (size_t)l * DM * DM;
    const float* wglu = a.in[I_WGLU] + (size_t)l * 512 * 512;
    constexpr int IT_FU = (DM / 64) * (FF / 64), IT_FD = (FF / 64) * (DM / 64), IT_WA = (DM / 64) * (3584 / 64), IT_WB = (DM / 64) * (6656 / 64),
                  IT_BR = (1536 / 64) * (DM / 64), IT_WO = (DM / 64) * (DM / 64), IT_GL = (512 / 64) * (512 / 64);
    constexpr int IT_TOTAL = 4 * IT_FU + 2 * IT_FD + IT_WA + IT_WB + IT_BR + IT_WO + IT_GL;
    for (int it = gw; it < IT_TOTAL; it += NGW) {
        int r = it;
        if (tr_try(r, f1g, FF, DM, FF, 0, f1n, (bf16_t*)(ws + WS_W1U), DM, 0, 1, scr, lane)) continue;
        if (tr_try(r, f1u, FF, DM, FF, 0, f1n, (bf16_t*)(ws + WS_W1U), DM, 128, 1, scr, lane)) continue;
        if (tr_try(r, f2g, FF, DM, FF, 0, f2n, (bf16_t*)(ws + WS_W2U), DM, 0, 1, scr, lane)) continue;
        if (tr_try(r, f2u, FF, DM, FF, 0, f2n, (bf16_t*)(ws + WS_W2U), DM, 128, 1, scr, lane)) continue;
        if (tr_try(r, f1d, DM, FF, DM, 0, nullptr, (bf16_t*)(ws + WS_W1D), FF, 0, 0, scr, lane)) continue;
        if (tr_try(r, f2d, DM, FF, DM, 0, nullptr, (bf16_t*)(ws + WS_W2D), FF, 0, 0, scr, lane)) continue;
        if (tr_try(r, win, INW, DM, 3584, 0, mxn, (bf16_t*)(ws + WS_WIN), DM, 0, 0, scr, lane)) continue;
        if (tr_try(r, win, INW, DM, 6656, 3600, mxn, (bf16_t*)(ws + WS_WIN), DM, 3584, 0, scr, lane)) continue;
        if (tr_try(r, wbr + (size_t)512 * DM, DM, 1536, DM, 0, nullptr, (bf16_t*)(ws + WS_WBR) + 512, DM, 0, 0, scr, lane)) continue;
        if (tr_try(r, wout, DM, DM, DM, 0, nullptr, (bf16_t*)(ws + WS_WO), DM, 0, 0, scr, lane)) continue;
        tr_try(r, wglu, 512, 512, 512, 0, nullptr, (bf16_t*)(ws + WS_WGLU), 512, 0, 0, scr, lane);
    }
    {
        const float* pw = a.in[I_POOLW] + (size_t)l * 4 * 128 * 128; const float* ps = a.in[I_POOLS] + (size_t)l * 512;
        bf16_t* WbT = (bf16_t*)(ws + WS_WBR);
        for (int n = blockIdx.x; n < DM; n += G) {
            const int k = tid, g = k >> 7;
            const float* pr = pw + (size_t)k * 128;
            float s = 0.f;
#pragma unroll 8
            for (int d = 0; d < 128; ++d) s += pr[d] * ps[g * 128 + d] * wbr[(size_t)(g * 128 + d) * DM + n];
            WbT[(size_t)n * DM + k] = (bf16_t)f2bf(s);
        }
    }
    {
        bf16_t* WGT = (bf16_t*)(ws + WS_WGT);
        for (int i = blockIdx.x * 512 + tid; i < 16 * DM; i += G * 512) { const int j = i >> 11, k = i & 2047; WGT[i] = (bf16_t)f2bf(mxn[k] * win[(size_t)k * INW + 3584 + j]); }
    }
    {
        const float* are = a.in[I_ARE] + (size_t)l * 32 * 64; const float* aim = a.in[I_AIM] + (size_t)l * 32 * 64; const float* ldt = a.in[I_LDT] + (size_t)l * 32;
        const float* bre = a.in[I_BRE] + (size_t)l * 32 * 64 * 16; const float* bim = a.in[I_BIM] + (size_t)l * 32 * 64 * 16;
        const float* cre = a.in[I_CRE] + (size_t)l * 32 * 16 * 64; const float* cim = a.in[I_CIM] + (size_t)l * 32 * 16 * 64;
        const float* sd = a.in[I_SD] + (size_t)l * 512;
        bf16_t* KT = (bf16_t*)(ws + WS_KT); bf16_t* MET = (bf16_t*)(ws + WS_MET); bf16_t* MCT = (bf16_t*)(ws + WS_MCT); float* L64 = (float*)(ws + WS_L64);
        float* s_pw = (float*)lds;
        float* s_f = s_pw + 128;
        float* s_bbr = s_f + 128;
        float* s_bbi = s_bbr + 1024;
        __syncthreads();
        for (int it = blockIdx.x; it < 32 * 65; it += G) {
            const int g = it / 65, j = it % 65;
            if (tid < 64) {
                const int p = tid;
                const double dt = (double)expf(ldt[g]);
                const double ar = (double)are[g * 64 + p], ai = (double)aim[g * 64 + p];
                double pr, pi, l1r, l1i;
                cpow_d(dt * ai, dt * ar, j, pr, pi);
                cpow_d(dt * ai, dt * ar, 1, l1r, l1i);
                const double den = ar * ar + ai * ai;
                const double fr = ((l1r - 1.0) * ar + l1i * ai) / den, fi = (l1i * ar - (l1r - 1.0) * ai) / den;
                s_pw[2 * p] = (float)pr; s_pw[2 * p + 1] = (float)pi; s_f[2 * p] = (float)fr; s_f[2 * p + 1] = (float)fi;
                if (j == 64) { L64[(g * 64 + p) * 2] = (float)pr; L64[(g * 64 + p) * 2 + 1] = (float)pi; }
            }
            __syncthreads();
#pragma unroll
            for (int i = 0; i < 2; ++i) { const int idx = tid + i * 512, p = idx >> 4; const float fr = s_f[2 * p], fi = s_f[2 * p + 1];
                const float br = bre[(size_t)g * 1024 + idx], bi = bim[(size_t)g * 1024 + idx];
                s_bbr[idx] = fr * br - fi * bi; s_bbi[idx] = fr * bi + fi * br; }
            __syncthreads();
            if (j < 64) {
                if (tid < 256) {
                    const int h = tid >> 4, hp = tid & 15; float s = 0.f;
                    for (int p = 0; p < 64; ++p) { const float cr = cre[(size_t)(g * 16 + h) * 64 + p], ci = cim[(size_t)(g * 16 + h) * 64 + p], pr = s_pw[2 * p], pi = s_pw[2 * p + 1];
                        const float wr = cr * pr - ci * pi, wi = cr * pi + ci * pr; s += wr * s_bbr[p * 16 + hp] - wi * s_bbi[p * 16 + hp]; }
                    if (j == 0 && h == hp) s += sd[g * 16 + h];
                    KT[((size_t)(g * 64 + j) * 16 + h) * 16 + hp] = (bf16_t)f2bf(s);
                }
#pragma unroll
                for (int i = 0; i < 2; ++i) { const int idx = tid + i * 512, p = idx >> 4, hp = idx & 15; const float pr = s_pw[2 * p], pi = s_pw[2 * p + 1], br = s_bbr[idx], bi = s_bbi[idx];
                    const int jp = 63 - j;
                    MET[((size_t)(g * 128 + p) * 64 + jp) * 16 + hp] = (bf16_t)f2bf(pr * br - pi * bi);
                    MET[((size_t)(g * 128 + 64 + p) * 64 + jp) * 16 + hp] = (bf16_t)f2bf(pr * bi + pi * br); }
            }
            if (j >= 1) {
                const int sp = j - 1;
#pragma unroll
                for (int i = 0; i < 2; ++i) { const int idx = tid + i * 512, h = idx >> 6, p = idx & 63; const float cr = cre[(size_t)(g * 16 + h) * 64 + p], ci = cim[(size_t)(g * 16 + h) * 64 + p], pr = s_pw[2 * p], pi = s_pw[2 * p + 1];
                    const size_t base = ((size_t)g * 1024 + sp * 16 + h) * 128;
                    MCT[base + p] = (bf16_t)f2bf(cr * pr - ci * pi); MCT[base + 64 + p] = (bf16_t)f2bf(-(cr * pi + ci * pr)); }
            }
            __syncthreads();
        }
    }
    if (l == 0) {
        const float* x = a.in[I_X]; bf16_t* XB = (bf16_t*)(ws + WS_XB); unsigned long long* rss = (unsigned long long*)(ws + WS_RSS);
        for (int row = gw; row < T; row += NGW) {
            const f32x4* xr = (const f32x4*)(x + (size_t)row * DM) + lane; u32x2* o = (u32x2*)(XB + (size_t)row * DM) + lane;
            float ss = 0.f;
#pragma unroll
            for (int i = 0; i < 8; ++i) { const f32x4 v = xr[64 * i]; ss += v[0] * v[0] + v[1] * v[1] + v[2] * v[2] + v[3] * v[3]; u32x2 w; w.x = pk2(v[0], v[1]); w.y = pk2(v[2], v[3]); o[64 * i] = w; }
            ss = wave_sum(ss);
            if (lane == 0) rss[row] = (unsigned long long)(ss * 16777216.f);
        }
        for (int i = blockIdx.x * 512 + tid; i < 6 * T; i += G * 512) rss[T + i] = 0ull;
    }
}

__device__ __forceinline__ void phase_glr(const Args& a, const unsigned long long* rss, int G) {
    const int tid = otid(), lane = tid & 63, wave = tid >> 6, r16 = lane & 15, quad = lane >> 4;
    const int gw = blockIdx.x * 8 + wave, NGW = G * 8;
    const bf16_t* XB = (const bf16_t*)(a.ws + WS_XB); const bf16_t* WGT = (const bf16_t*)(a.ws + WS_WGT); float* GLR = (float*)(a.ws + WS_GLR);
    for (int task = gw; task < T / 16; task += NGW) {
        const int r0 = task * 16;
        f32x4 acc = (f32x4){0.f, 0.f, 0.f, 0.f};
        const bf16_t* ap = XB + (size_t)(r0 + r16) * DM + quad * 8; const bf16_t* bp = WGT + (size_t)r16 * DM + quad * 8;
#pragma unroll 8
        for (int kb = 0; kb < 64; ++kb) acc = mfma16(*(const bf16x8*)(ap + kb * 32), *(const bf16x8*)(bp + kb * 32), acc);
#pragma unroll
        for (int i = 0; i < 4; ++i) { const int row = r0 + quad * 4 + i; GLR[(size_t)row * 16 + r16] = acc[i] * rsqrtf((float)rss[row] * (1.f / (16777216.f * DM)) + EPS); }
    }
}

template <int W>
__device__ __forceinline__ void pool_group(const bf16_t* Z, bf16_t* Y, int c00, int G) {
    for (int idx = blockIdx.x * 512 + otid(); idx < T * 16; idx += G * 512) {
        const int t = idx >> 4, c0 = c00 + (idx & 15) * 8, s = t & (SEQ - 1);
        const int cnt = (s + 1) < W ? (s + 1) : W;
        u32x4 v[W];
#pragma unroll
        for (int j = 0; j < W; ++j) { const int tj = (j < cnt) ? (t - j) : t; v[j] = *(const u32x4*)(Z + (size_t)tj * ZW + ZC_POOL + c0); }
        float sum[8];
#pragma unroll
        for (int i = 0; i < 8; ++i) sum[i] = 0.f;
#pragma unroll
        for (int j = 0; j < W; ++j) { const float m = (j < cnt) ? 1.f : 0.f;
            sum[0] += m * bflo(v[j].x); sum[1] += m * bfhi(v[j].x); sum[2] += m * bflo(v[j].y); sum[3] += m * bfhi(v[j].y);
            sum[4] += m * bflo(v[j].z); sum[5] += m * bfhi(v[j].z); sum[6] += m * bflo(v[j].w); sum[7] += m * bfhi(v[j].w); }
        const float inv = 1.f / (float)cnt;
        u32x4 o; o.x = pk2(sum[0] * inv - bflo(v[0].x), sum[1] * inv - bfhi(v[0].x)); o.y = pk2(sum[2] * inv - bflo(v[0].y), sum[3] * inv - bfhi(v[0].y));
        o.z = pk2(sum[4] * inv - bflo(v[0].z), sum[5] * inv - bfhi(v[0].z)); o.w = pk2(sum[6] * inv - bflo(v[0].w), sum[7] * inv - bfhi(v[0].w));
        *(u32x4*)(Y + (size_t)t * DM + c0) = o;
    }
}
__device__ __forceinline__ void phase_pool(const Args& a, int G) {
    const bf16_t* Z = (const bf16_t*)(a.ws + WS_Z); bf16_t* Y = (bf16_t*)(a.ws + WS_Y);
    pool_group<2>(Z, Y, 0, G); pool_group<4>(Z, Y, 128, G); pool_group<8>(Z, Y, 256, G); pool_group<16>(Z, Y, 384, G);
}

constexpr int OFF_BC = 0, OFF_QP = 32768, OFF_KP = 50176, OFF_OB = 0, OFF_QD = 67584, OFF_VT = 84992, OFF_PB = 121856, OFF_GL = 131072, OFF_TOT = 135168;
constexpr int PQ = 136, PV = 72, POB = 260;

__device__ __forceinline__ void gla_bc(const Args& a, int l, unsigned char* lds, int t0, int h) {
    const int tid = otid(), d = tid & 127, jq = tid >> 7;
    float* BC = (float*)(lds + OFF_BC); float* GL = (float*)(lds + OFF_GL); float* TOT = (float*)(lds + OFF_TOT);
    const float* GLR = (const float*)(a.ws + WS_GLR);
    const float* w2 = a.in[I_GW2] + (size_t)l * 16 * 512; const float* gb = a.in[I_GB] + (size_t)l * 512;
    for (int i = tid; i < 1024; i += 512) GL[i] = GLR[(size_t)t0 * 16 + i];
    float w[16];
#pragma unroll
    for (int r = 0; r < 16; ++r) w[r] = w2[r * 512 + h * 128 + d];
    const float bias = gb[h * 128 + d];
    __syncthreads();
    float run = 0.f;
#pragma unroll 4
    for (int jj = 0; jj < 16; ++jj) {
        const int j = jq * 16 + jj;
        float z = bias;
#pragma unroll
        for (int r = 0; r < 16; ++r) z += GL[j * 16 + r] * w[r];
        const float la = (fminf(z, 0.f) - __logf(1.f + __expf(-fabsf(z)))) * (1.f / 16.f);
        run += la; BC[j * 128 + d] = run;
    }
    TOT[jq * 128 + d] = run;
    __syncthreads();
    float off = 0.f;
    for (int q = 0; q < jq; ++q) off += TOT[q * 128 + d];
    if (jq > 0) {
#pragma unroll 4
        for (int jj = 0; jj < 16; ++jj) BC[(jq * 16 + jj) * 128 + d] += off;
    }
    __syncthreads();
}

__device__ __forceinline__ int tsw(int x, int j) { return x * PV + ((((j >> 3) ^ ((x >> 3) & 7)) << 3) | (j & 7)); }
__device__ __forceinline__ int tsc(int x, int c) { return x * PV + ((c ^ ((x >> 3) & 7)) << 3); }
__device__ __forceinline__ float bfe(const u32x4& v, int e) { const unsigned w = (e < 2) ? v.x : (e < 4) ? v.y : (e < 6) ? v.z : v.w; return (e & 1) ? bfhi(w) : bflo(w); }
__device__ __forceinline__ unsigned short bfr(const u32x4& v, int e) { const unsigned w = (e < 2) ? v.x : (e < 4) ? v.y : (e < 6) ? v.z : v.w; return (unsigned short)((e & 1) ? (w >> 16) : (w & 0xffffu)); }

__device__ __forceinline__ void gla_kv_unit(const Args& a, int l, unsigned char* lds, int unit) {
    const int tid = otid(), lane = tid & 63, wave = tid >> 6, r16 = lane & 15, quad = lane >> 4;
    const int bh = unit >> 6, n = unit & 63, b = bh >> 2, h = bh & 3, t0 = b * SEQ + n * 64;
    const bf16_t* Z = (const bf16_t*)(a.ws + WS_Z); bf16_t* KV = (bf16_t*)(a.ws + WS_KV); float* DEC = (float*)(a.ws + WS_DEC);
    u32x4 kreg[2], vreg[4];
#pragma unroll
    for (int i = 0; i < 2; ++i) { const int p = tid + 512 * i; kreg[i] = *(const u32x4*)(Z + (size_t)(t0 + (p >> 4)) * ZW + ZC_K + h * 128 + (p & 15) * 8); }
#pragma unroll
    for (int i = 0; i < 4; ++i) { const int p = tid + 512 * i; vreg[i] = *(const u32x4*)(Z + (size_t)(t0 + (p >> 5)) * ZW + ZC_V + h * 256 + (p & 31) * 8); }
    gla_bc(a, l, lds, t0, h);
    const float* BC = (const float*)(lds + OFF_BC); bf16_t* KTl = (bf16_t*)(lds + OFF_QP); bf16_t* VT = (bf16_t*)(lds + OFF_VT);
#pragma unroll
    for (int i = 0; i < 2; ++i) {
        const int p = tid + 512 * i, j = p >> 4, d0 = (p & 15) * 8;
        const f32x4 bl0 = *(const f32x4*)(BC + 63 * 128 + d0), bl1 = *(const f32x4*)(BC + 63 * 128 + d0 + 4);
        const f32x4 bc0 = *(const f32x4*)(BC + j * 128 + d0), bc1 = *(const f32x4*)(BC + j * 128 + d0 + 4);
#pragma unroll
        for (int e = 0; e < 8; ++e) { const float bl = e < 4 ? bl0[e & 3] : bl1[e & 3], bc = e < 4 ? bc0[e & 3] : bc1[e & 3];
            KTl[tsw(d0 + e, j)] = (bf16_t)f2bf(bfe(kreg[i], e) * __expf(bl - bc)); }
    }
    if (tid < 128) DEC[(size_t)unit * 128 + tid] = __expf(BC[63 * 128 + tid]);
#pragma unroll
    for (int i = 0; i < 4; ++i) {
        const int p = tid + 512 * i, j = p >> 5, v0 = (p & 31) * 8;
#pragma unroll
        for (int e = 0; e < 8; ++e) VT[tsw(v0 + e, j)] = bfr(vreg[i], e);
    }
    __syncthreads();
    f32x4 acc[8][2];
#pragma unroll
    for (int i = 0; i < 8; ++i) { acc[i][0] = (f32x4){0.f, 0.f, 0.f, 0.f}; acc[i][1] = (f32x4){0.f, 0.f, 0.f, 0.f}; }
#pragma unroll
    for (int kb = 0; kb < 2; ++kb) {
        bf16x8 bf[2];
#pragma unroll
        for (int v2 = 0; v2 < 2; ++v2) bf[v2] = *(const bf16x8*)(VT + tsc((wave * 2 + v2) * 16 + r16, kb * 4 + quad));
#pragma unroll
        for (int db = 0; db < 8; ++db) { const bf16x8 af = *(const bf16x8*)(KTl + tsc(db * 16 + r16, kb * 4 + quad));
            acc[db][0] = mfma16(af, bf[0], acc[db][0]); acc[db][1] = mfma16(af, bf[1], acc[db][1]); }
    }
#pragma unroll
    for (int db = 0; db < 8; ++db)
#pragma unroll
        for (int v2 = 0; v2 < 2; ++v2) { const int v = (wave * 2 + v2) * 16 + r16; u32x2 o; o.x = pk2(acc[db][v2][0], acc[db][v2][1]); o.y = pk2(acc[db][v2][2], acc[db][v2][3]);
            *(u32x2*)(KV + ((size_t)unit * 256 + v) * 128 + db * 16 + quad * 4) = o; }
    __syncthreads();
}

__device__ __forceinline__ void gla_scan(const Args& a, int G) {
    bf16_t* KV = (bf16_t*)(a.ws + WS_KV); const float* DEC = (const float*)(a.ws + WS_DEC);
    for (int id = blockIdx.x * 512 + otid(); id < 16 * 256 * 32; id += G * 512) {
        const int bh = id >> 13, v = (id >> 5) & 255, d0 = (id & 31) * 4;
        float s0 = 0.f, s1 = 0.f, s2 = 0.f, s3 = 0.f;
#pragma unroll 8
        for (int n = 0; n < 64; ++n) {
            const int unit = bh * 64 + n;
            u32x2* p = (u32x2*)(KV + ((size_t)unit * 256 + v) * 128 + d0);
            const u32x2 kv = *p; const f32x4 dc = *(const f32x4*)(DEC + (size_t)unit * 128 + d0);
            u32x2 o; o.x = pk2(s0, s1); o.y = pk2(s2, s3); *p = o;
            s0 = dc[0] * s0 + bflo(kv.x); s1 = dc[1] * s1 + bfhi(kv.x); s2 = dc[2] * s2 + bflo(kv.y); s3 = dc[3] * s3 + bfhi(kv.y);
        }
    }
}

__device__ __forceinline__ void gla_out_unit(const Args& a, int l, unsigned char* lds, int unit) {
    const int tid = otid(), lane = tid & 63, wave = tid >> 6, r16 = lane & 15, quad = lane >> 4;
    const int bh = unit >> 6, n = unit & 63, b = bh >> 2, h = bh & 3, t0 = b * SEQ + n * 64;
    const bf16_t* Z = (const bf16_t*)(a.ws + WS_Z); const bf16_t* KV = (const bf16_t*)(a.ws + WS_KV); bf16_t* Y = (bf16_t*)(a.ws + WS_Y);
    u32x4 qreg[2], kreg[2], vreg[4];
#pragma unroll
    for (int i = 0; i < 2; ++i) { const int p = tid + 512 * i; const bf16_t* rp = Z + (size_t)(t0 + (p >> 4)) * ZW + h * 128 + (p & 15) * 8;
        qreg[i] = *(const u32x4*)(rp + ZC_Q); kreg[i] = *(const u32x4*)(rp + ZC_K); }
#pragma unroll
    for (int i = 0; i < 4; ++i) { const int p = tid + 512 * i; vreg[i] = *(const u32x4*)(Z + (size_t)(t0 + (p >> 5)) * ZW + ZC_V + h * 256 + (p & 31) * 8); }
    gla_bc(a, l, lds, t0, h);
    const float* BC = (const float*)(lds + OFF_BC);
    bf16_t* QP = (bf16_t*)(lds + OFF_QP); bf16_t* KP = (bf16_t*)(lds + OFF_KP); bf16_t* QD = (bf16_t*)(lds + OFF_QD); bf16_t* VT = (bf16_t*)(lds + OFF_VT); bf16_t* PB = (bf16_t*)(lds + OFF_PB);
    float* OB = (float*)(lds + OFF_OB);
#pragma unroll
    for (int i = 0; i < 2; ++i) {
        const int p = tid + 512 * i, j = p >> 4, d0 = (p & 15) * 8;
        const f32x4 bm0 = *(const f32x4*)(BC + 31 * 128 + d0), bm1 = *(const f32x4*)(BC + 31 * 128 + d0 + 4);
        const f32x4 bc0 = *(const f32x4*)(BC + j * 128 + d0), bc1 = *(const f32x4*)(BC + j * 128 + d0 + 4);
        float qp[8], kp[8], qd[8];
#pragma unroll
        for (int e = 0; e < 8; ++e) { const float bm = e < 4 ? bm0[e & 3] : bm1[e & 3], bc = e < 4 ? bc0[e & 3] : bc1[e & 3];
            const float qv = bfe(qreg[i], e) * 0.08838834764831845f, kv = bfe(kreg[i], e);
            qp[e] = qv * __expf(bc - bm); kp[e] = kv * __expf(bm - bc); qd[e] = qv * __expf(bc); }
        u32x4 o; o.x = pk2(qp[0], qp[1]); o.y = pk2(qp[2], qp[3]); o.z = pk2(qp[4], qp[5]); o.w = pk2(qp[6], qp[7]); *(u32x4*)(QP + j * PQ + d0) = o;
        o.x = pk2(kp[0], kp[1]); o.y = pk2(kp[2], kp[3]); o.z = pk2(kp[4], kp[5]); o.w = pk2(kp[6], kp[7]); *(u32x4*)(KP + j * PQ + d0) = o;
        o.x = pk2(qd[0], qd[1]); o.y = pk2(qd[2], qd[3]); o.z = pk2(qd[4], qd[5]); o.w = pk2(qd[6], qd[7]); *(u32x4*)(QD + j * PQ + d0) = o;
    }
#pragma unroll
    for (int i = 0; i < 4; ++i) {
        const int p = tid + 512 * i, j = p >> 5, v0 = (p & 31) * 8;
#pragma unroll
        for (int e = 0; e < 8; ++e) VT[tsw(v0 + e, j)] = bfr(vreg[i], e);
    }
    bf16x8 bfk[4][2];
#pragma unroll
    for (int kb = 0; kb < 4; ++kb)
#pragma unroll
        for (int v2 = 0; v2 < 2; ++v2) bfk[kb][v2] = *(const bf16x8*)(KV + ((size_t)unit * 256 + (wave * 2 + v2) * 16 + r16) * 128 + kb * 32 + quad * 8);
    u32x2 rv8[8];
#pragma unroll
    for (int rr = 0; rr < 8; ++rr) rv8[rr] = *(const u32x2*)(Z + (size_t)(t0 + wave * 8 + rr) * ZW + ZC_R + h * 256 + lane * 4);
    __syncthreads();
    {
        const int ib = wave >> 1;
#pragma unroll
        for (int jbi = 0; jbi < 2; ++jbi) {
            const int jb = (wave & 1) * 2 + jbi;
            f32x4 sc = (f32x4){0.f, 0.f, 0.f, 0.f};
            if (jb <= ib) {
#pragma unroll
                for (int kb = 0; kb < 4; ++kb) sc = mfma16(*(const bf16x8*)(QP + (ib * 16 + r16) * PQ + kb * 32 + quad * 8), *(const bf16x8*)(KP + (jb * 16 + r16) * PQ + kb * 32 + quad * 8), sc);
            }
#pragma unroll
            for (int i = 0; i < 4; ++i) { const int row = ib * 16 + quad * 4 + i, col = jb * 16 + r16; PB[row * PV + col] = (bf16_t)f2bf(col <= row ? sc[i] : 0.f); }
        }
    }
    __syncthreads();
    f32x4 acc[4][2];
#pragma unroll
    for (int i = 0; i < 4; ++i) { acc[i][0] = (f32x4){0.f, 0.f, 0.f, 0.f}; acc[i][1] = (f32x4){0.f, 0.f, 0.f, 0.f}; }
#pragma unroll
    for (int kb = 0; kb < 2; ++kb) {
        bf16x8 bf[2];
#pragma unroll
        for (int v2 = 0; v2 < 2; ++v2) bf[v2] = *(const bf16x8*)(VT + tsc((wave * 2 + v2) * 16 + r16, kb * 4 + quad));
#pragma unroll
        for (int ib = 0; ib < 4; ++ib) { const bf16x8 af = *(const bf16x8*)(PB + (ib * 16 + r16) * PV + kb * 32 + quad * 8);
            acc[ib][0] = mfma16(af, bf[0], acc[ib][0]); acc[ib][1] = mfma16(af, bf[1], acc[ib][1]); }
    }
#pragma unroll
    for (int kb = 0; kb < 4; ++kb) {
#pragma unroll
        for (int ib = 0; ib < 4; ++ib) { const bf16x8 af = *(const bf16x8*)(QD + (ib * 16 + r16) * PQ + kb * 32 + quad * 8);
            acc[ib][0] = mfma16(af, bfk[kb][0], acc[ib][0]); acc[ib][1] = mfma16(af, bfk[kb][1], acc[ib][1]); }
    }
#pragma unroll
    for (int ib = 0; ib < 4; ++ib)
#pragma unroll
        for (int v2 = 0; v2 < 2; ++v2)
#pragma unroll
            for (int i = 0; i < 4; ++i) OB[(ib * 16 + quad * 4 + i) * POB + (wave * 2 + v2) * 16 + r16] = acc[ib][v2][i];
    __syncthreads();
    {
        const float* gn = a.in[I_GNORM] + (size_t)l * 1024 + h * 256 + lane * 4;
        const f32x4 gain = *(const f32x4*)gn;
#pragma unroll
        for (int rr = 0; rr < 8; ++rr) {
            const int i = wave * 8 + rr;
            const f32x4 v = *(const f32x4*)(OB + i * POB + lane * 4);
            const float ss = wave_sum(v[0] * v[0] + v[1] * v[1] + v[2] * v[2] + v[3] * v[3]);
            const float rinv = rsqrtf(ss * (1.f / 256.f) + EPS);
            const u32x2 rv = rv8[rr];
            const float r0 = bflo(rv.x), r1 = bfhi(rv.x), r2 = bflo(rv.y), r3 = bfhi(rv.y);
            u32x2 o; o.x = pk2(v[0] * rinv * gain[0] * r0 * sigmoid_f(r0), v[1] * rinv * gain[1] * r1 * sigmoid_f(r1));
            o.y = pk2(v[2] * rinv * gain[2] * r2 * sigmoid_f(r2), v[3] * rinv * gain[3] * r3 * sigmoid_f(r3));
            *(u32x2*)(Y + (size_t)(t0 + i) * DM + YC_GLA + h * 256 + lane * 4) = o;
        }
    }
    __syncthreads();
}

__device__ __forceinline__ void ssm_end_unit(const Args& a, int unit) {
    const int tid = otid(), lane = tid & 63, wave = tid >> 6, r16 = lane & 15, quad = lane >> 4;
    const int g = unit >> 2, rb = unit & 3;
    const bf16_t* Z = (const bf16_t*)(a.ws + WS_Z); const bf16_t* MET = (const bf16_t*)(a.ws + WS_MET); float* E = (float*)(a.ws + WS_E);
    const int crow = rb * 64 + (wave & 3) * 16, qg = (wave >> 2) * 64;
    const int ch = (quad & 1) * 8, jo = quad >> 1;
    f32x4 acc[4];
#pragma unroll
    for (int i = 0; i < 4; ++i) acc[i] = (f32x4){0.f, 0.f, 0.f, 0.f};
    const bf16_t* ap = Z + (size_t)((crow + r16) * 64 + jo) * ZW + ZC_S + g * 16 + ch;
    const bf16_t* bp = MET + ((size_t)(g * 128 + qg + r16) * 64 + jo) * 16 + ch;
#pragma unroll 4
    for (int kb = 0; kb < 32; ++kb) {
        const bf16x8 af = *(const bf16x8*)(ap + (size_t)kb * 2 * ZW);
#pragma unroll
        for (int nb = 0; nb < 4; ++nb) acc[nb] = mfma16(af, *(const bf16x8*)(bp + (size_t)nb * 16 * 1024 + kb * 32), acc[nb]);
    }
#pragma unroll
    for (int nb = 0; nb < 4; ++nb)
#pragma unroll
        for (int i = 0; i < 4; ++i) E[((size_t)(crow + quad * 4 + i) * 32 + g) * 128 + qg + nb * 16 + r16] = acc[nb][i];
}
__device__ __forceinline__ void ssm_scan(const Args& a, int id) {
    const int b = id >> 11, g = (id >> 6) & 31, p = id & 63;
    const float* E = (const float*)(a.ws + WS_E); bf16_t* HC = (bf16_t*)(a.ws + WS_HC); const float* L64 = (const float*)(a.ws + WS_L64);
    const float lr = L64[(g * 64 + p) * 2], li = L64[(g * 64 + p) * 2 + 1];
    float hr = 0.f, hi = 0.f;
#pragma unroll 8
    for (int n = 0; n < 64; ++n) {
        const size_t base = ((size_t)(b * 64 + n) * 32 + g) * 128;
        HC[base + p] = (bf16_t)f2bf(hr); HC[base + 64 + p] = (bf16_t)f2bf(hi);
        const float er = E[base + p], ei = E[base + 64 + p];
        const float nr = lr * hr - li * hi + er, ni = lr * hi + li * hr + ei;
        hr = nr; hi = ni;
    }
}
__device__ __forceinline__ void ssm_out_unit(const Args& a, int unit) {
    const int tid = otid(), lane = tid & 63, wave = tid >> 6, r16 = lane & 15, quad = lane >> 4;
    const int g = unit >> 4, cb = unit & 15;
    const bf16_t* Z = (const bf16_t*)(a.ws + WS_Z); const bf16_t* KT = (const bf16_t*)(a.ws + WS_KT); const bf16_t* MCT = (const bf16_t*)(a.ws + WS_MCT);
    const bf16_t* HC = (const bf16_t*)(a.ws + WS_HC); bf16_t* YS = (bf16_t*)(a.ws + WS_YS);
    const int ch = (quad & 1) * 8, jo = quad >> 1;
    f32x4 acc[2][4];
#pragma unroll
    for (int i = 0; i < 2; ++i)
#pragma unroll
        for (int k = 0; k < 4; ++k) acc[i][k] = (f32x4){0.f, 0.f, 0.f, 0.f};
    const int kbn = cb * 2 + 2;
    const bf16x8 zero8 = (bf16x8){0, 0, 0, 0, 0, 0, 0, 0};
    for (int kb0 = 0; kb0 < kbn; kb0 += 2) {
        bf16x8 af[2][2], bf[2][4];
#pragma unroll
        for (int u = 0; u < 2; ++u) {
            const int kb = kb0 + u, jp = kb * 2 + jo; const bool on = kb < kbn;
#pragma unroll
            for (int rk = 0; rk < 2; ++rk) af[u][rk] = on ? *(const bf16x8*)(Z + (size_t)((wave * 32 + rk * 16 + r16) * 64 + jp) * ZW + ZC_S + g * 16 + ch) : zero8;
#pragma unroll
            for (int nb = 0; nb < 4; ++nb) { const int dl = cb * 4 + nb - jp; bf[u][nb] = (on && dl >= 0) ? *(const bf16x8*)(KT + ((size_t)(g * 64 + dl) * 16 + r16) * 16 + ch) : zero8; }
        }
#pragma unroll
        for (int u = 0; u < 2; ++u)
#pragma unroll
            for (int nb = 0; nb < 4; ++nb) { acc[0][nb] = mfma16(af[u][0], bf[u][nb], acc[0][nb]); acc[1][nb] = mfma16(af[u][1], bf[u][nb], acc[1][nb]); }
    }
#pragma unroll
    for (int kb = 0; kb < 4; ++kb) {
        bf16x8 af[2];
#pragma unroll
        for (int rk = 0; rk < 2; ++rk) af[rk] = *(const bf16x8*)(HC + ((size_t)(wave * 32 + rk * 16 + r16) * 32 + g) * 128 + kb * 32 + quad * 8);
#pragma unroll
        for (int nb = 0; nb < 4; ++nb) { const bf16x8 bf = *(const bf16x8*)(MCT + ((size_t)g * 1024 + (cb * 4 + nb) * 16 + r16) * 128 + kb * 32 + quad * 8);
            acc[0][nb] = mfma16(af[0], bf, acc[0][nb]); acc[1][nb] = mfma16(af[1], bf, acc[1][nb]); }
    }
#pragma unroll
    for (int rk = 0; rk < 2; ++rk)
#pragma unroll
        for (int nb = 0; nb < 4; ++nb)
#pragma unroll
            for (int i = 0; i < 4; ++i) { const int chunk = wave * 32 + rk * 16 + quad * 4 + i, t = chunk * 64 + cb * 4 + nb;
                YS[(size_t)t * 512 + g * 16 + r16] = (bf16_t)f2bf(gelu_tanh_f(acc[rk][nb][i])); }
}

__device__ __forceinline__ void phase_final(const Args& a, int G) {
    const int tid = otid(), lane = tid & 63, wave = tid >> 6;
    const int gw = blockIdx.x * 8 + wave, NGW = G * 8;
    const unsigned long long* rss = (const unsigned long long*)(a.ws + WS_RSS) + (size_t)6 * T; const float* gf = a.in[I_FINN];
    for (int row = gw; row < T; row += NGW) {
        const float rinv = rsqrtf((float)rss[row] * (1.f / (16777216.f * DM)) + EPS);
        f32x4* xr = (f32x4*)(a.out + (size_t)row * DM) + lane; const f32x4* gr = (const f32x4*)gf + lane;
#pragma unroll
        for (int i = 0; i < 8; ++i) { f32x4 v = xr[64 * i]; const f32x4 gg = gr[64 * i]; v = v * rinv * gg; xr[64 * i] = v; }
    }
}


#define XB_TMO      128
#define XB_XCNT(j)  (256  + 64 * (j))
#define XB_XSUB(j)  (1280 + 64 * (j))
#define XB_XGEN(j)  (2304 + 64 * (j))
#define XB_TOP      3328
#define XB_TOPGEN   3392
#define XCD_BAR_WORDS 3456
#define XB_SPIN_CAP (1u << 18)
__device__ __forceinline__ unsigned xb_ld(unsigned* p)              { return __hip_atomic_load(p, __ATOMIC_RELAXED, __HIP_MEMORY_SCOPE_AGENT); }
__device__ __forceinline__ unsigned xb_add(unsigned* p, unsigned v) { return __hip_atomic_fetch_add(p, v, __ATOMIC_RELAXED, __HIP_MEMORY_SCOPE_AGENT); }
__device__ __forceinline__ unsigned xb_xcc_id() { return (unsigned)__builtin_amdgcn_s_getreg((3 << 11) | 20) & 0xFu; }
#define XB_SPIN(cond, bar) do { unsigned _sp = 0; while (cond) { __builtin_amdgcn_s_sleep(1); \
    if ((++_sp & 255u) == 0u) { if (xb_ld(&(bar)[XB_TMO])) break; if (_sp > XB_SPIN_CAP) { atomicAdd(&(bar)[XB_TMO], 1u); break; } } } } while (0)
struct XcdBarrier { unsigned* bar; unsigned x; volatile LAS unsigned* st; };
__device__ __forceinline__ XcdBarrier xcd_barrier_post(unsigned* bar, volatile LAS unsigned* st) {
    XcdBarrier b; b.bar = bar; b.x = xb_xcc_id(); b.st = st;
    if (threadIdx.x == 0) (void)xb_add(&bar[XB_XCNT(b.x)], 1u);
    return b;
}
__device__ __forceinline__ void xcd_barrier_complete(unsigned* bar, unsigned x, unsigned& nloc, unsigned& nx) {
    const unsigned G = gridDim.x * gridDim.y * gridDim.z;
    unsigned sum, cnt, mine, sp = 0u;
    for (;;) {
        sum = 0u; cnt = 0u; mine = 0u;
#pragma unroll
        for (unsigned j = 0; j < 16; ++j) { const unsigned c = xb_ld(&bar[XB_XCNT(j)]); sum += c; cnt += (c > 0u) ? 1u : 0u; mine = (j == x) ? c : mine; }
        if (sum == G) break;
        __builtin_amdgcn_s_sleep(1);
        if ((++sp & 255u) == 0u) { if (xb_ld(&bar[XB_TMO])) break; if (sp > XB_SPIN_CAP) { atomicAdd(&bar[XB_TMO], 1u); break; } }
    }
    nloc = mine > 0u ? mine : 1u; nx = cnt > 0u ? cnt : 1u;
}
__device__ __forceinline__ void xcd_barrier(const XcdBarrier& b) {
    asm volatile("s_waitcnt vmcnt(0)" ::: "memory");
    __syncthreads();
    if (threadIdx.x == 0) {
        unsigned* bar = b.bar;
        __builtin_amdgcn_s_waitcnt(0);
        unsigned nloc = b.st[0], nx = b.st[1];
        if (nloc == 0u) { xcd_barrier_complete(bar, b.x, nloc, nx); b.st[0] = nloc; b.st[1] = nx; }
        const unsigned old = xb_add(&bar[XB_XSUB(b.x)], 1u);
        const unsigned gen = old / nloc;
        if (old + 1u == (gen + 1u) * nloc) {
            __builtin_amdgcn_fence(__ATOMIC_RELEASE, "agent");
            asm volatile("s_waitcnt vmcnt(0)" ::: "memory");
            const unsigned og = xb_add(&bar[XB_TOP], 1u);
            const unsigned tg = og / nx;
            if (og + 1u == (tg + 1u) * nx) xb_add(&bar[XB_TOPGEN], 1u);
            else XB_SPIN(xb_ld(&bar[XB_TOPGEN]) == tg, bar);
            __builtin_amdgcn_fence(__ATOMIC_ACQUIRE, "agent");
            xb_add(&bar[XB_XGEN(b.x)], 1u);
            asm volatile("s_waitcnt vmcnt(0)" ::: "memory");
        } else {
            XB_SPIN(xb_ld(&bar[XB_XGEN(b.x)]) == gen, bar);
            __builtin_amdgcn_fence(__ATOMIC_ACQUIRE, "agent");
            asm volatile("s_waitcnt vmcnt(0)" ::: "memory");
        }
    }
    __syncthreads();
}

constexpr int PH_PER_LAYER = 12, N_PHASES = 2 * PH_PER_LAYER + 1;

__global__ void __launch_bounds__(512, 2) mega_fwd(Args a) {
    extern __shared__ __attribute__((aligned(16))) unsigned char lds[];
    cg::grid_group grid = cg::this_grid();
    constexpr int G = 256;
    unsigned char* ws = a.ws;
    LAS unsigned char* ldsl = (LAS unsigned char*)lds;
    unsigned long long* rssb = (unsigned long long*)(ws + WS_RSS);
    volatile LAS unsigned* bst = (volatile LAS unsigned*)(ldsl + (LDS_BYTES - 64));
    if (threadIdx.x < 2) bst[threadIdx.x] = 0u;
    __syncthreads();
    XcdBarrier bar = xcd_barrier_post((unsigned*)(ws + WS_BAR), bst);
#if !MK_MULTI_LAUNCH
    if (a.ph_hi - a.ph_lo > 1) grid.sync();
#endif
    for (int ph = a.ph_lo; ph < a.ph_hi; ++ph) {
        if (ph != a.ph_lo) xcd_barrier(bar);
        if (ph == N_PHASES - 1) { phase_final(a, G); continue; }
        const int l = ph / PH_PER_LAYER, k = ph % PH_PER_LAYER;
#ifdef PROBE_K
        for (int rep = 0; rep < ((k == PROBE_K) ? 2 : 1); ++rep) {
        if (rep) xcd_barrier(bar);
#endif
        if (k == 0) {
#ifndef NO_PREP
            phase_prep(a, l, lds, G);
#endif
        } else if (k == 1 || k == 10) {
            const int second = (k == 10);
            pg8::Gemm g{(const bf16_t*)(ws + WS_XB), (const bf16_t*)(ws + (second ? WS_W2U : WS_W1U)), T, 2 * FF, DM, DM, DM};
            pg8::StaticOrder S; S.init(T, 2 * FF, G, (int)blockIdx.x);
            pg8::EpiFfnUp E{(bf16_t*)(ws + WS_Z), rssb + (size_t)(3 * l + (second ? 2 : 0)) * T};
            pg8::gemm_phase(ldsl, g, S, E);
        } else if (k == 2 || k == 11) {
            const int second = (k == 11);
            pg8::Gemm g{(const bf16_t*)(ws + WS_Z), (const bf16_t*)(ws + (second ? WS_W2D : WS_W1D)), T, DM, FF, FF, FF};
            pg8::StaticOrder S; S.init(T, DM, G, (int)blockIdx.x);
            const float* xin = (l == 0 && !second) ? a.in[I_X] : a.out;
            pg8::EpiResid E{xin, a.out, (bf16_t*)(ws + WS_XB), rssb + (size_t)(3 * l + (second ? 3 : 1)) * T, 0.5f};
            pg8::gemm_phase(ldsl, g, S, E);
        } else if (k == 3) {
            pg8::Gemm g{(const bf16_t*)(ws + WS_XB), (const bf16_t*)(ws + WS_WIN), T, ZW, DM, DM, DM};
            pg8::StaticOrder S; S.init(T, ZW, G, (int)blockIdx.x);
            pg8::EpiWin E{(bf16_t*)(ws + WS_Z), rssb + (size_t)(3 * l + 1) * T};
            pg8::gemm_phase(ldsl, g, S, E);
#ifndef NO_GLR
            phase_glr(a, rssb + (size_t)(3 * l + 1) * T, G);
#endif
        } else if (k == 4) {
#ifndef NO_GLA
            for (int u = blockIdx.x; u < 1024; u += G) gla_kv_unit(a, l, lds, u);
#endif
#ifndef NO_SSM
            for (int u = G - 1 - (int)blockIdx.x; u < 128; u += G) ssm_end_unit(a, u);
#endif
#ifndef NO_POOL
            phase_pool(a, G);
#endif
        } else if (k == 5) {
#ifndef NO_GLA
            gla_scan(a, G);
#endif
#ifndef NO_SSM
            { const int id = (G - 1 - (int)blockIdx.x) * 512 + otid(); if (id < 8192) ssm_scan(a, id); }
#endif
        } else if (k == 6) {
#ifndef NO_GLA
            for (int u = blockIdx.x; u < 1024; u += G) gla_out_unit(a, l, lds, u);
#endif
#ifndef NO_SSM
            for (int u = blockIdx.x; u < 512; u += G) ssm_out_unit(a, u);
#endif
        } else if (k == 7) {
            pg8::Gemm g{(const bf16_t*)(ws + WS_YS), (const bf16_t*)(ws + WS_WGLU), T, 512, 512, 512, 512};
            pg8::StaticOrder S; S.init(T, 512, G, (int)blockIdx.x);
            pg8::EpiGlu E{(const bf16_t*)(ws + WS_YS), (bf16_t*)(ws + WS_Y)};
            pg8::gemm_phase(ldsl, g, S, E);
        } else if (k == 8) {
            const bf16_t* Y = (const bf16_t*)(ws + WS_Y); const bf16_t* Wb = (const bf16_t*)(ws + WS_WBR); const bf16_t* Zg = (const bf16_t*)(ws + WS_Z) + ZC_G;
            pg8::StaticOrder S; S.init(T, DM, G, (int)blockIdx.x);
            { pg8::Gemm g{Y, Wb, T, DM, 512, DM, DM}; pg8::EpiBranch E{Zg, (bf16_t*)(ws + WS_MB), 0}; pg8::gemm_phase(ldsl, g, S, E); }
            { pg8::Gemm g{Y + 512, Wb + 512, T, DM, 1024, DM, DM}; pg8::EpiBranch E{Zg + 2048, (bf16_t*)(ws + WS_MB), 1}; pg8::gemm_phase(ldsl, g, S, E); }
            { pg8::Gemm g{Y + 1536, Wb + 1536, T, DM, 512, DM, DM}; pg8::EpiBranch E{Zg + 4096, (bf16_t*)(ws + WS_MB), 1}; pg8::gemm_phase(ldsl, g, S, E); }
        } else if (k == 9) {
            pg8::Gemm g{(const bf16_t*)(ws + WS_MB), (const bf16_t*)(ws + WS_WO), T, DM, DM, DM, DM};
            pg8::StaticOrder S; S.init(T, DM, G, (int)blockIdx.x);
            pg8::EpiResid E{a.out, a.out, (bf16_t*)(ws + WS_XB), rssb + (size_t)(3 * l + 2) * T, 1.0f};
            pg8::gemm_phase(ldsl, g, S, E);
        }
#ifdef PROBE_K
        }
#endif
    }
}

extern "C" void kernel_launch(void* const* d_in, const int* in_sizes, int n_in, void* d_out, int out_size, void* d_ws, size_t ws_size, hipStream_t stream) {
    static int grid = 0;
    if (grid == 0) {
        if (n_in != 28 || in_sizes[0] != T * DM || out_size != T * DM || ws_size < WS_END) {
            fprintf(stderr, "kernel_launch: unexpected problem (n_in %d, in0 %d, out %d, ws %zu, need %zu)\n", n_in, n_in > 0 ? in_sizes[0] : -1, out_size, ws_size, (size_t)WS_END);
            grid = -1; return;
        }
        int dev = 0, cus = 0, per_cu = 0;
        hipGetDevice(&dev);
        hipDeviceGetAttribute(&cus, hipDeviceAttributeMultiprocessorCount, dev);
        hipFuncSetAttribute((const void*)mega_fwd, hipFuncAttributeMaxDynamicSharedMemorySize, LDS_BYTES);
        hipOccupancyMaxActiveBlocksPerMultiprocessor(&per_cu, (const void*)mega_fwd, 512, LDS_BYTES);
        if (per_cu < 1) per_cu = 1;
        if (per_cu > 1) per_cu = 1;
        grid = 256;
        if (cus * per_cu < 256) { fprintf(stderr, "kernel_launch: needs 256 co-resident workgroups (have %d x %d)\n", cus, per_cu); grid = -1; return; }
        (void)hipGetLastError();
    }
    if (grid < 0) return;
    Args a{};
    for (int i = 0; i < 28; ++i) a.in[i] = (const float*)d_in[i];
    a.out = (float*)d_out; a.ws = (unsigned char*)d_ws;
    (void)hipMemsetAsync((char*)d_ws + WS_BAR, 0, 16384, stream);
#if MK_MULTI_LAUNCH
    for (int ph = 0; ph < N_PHASES; ++ph) {
        a.ph_lo = ph; a.ph_hi = ph + 1;
        hipLaunchKernelGGL(mega_fwd, dim3(grid), dim3(512), LDS_BYTES, stream, a);
    }
#else
    a.ph_lo = 0; a.ph_hi = N_PHASES;
    void* args[] = {&a};
    hipError_t e = hipLaunchCooperativeKernel((const void*)mega_fwd, dim3(grid), dim3(512), args, LDS_BYTES, stream);
    if (e != hipSuccess) fprintf(stderr, "cooperative launch failed: %s (grid %d)\n", hipGetErrorString(e), grid);
#endif
}
```

```cpp
#include <hip/hip_runtime.h>
#include <hip/hip_cooperative_groups.h>
#include <cstdio>
#include <cstdint>
namespace cg = cooperative_groups;

#ifndef MK_MULTI_LAUNCH
#define MK_MULTI_LAUNCH 0
#endif

#define LAS __attribute__((address_space(3)))
typedef unsigned short bf16_t;
typedef short bf16x8 __attribute__((ext_vector_type(8)));
typedef float f32x4 __attribute__((ext_vector_type(4)));
typedef unsigned u32x4 __attribute__((ext_vector_type(4)));
typedef unsigned u32x2 __attribute__((ext_vector_type(2)));

constexpr int T = 16384, DM = 2048, FF = 5632, SEQ = 4096;
constexpr int ZW = 10240;
constexpr int ZC_POOL = 0, ZC_Q = 512, ZC_K = 1024, ZC_V = 1536, ZC_R = 2560, ZC_S = 3584, ZC_G = 4096;
constexpr int YC_GLA = 512, YC_SSM = 1536;
constexpr int INW = 10256;
constexpr float EPS = 1e-6f;

constexpr size_t MiB = 1u << 20;
constexpr size_t WS_RSS = 0;
constexpr size_t WS_BAR = 917504;
constexpr size_t WS_WGT = 1 * MiB;
constexpr size_t WS_L64 = 1 * MiB + 131072;
constexpr size_t WS_GLR = 2 * MiB;
constexpr size_t WS_DEC = 3 * MiB;
constexpr size_t WS_KT = 4 * MiB;
constexpr size_t WS_E = 5 * MiB;
constexpr size_t WS_HC = 9 * MiB;
constexpr size_t WS_MET = 11 * MiB;
constexpr size_t WS_MCT = 19 * MiB;
constexpr size_t WS_YS = 27 * MiB;
constexpr size_t WS_W1U = 43 * MiB, WS_W1D = 87 * MiB, WS_WIN = 109 * MiB, WS_WBR = 149 * MiB, WS_WO = 157 * MiB, WS_WGLU = 165 * MiB;
constexpr size_t WS_W2U = 166 * MiB, WS_W2D = 210 * MiB;
constexpr size_t WS_XB = 232 * MiB, WS_Y = 296 * MiB, WS_MB = 360 * MiB, WS_KV = 424 * MiB, WS_Z = 488 * MiB, WS_END = 808 * MiB;

constexpr int LDS_BYTES = 147456;

typedef __bf16 bf16v2_t __attribute__((ext_vector_type(2)));
typedef float f32v2_t __attribute__((ext_vector_type(2)));
__device__ __forceinline__ unsigned pk2(float lo, float hi) { const f32v2_t v = {lo, hi}; const bf16v2_t b = __builtin_convertvector(v, bf16v2_t); return __builtin_bit_cast(unsigned, b); }
__device__ __forceinline__ unsigned f2bf(float f) { return pk2(f, 0.f) & 0xffffu; }
__device__ __forceinline__ float bf2f(unsigned short b) { return __uint_as_float(((unsigned)b) << 16); }
__device__ __forceinline__ float bflo(unsigned w) { return __uint_as_float(w << 16); }
__device__ __forceinline__ float bfhi(unsigned w) { return __uint_as_float(w & 0xffff0000u); }
__device__ __forceinline__ float wave_sum(float v) {
#pragma unroll
    for (int o = 1; o < 64; o <<= 1) v += __shfl_xor(v, o);
    return v;
}
__device__ __forceinline__ float sigmoid_f(float x) { return __builtin_amdgcn_rcpf(1.f + __expf(-x)); }
__device__ __forceinline__ float gelu_tanh_f(float x) {
    const float u = 0.7978845608028654f * (x + 0.044715f * x * x * x);
    const float t = 1.f - 2.f * __builtin_amdgcn_rcpf(1.f + __expf(2.f * u));
    return 0.5f * x * (1.f + t);
}
#define LDS_WAIT() asm volatile("s_waitcnt lgkmcnt(0)" ::: "memory")
__device__ __forceinline__ int otid() { int t = threadIdx.x; asm volatile("" : "+v"(t)); return t; }
__device__ __forceinline__ f32x4 mfma16(bf16x8 a, bf16x8 b, f32x4 c) { return __builtin_amdgcn_mfma_f32_16x16x32_bf16(a, b, c, 0, 0, 0); }

namespace pg8 {
constexpr int BM = 256, BK = 64, HALF = 128, HTB = HALF * BK * 2, STAGE_BYTES = 8 * HTB, NXCD = 8, WGM = 8;
__host__ __device__ __forceinline__ int lds_byte(int r, int c) { const int st = (r >> 4) * 2 + (c >> 5), rr = r & 15, cc = c & 31, ob = rr * 64 + cc * 2; return st * 1024 + (ob ^ (((ob >> 9) & 1) << 5)); }
__host__ __device__ __forceinline__ void stage_rc(int b, int& R, int& C) { const int st = b / 1024, sb = b % 1024, swz = sb ^ (((sb >> 9) & 1) << 5); R = (st >> 1) * 16 + swz / 64; C = (st & 1) * 32 + (swz % 64) / 2; }
__host__ __device__ __forceinline__ int perm32(int rho) { const int n = rho >> 4, i = rho & 15; return 8 * (i >> 2) + 4 * n + (i & 3); }

struct Unit { int pm, pn, seg; };
struct Gemm { const bf16_t* A; const bf16_t* Bt; int M, N, K, lda, ldb; };

struct StaticOrder {
    static constexpr bool SEGMENTED = false;
    int nM, nN, nwg, G, c;
    __device__ __forceinline__ int koff(const Unit&) const { return 0; }
    __device__ __forceinline__ int nt(const Unit&) const { return 0; }
    __device__ void init(int M, int N, int G_, int c_) { nM = M / BM; nN = N / BM; nwg = nM * nN; G = G_; c = c_; }
    __device__ bool next(int i, Unit& u) const {
        const long L = (long)i * G + c; if (L >= nwg) return false;
        int wgid = (int)L; { const int q = nwg / NXCD, r = nwg % NXCD, xcd = wgid % NXCD, off = wgid / NXCD; wgid = (xcd < r ? xcd * (q + 1) : r * (q + 1) + (xcd - r) * q) + off; }
        const int nig = WGM * nN, gid = wgid / nig, fm = gid * WGM, gsz = (nM - fm) < WGM ? (nM - fm) : WGM;
        u.pm = fm + ((wgid % nig) % gsz); u.pn = (wgid % nig) / gsz; u.seg = 0; return true;
    }
};
struct BranchOrder : StaticOrder {
    static constexpr bool SEGMENTED = true;
    __device__ bool next(int i, Unit& u) const { const bool ok = StaticOrder::next(i / 3, u); u.seg = i % 3; return ok; }
    __device__ __forceinline__ int koff(const Unit& u) const { return u.seg == 0 ? 0 : (u.seg == 1 ? 512 : 1536); }
    __device__ __forceinline__ int nt(const Unit& u) const { return u.seg == 1 ? 16 : 8; }
};

template <class Epi, class Sched>
__device__ __forceinline__ void gemm_phase(LAS unsigned char* lds, const Gemm g, const Sched& S, const Epi& E) {
    const int tid = otid(), wid = __builtin_amdgcn_readfirstlane(tid >> 6), lane = tid & 63, wr = wid >> 2, wc = wid & 3, fr = lane & 15, fq = lane >> 4;
    unsigned voffA[2], voffB[2];
#pragma unroll
    for (int i = 0; i < 2; ++i) { int R, C; stage_rc(tid * 16 + i * 8192, R, C); const int Rb = (R & ~31) + perm32(R & 31);
        voffA[i] = (unsigned)(R * g.lda + C) * 2u; voffB[i] = (unsigned)(Rb * g.ldb + C) * 2u; }
    const size_t kstep = (size_t)(BK * 2);
    const size_t hstepA = (size_t)HALF * g.lda * 2, hstepB = (size_t)HALF * g.ldb * 2;
    const size_t tstepA = 2 * hstepA, tstepB = 2 * hstepB;
    const unsigned ldsw = (unsigned)wid * 1024u;
    const int aoff = lds_byte(wr * 64 + fr, fq * 8), boff = lds_byte(wc * 32 + fr, fq * 8);
#define PG8_SA(b, h) (((b) * 2 + (h)) * HTB)
#define PG8_SB(b, h) ((4 + (b) * 2 + (h)) * HTB)
#define PG8_STAGE(bufoff, gbase, voff) do { _Pragma("unroll") for (int _i = 0; _i < 2; ++_i) \
        __builtin_amdgcn_global_load_lds((const unsigned*)((const char*)(gbase) + (voff)[_i]), (LAS unsigned*)(lds + (bufoff) + ldsw + _i * 8192), 16, 0, 0); } while (0)
#define PG8_LDA(dst, b, h) do { _Pragma("unroll") for (int m = 0; m < 4; ++m) _Pragma("unroll") for (int k = 0; k < 2; ++k) dst[m][k] = *(const LAS bf16x8*)(lds + PG8_SA(b, h) + aoff + m * 2048 + k * 1024); } while (0)
#define PG8_LDB(dst, b, h) do { _Pragma("unroll") for (int n = 0; n < 2; ++n) _Pragma("unroll") for (int k = 0; k < 2; ++k) dst[n][k] = *(const LAS bf16x8*)(lds + PG8_SB(b, h) + boff + n * 2048 + k * 1024); } while (0)
#define PG8_MMA(ai, bj, At, Bt) do { __builtin_amdgcn_s_setprio(1); _Pragma("unroll") for (int m = 0; m < 4; ++m) _Pragma("unroll") for (int n = 0; n < 2; ++n) _Pragma("unroll") for (int k = 0; k < 2; ++k) \
        acc[ai][bj][m][n] = __builtin_amdgcn_mfma_f32_16x16x32_bf16(Bt[n][k], At[m][k], acc[ai][bj][m][n], 0, 0, 0); __builtin_amdgcn_s_setprio(0); } while (0)
#define PG8_WAIT_V(n) asm volatile("s_waitcnt vmcnt(" #n ")" ::: "memory")
#define PG8_WAIT_L(n) asm volatile("s_waitcnt lgkmcnt(" #n ")" ::: "memory")
#define PG8_BAR __builtin_amdgcn_s_barrier()
#define PG8_SCHED __builtin_amdgcn_sched_barrier(0)
    Unit cur, nxt; int ui = 0;
    if (!S.next(0, cur)) return;
    f32x4 acc[2][2][4][2];
#pragma unroll
    for (int a = 0; a < 2; ++a)
#pragma unroll
        for (int b = 0; b < 2; ++b)
#pragma unroll
            for (int m = 0; m < 4; ++m)
#pragma unroll
                for (int n = 0; n < 2; ++n) acc[a][b][m][n] = (f32x4){0.f, 0.f, 0.f, 0.f};
    bf16x8 At[4][2], B0[2][2], B1[2][2];
    int nt = Sched::SEGMENTED ? S.nt(cur) : g.K / BK;
    const char* cA = (const char*)g.A + (size_t)cur.pm * tstepA + (size_t)S.koff(cur) * 2; const char* cB = (const char*)g.Bt + (size_t)cur.pn * tstepB + (size_t)S.koff(cur) * 2;
    PG8_STAGE(PG8_SB(0, 0), cB, voffB); PG8_STAGE(PG8_SB(0, 1), cB + hstepB, voffB); PG8_STAGE(PG8_SA(0, 0), cA, voffA); PG8_STAGE(PG8_SA(0, 1), cA + hstepA, voffA);
    if (wr == 1) PG8_BAR;
    PG8_WAIT_V(2); PG8_BAR;
    PG8_STAGE(PG8_SB(1, 0), cB + kstep, voffB); PG8_STAGE(PG8_SA(1, 0), cA + kstep, voffA); PG8_STAGE(PG8_SB(1, 1), cB + hstepB + kstep, voffB);
    PG8_WAIT_V(6); PG8_BAR;
    for (;;) {
        const bool has_next = S.next(ui + 1, nxt);
        const char* nA = has_next ? (const char*)g.A + (size_t)nxt.pm * tstepA + (size_t)S.koff(nxt) * 2 : cA; const char* nB = has_next ? (const char*)g.Bt + (size_t)nxt.pn * tstepB + (size_t)S.koff(nxt) * 2 : cB;
        for (int t = 0; t < nt; t += 2) {
            const bool last = (t == nt - 2);
            const char* a1 = cA + (size_t)(t + 1) * kstep;
            const char* a2 = last ? nA : cA + (size_t)(t + 2) * kstep; const char* b2 = last ? nB : cB + (size_t)(t + 2) * kstep;
            const char* a3 = a2 + kstep; const char* b3 = b2 + kstep;
            PG8_LDB(B0, 0, 0); PG8_LDB(B1, 0, 1); PG8_SCHED; PG8_LDA(At, 0, 0); PG8_STAGE(PG8_SA(1, 1), a1 + hstepA, voffA);
            PG8_WAIT_V(8); PG8_WAIT_L(0); PG8_BAR; PG8_MMA(0, 0, At, B0); PG8_MMA(0, 1, At, B1); PG8_BAR; PG8_SCHED;
            PG8_LDA(At, 0, 1); PG8_STAGE(PG8_SB(0, 0), b2, voffB); PG8_STAGE(PG8_SB(0, 1), b2 + hstepB, voffB); PG8_STAGE(PG8_SA(0, 0), a2, voffA);
            PG8_WAIT_V(8); PG8_WAIT_L(0); PG8_BAR; PG8_MMA(1, 0, At, B0); PG8_MMA(1, 1, At, B1); PG8_BAR; PG8_SCHED;
            PG8_LDB(B0, 1, 0); PG8_LDB(B1, 1, 1); PG8_SCHED; PG8_LDA(At, 1, 0); PG8_STAGE(PG8_SA(0, 1), a2 + hstepA, voffA);
            PG8_WAIT_V(8); PG8_WAIT_L(0); PG8_BAR; PG8_MMA(0, 0, At, B0); PG8_MMA(0, 1, At, B1); PG8_BAR; PG8_SCHED;
            PG8_LDA(At, 1, 1); PG8_STAGE(PG8_SB(1, 0), b3, voffB); PG8_STAGE(PG8_SB(1, 1), b3 + hstepB, voffB); PG8_STAGE(PG8_SA(1, 0), a3, voffA);
            PG8_WAIT_V(8); PG8_WAIT_L(0); PG8_BAR; PG8_MMA(1, 0, At, B0); PG8_MMA(1, 1, At, B1); PG8_BAR; PG8_SCHED;
        }
        if (wr == 0) PG8_BAR;
        E(acc, cur, wr, wc, fr, fq);
        if (!has_next) break;
#pragma unroll
        for (int a = 0; a < 2; ++a)
#pragma unroll
            for (int b = 0; b < 2; ++b)
#pragma unroll
                for (int m = 0; m < 4; ++m)
#pragma unroll
                    for (int n = 0; n < 2; ++n) acc[a][b][m][n] = (f32x4){0.f, 0.f, 0.f, 0.f};
        cur = nxt; cA = nA; cB = nB; ++ui;
        if (Sched::SEGMENTED) nt = S.nt(cur);
        if (wr == 1) PG8_BAR;
    }
    PG8_WAIT_V(0);
    PG8_BAR;
#undef PG8_SA
#undef PG8_SB
#undef PG8_STAGE
#undef PG8_LDA
#undef PG8_LDB
#undef PG8_MMA
#undef PG8_WAIT_V
#undef PG8_WAIT_L
#undef PG8_BAR
#undef PG8_SCHED
}

typedef const f32x4 (&AccRef)[2][2][4][2];

struct EpiFfnUp {
    bf16_t* H; const unsigned long long* rss;
    __device__ __forceinline__ void operator()(AccRef acc, const Unit& u, int wr, int wc, int fr, int fq) const {
        const int row0 = u.pm * BM + wr * 64 + fr, col0 = u.pn * 128 + wc * 32 + 8 * fq;
#pragma unroll
        for (int ai = 0; ai < 2; ++ai)
#pragma unroll
            for (int m = 0; m < 4; ++m) {
                const int row = row0 + ai * HALF + m * 16;
                const float rinv = rsqrtf((float)rss[row] * (1.f / (16777216.f * DM)) + EPS);
                float h[8];
#pragma unroll
                for (int n = 0; n < 2; ++n)
#pragma unroll
                    for (int j = 0; j < 4; ++j) { const float gg = acc[ai][0][m][n][j] * rinv, uu = acc[ai][1][m][n][j] * rinv; h[n * 4 + j] = gg * uu * sigmoid_f(gg); }
                u32x4 o; o.x = pk2(h[0], h[1]); o.y = pk2(h[2], h[3]); o.z = pk2(h[4], h[5]); o.w = pk2(h[6], h[7]);
                *(u32x4*)(H + (size_t)row * FF + col0) = o;
            }
    }
};
struct EpiWin {
    bf16_t* Z; const unsigned long long* rss;
    __device__ __forceinline__ void operator()(AccRef acc, const Unit& u, int wr, int wc, int fr, int fq) const {
        const int row0 = u.pm * BM + wr * 64 + fr, col0 = u.pn * BM + wc * 32 + 8 * fq;
        const bool sg = u.pn >= 16;
#pragma unroll
        for (int ai = 0; ai < 2; ++ai)
#pragma unroll
            for (int m = 0; m < 4; ++m) {
                const int row = row0 + ai * HALF + m * 16;
                const float rinv = rsqrtf((float)rss[row] * (1.f / (16777216.f * DM)) + EPS);
#pragma unroll
                for (int bj = 0; bj < 2; ++bj) {
                    float h[8];
#pragma unroll
                    for (int n = 0; n < 2; ++n)
#pragma unroll
                        for (int j = 0; j < 4; ++j) { const float v = acc[ai][bj][m][n][j] * rinv; h[n * 4 + j] = sg ? sigmoid_f(v) : v; }
                    u32x4 o; o.x = pk2(h[0], h[1]); o.y = pk2(h[2], h[3]); o.z = pk2(h[4], h[5]); o.w = pk2(h[6], h[7]);
                    *(u32x4*)(Z + (size_t)row * ZW + col0 + bj * HALF) = o;
                }
            }
    }
};
struct EpiResid {
    const float* xin; float* xout; bf16_t* XB; unsigned long long* rssn; float scale;
    __device__ __forceinline__ void operator()(AccRef acc, const Unit& u, int wr, int wc, int fr, int fq) const {
        const int row0 = u.pm * BM + wr * 64 + fr, col0 = u.pn * BM + wc * 32 + 8 * fq;
#pragma unroll
        for (int ai = 0; ai < 2; ++ai)
#pragma unroll
            for (int m = 0; m < 4; ++m) {
                const int row = row0 + ai * HALF + m * 16;
                float ss = 0.f;
#pragma unroll
                for (int bj = 0; bj < 2; ++bj) {
                    const size_t off = (size_t)row * DM + col0 + bj * HALF;
                    f32x4 x0 = *(const f32x4*)(xin + off), x1 = *(const f32x4*)(xin + off + 4);
                    x0 = x0 + acc[ai][bj][m][0] * scale; x1 = x1 + acc[ai][bj][m][1] * scale;
                    *(f32x4*)(xout + off) = x0; *(f32x4*)(xout + off + 4) = x1;
                    u32x4 o; o.x = pk2(x0[0], x0[1]); o.y = pk2(x0[2], x0[3]); o.z = pk2(x1[0], x1[1]); o.w = pk2(x1[2], x1[3]);
                    *(u32x4*)(XB + off) = o;
                    ss += x0[0] * x0[0] + x0[1] * x0[1] + x0[2] * x0[2] + x0[3] * x0[3] + x1[0] * x1[0] + x1[1] * x1[1] + x1[2] * x1[2] + x1[3] * x1[3];
                }
                ss += __shfl_xor(ss, 16); ss += __shfl_xor(ss, 32);
                if (fq == 0) atomicAdd(rssn + row, (unsigned long long)(ss * 16777216.f));
            }
    }
};
struct EpiBranch {
    const bf16_t* G0; bf16_t* MB;
    __device__ __forceinline__ void operator()(AccRef acc, const Unit& u, int wr, int wc, int fr, int fq) const {
        const int row0 = u.pm * BM + wr * 64 + fr, col0 = u.pn * BM + wc * 32 + 8 * fq;
        const bf16_t* G = G0 + u.seg * 2048; const bool accum = u.seg > 0;
#pragma unroll
        for (int ai = 0; ai < 2; ++ai)
#pragma unroll
            for (int m = 0; m < 4; ++m) {
                const int row = row0 + ai * HALF + m * 16;
#pragma unroll
                for (int bj = 0; bj < 2; ++bj) {
                    const int col = col0 + bj * HALF;
                    const u32x4 gv = *(const u32x4*)(G + (size_t)row * ZW + col);
                    u32x4 pv = (u32x4){0u, 0u, 0u, 0u};
                    if (accum) pv = *(const u32x4*)(MB + (size_t)row * DM + col);
                    const f32x4 a0 = acc[ai][bj][m][0], a1 = acc[ai][bj][m][1];
                    u32x4 o;
                    o.x = pk2(bflo(pv.x) + bflo(gv.x) * a0[0], bfhi(pv.x) + bfhi(gv.x) * a0[1]);
                    o.y = pk2(bflo(pv.y) + bflo(gv.y) * a0[2], bfhi(pv.y) + bfhi(gv.y) * a0[3]);
                    o.z = pk2(bflo(pv.z) + bflo(gv.z) * a1[0], bfhi(pv.z) + bfhi(gv.z) * a1[1]);
                    o.w = pk2(bflo(pv.w) + bflo(gv.w) * a1[2], bfhi(pv.w) + bfhi(gv.w) * a1[3]);
                    *(u32x4*)(MB + (size_t)row * DM + col) = o;
                }
            }
    }
};
struct EpiGlu {
    const bf16_t* YS; bf16_t* Y;
    __device__ __forceinline__ void operator()(AccRef acc, const Unit& u, int wr, int wc, int fr, int fq) const {
        const int row0 = u.pm * BM + wr * 64 + fr, col0 = u.pn * BM + wc * 32 + 8 * fq;
#pragma unroll
        for (int ai = 0; ai < 2; ++ai)
#pragma unroll
            for (int m = 0; m < 4; ++m) {
                const int row = row0 + ai * HALF + m * 16;
#pragma unroll
                for (int bj = 0; bj < 2; ++bj) {
                    const int col = col0 + bj * HALF;
                    const u32x4 yv = *(const u32x4*)(YS + (size_t)row * 512 + col);
                    const f32x4 a0 = acc[ai][bj][m][0], a1 = acc[ai][bj][m][1];
                    u32x4 o;
                    o.x = pk2(bflo(yv.x) * sigmoid_f(a0[0]), bfhi(yv.x) * sigmoid_f(a0[1]));
                    o.y = pk2(bflo(yv.y) * sigmoid_f(a0[2]), bfhi(yv.y) * sigmoid_f(a0[3]));
                    o.z = pk2(bflo(yv.z) * sigmoid_f(a1[0]), bfhi(yv.z) * sigmoid_f(a1[1]));
                    o.w = pk2(bflo(yv.w) * sigmoid_f(a1[2]), bfhi(yv.w) * sigmoid_f(a1[3]));
                    *(u32x4*)(Y + (size_t)row * DM + YC_SSM + col) = o;
                }
            }
    }
};
}

struct Args { const float* in[28]; float* out; unsigned char* ws; int ph_lo, ph_hi; };
enum { I_X = 0, I_F1N, I_F1G, I_F1U, I_F1D, I_MIXN, I_WIN, I_POOLW, I_POOLS, I_GW2, I_GB, I_GNORM, I_ARE, I_AIM, I_LDT, I_BRE, I_BIM, I_CRE, I_CIM,
       I_SD, I_WGLU, I_WBR, I_WOUT, I_F2N, I_F2G, I_F2U, I_F2D, I_FINN };

__device__ __forceinline__ void tr_item(const float* W, int ldw, int col0, const float* ksc, bf16_t* WT, int ldt, int drow, int k0, int n0, unsigned* scr, int lane) {
    const int a = lane & 15, b = lane >> 4;
    const float* src = W + (size_t)(k0 + 2 * b) * ldw + col0 + n0 + a * 4;
    f32x4 v[16];
#pragma unroll
    for (int m = 0; m < 8; ++m) { v[2 * m] = *(const f32x4*)(src + (size_t)(8 * m) * ldw); v[2 * m + 1] = *(const f32x4*)(src + (size_t)(8 * m + 1) * ldw); }
#pragma unroll
    for (int m = 0; m < 8; ++m) {
        const float s0 = ksc ? ksc[k0 + 8 * m + 2 * b] : 1.f, s1 = ksc ? ksc[k0 + 8 * m + 2 * b + 1] : 1.f;
#pragma unroll
        for (int e = 0; e < 4; ++e) scr[(4 * a + e) * 32 + (((m ^ (a & 7)) << 2) | b)] = pk2(v[2 * m][e] * s0, v[2 * m + 1][e] * s1);
    }
    LDS_WAIT();
#pragma unroll
    for (int j = 0; j < 8; ++j) { const int n = (lane >> 3) + 8 * j, c = lane & 7;
        const u32x4 o = *(const u32x4*)(scr + n * 32 + ((c ^ ((n >> 2) & 7)) << 2));
        *(u32x4*)(WT + (size_t)(drow + n) * ldt + k0 + c * 8) = o; }
    LDS_WAIT();
}
__device__ __forceinline__ bool tr_try(int& r, const float* W, int ldw, int K, int N, int col0, const float* ksc, bf16_t* WT, int ldt, int drow0, int mode, unsigned* scr, int lane) {
    const int nblk = N / 64, items = (K / 64) * nblk;
    if (r >= items) { r -= items; return false; }
    const int kb = r / nblk, n0 = (r % nblk) * 64;
    const int drow = drow0 + (mode ? ((n0 >> 7) * 256 + (n0 & 127)) : n0);
    tr_item(W, ldw, col0, ksc, WT, ldt, drow, kb * 64, n0, scr, lane);
    return true;
}

__device__ __forceinline__ void cpow_d(double th, double la, int j, double& pr, double& pi) {
    const double y = th * (double)j;
    const double kq = __builtin_rint(y * 0.63661977236758134308);
    double r = __builtin_fma(-kq, 1.57079632679489655800, y); r = __builtin_fma(-kq, 6.12323399573676603587e-17, r);
    const double r2 = r * r;
    double s = 1.0 - r2 * (1.0 / 272.0); s = 1.0 - r2 * (1.0 / 210.0) * s; s = 1.0 - r2 * (1.0 / 156.0) * s; s = 1.0 - r2 * (1.0 / 110.0) * s; s = 1.0 - r2 * (1.0 / 72.0) * s; s = 1.0 - r2 * (1.0 / 42.0) * s; s = 1.0 - r2 * (1.0 / 20.0) * s; s = 1.0 - r2 * (1.0 / 6.0) * s; s *= r;
    double c = 1.0 - r2 * (1.0 / 240.0); c = 1.0 - r2 * (1.0 / 182.0) * c; c = 1.0 - r2 * (1.0 / 132.0) * c; c = 1.0 - r2 * (1.0 / 90.0) * c; c = 1.0 - r2 * (1.0 / 56.0) * c; c = 1.0 - r2 * (1.0 / 30.0) * c; c = 1.0 - r2 * (1.0 / 12.0) * c; c = 1.0 - r2 * (1.0 / 2.0) * c;
    const int q = ((int)kq) & 3;
    double sn = s, cs = c;
    if (q == 1) { sn = c; cs = -s; } else if (q == 2) { sn = -s; cs = -c; } else if (q == 3) { sn = -c; cs = s; }
    const double x = la * (double)j * (1.0 * (1.0 / 64.0));
    double e = 1.0 + x * (1.0 / 10.0); e = 1.0 + x * (1.0 / 9.0) * e; e = 1.0 + x * (1.0 / 8.0) * e; e = 1.0 + x * (1.0 / 7.0) * e; e = 1.0 + x * (1.0 / 6.0) * e; e = 1.0 + x * (1.0 / 5.0) * e; e = 1.0 + x * (1.0 / 4.0) * e; e = 1.0 + x * (1.0 / 3.0) * e; e = 1.0 + x * (1.0 / 2.0) * e; e = 1.0 + x * e;
#pragma unroll
    for (int i = 0; i < 6; ++i) e = e * e;
    pr = e * cs; pi = e * sn;
}

__device__ __forceinline__ void phase_prep(const Args& a, int l, unsigned char* lds, int G) {
    const int tid = otid(), lane = tid & 63, wave = tid >> 6;
    unsigned char* ws = a.ws;
    const int gw = blockIdx.x * 8 + wave, NGW = G * 8;
    unsigned* scr = (unsigned*)(lds + wave * 16384);
    const float* f1n = a.in[I_F1N] + (size_t)l * DM; const float* f2n = a.in[I_F2N] + (size_t)l * DM; const float* mxn = a.in[I_MIXN] + (size_t)l * DM;
    const float* f1g = a.in[I_F1G] + (size_t)l * DM * FF; const float* f1u = a.in[I_F1U] + (size_t)l * DM * FF; const float* f1d = a.in[I_F1D] + (size_t)l * FF * DM;
    const float* f2g = a.in[I_F2G] + (size_t)l * DM * FF; const float* f2u = a.in[I_F2U] + (size_t)l * DM * FF; const float* f2d = a.in[I_F2D] + (size_t)l * FF * DM;
    const float* win = a.in[I_WIN] + (size_t)l * DM * INW; const float* wbr = a.in[I_WBR] + (size_t)l * DM * DM; const float* wout = a.in[I_WOUT] + (size_t)l * DM * DM;
    const float* wglu = a.in[I_WGLU] + (size_t)l * 512 * 512;
    constexpr int IT_FU = (DM / 64) * (FF / 64), IT_FD = (FF / 64) * (DM / 64), IT_WA = (DM / 64) * (3584 / 64), IT_WB = (DM / 64) * (6656 / 64),
                  IT_BR = (1536 / 64) * (DM / 64), IT_WO = (DM / 64) * (DM / 64), IT_GL = (512 / 64) * (512 / 64);
    constexpr int IT_TOTAL = 4 * IT_FU + 2 * IT_FD + IT_WA + IT_WB + IT_BR + IT_WO + IT_GL;
    for (int it = gw; it < IT_TOTAL; it += NGW) {
        int r = it;
        if (tr_try(r, f1g, FF, DM, FF, 0, f1n, (bf16_t*)(ws + WS_W1U), DM, 0, 1, scr, lane)) continue;
        if (tr_try(r, f1u, FF, DM, FF, 0, f1n, (bf16_t*)(ws + WS_W1U), DM, 128, 1, scr, lane)) continue;
        if (tr_try(r, f2g, FF, DM, FF, 0, f2n, (bf16_t*)(ws + WS_W2U), DM, 0, 1, scr, lane)) continue;
        if (tr_try(r, f2u, FF, DM, FF, 0, f2n, (bf16_t*)(ws + WS_W2U), DM, 128, 1, scr, lane)) continue;
        if (tr_try(r, f1d, DM, FF, DM, 0, nullptr, (bf16_t*)(ws + WS_W1D), FF, 0, 0, scr, lane)) continue;
        if (tr_try(r, f2d, DM, FF, DM, 0, nullptr, (bf16_t*)(ws + WS_W2D), FF, 0, 0, scr, lane)) continue;
        if (tr_try(r, win, INW, DM, 3584, 0, mxn, (bf16_t*)(ws + WS_WIN), DM, 0, 0, scr, lane)) continue;
        if (tr_try(r, win, INW, DM, 6656, 3600, mxn, (bf16_t*)(ws + WS_WIN), DM, 3584, 0, scr, lane)) continue;
        if (tr_try(r, wbr + (size_t)512 * DM, DM, 1536, DM, 0, nullptr, (bf16_t*)(ws + WS_WBR) + 512, DM, 0, 0, scr, lane)) continue;
        if (tr_try(r, wout, DM, DM, DM, 0, nullptr, (bf16_t*)(ws + WS_WO), DM, 0, 0, scr, lane)) continue;
        tr_try(r, wglu, 512, 512, 512, 0, nullptr, (bf16_t*)(ws + WS_WGLU), 512, 0, 0, scr, lane);
    }
    {
        const float* pw = a.in[I_POOLW] + (size_t)l * 4 * 128 * 128; const float* ps = a.in[I_POOLS] + (size_t)l * 512;
        bf16_t* WbT = (bf16_t*)(ws + WS_WBR);
        const int n0 = blockIdx.x * 8, k = tid, g = k >> 7;
        const float* pr = pw + (size_t)k * 128;
        float s[8];
#pragma unroll
        for (int i = 0; i < 8; ++i) s[i] = 0.f;
#pragma unroll 4
        for (int d = 0; d < 128; ++d) {
            const float pv = pr[d] * ps[g * 128 + d];
            const f32x4 w0 = *(const f32x4*)(wbr + (size_t)(g * 128 + d) * DM + n0), w1 = *(const f32x4*)(wbr + (size_t)(g * 128 + d) * DM + n0 + 4);
            s[0] += pv * w0[0]; s[1] += pv * w0[1]; s[2] += pv * w0[2]; s[3] += pv * w0[3]; s[4] += pv * w1[0]; s[5] += pv * w1[1]; s[6] += pv * w1[2]; s[7] += pv * w1[3];
        }
#pragma unroll
        for (int i = 0; i < 8; ++i) WbT[(size_t)(n0 + i) * DM + k] = (bf16_t)f2bf(s[i]);
    }
    {
        bf16_t* WGT = (bf16_t*)(ws + WS_WGT);
        for (int i = blockIdx.x * 512 + tid; i < 16 * DM; i += G * 512) { const int j = i >> 11, k = i & 2047; WGT[i] = (bf16_t)f2bf(mxn[k] * win[(size_t)k * INW + 3584 + j]); }
    }
    {
        const float* are = a.in[I_ARE] + (size_t)l * 32 * 64; const float* aim = a.in[I_AIM] + (size_t)l * 32 * 64; const float* ldt = a.in[I_LDT] + (size_t)l * 32;
        const float* bre = a.in[I_BRE] + (size_t)l * 32 * 64 * 16; const float* bim = a.in[I_BIM] + (size_t)l * 32 * 64 * 16;
        const float* cre = a.in[I_CRE] + (size_t)l * 32 * 16 * 64; const float* cim = a.in[I_CIM] + (size_t)l * 32 * 16 * 64;
        const float* sd = a.in[I_SD] + (size_t)l * 512;
        bf16_t* KT = (bf16_t*)(ws + WS_KT); bf16_t* MET = (bf16_t*)(ws + WS_MET); bf16_t* MCT = (bf16_t*)(ws + WS_MCT); float* L64 = (float*)(ws + WS_L64);
        float* s_cr = (float*)lds;
        float* s_ci = s_cr + 1024;
        float* s_bbr = s_ci + 1024;
        float* s_bbi = s_bbr + 1024;
        float* s_pw = s_bbi + 1024;
        float* s_f = s_pw + 1024;
        __syncthreads();
        for (int it = blockIdx.x; it < 32 * 9; it += G) {
            const int g = it / 9, jb = it % 9;
            {
                const int p = tid & 63, jj = tid >> 6, j = jb * 8 + jj;
                const double dt = (double)expf(ldt[g]);
                const double ar = (double)are[g * 64 + p], ai = (double)aim[g * 64 + p];
                if (j <= 64) { double pr, pi; cpow_d(dt * ai, dt * ar, j, pr, pi); s_pw[(jj * 64 + p) * 2] = (float)pr; s_pw[(jj * 64 + p) * 2 + 1] = (float)pi;
                    if (j == 64) { L64[(g * 64 + p) * 2] = (float)pr; L64[(g * 64 + p) * 2 + 1] = (float)pi; } }
                if (tid < 64) {
                    double l1r, l1i; cpow_d(dt * ai, dt * ar, 1, l1r, l1i);
                    const double den = ar * ar + ai * ai;
                    s_f[2 * p] = (float)(((l1r - 1.0) * ar + l1i * ai) / den); s_f[2 * p + 1] = (float)((l1i * ar - (l1r - 1.0) * ai) / den);
                }
#pragma unroll
                for (int i = 0; i < 2; ++i) { const int idx = tid + i * 512; s_cr[idx] = cre[(size_t)g * 1024 + idx]; s_ci[idx] = cim[(size_t)g * 1024 + idx]; }
            }
            __syncthreads();
#pragma unroll
            for (int i = 0; i < 2; ++i) { const int idx = tid + i * 512, p = idx >> 4; const float fr = s_f[2 * p], fi = s_f[2 * p + 1];
                const float br = bre[(size_t)g * 1024 + idx], bi = bim[(size_t)g * 1024 + idx];
                s_bbr[idx] = fr * br - fi * bi; s_bbi[idx] = fr * bi + fi * br; }
            __syncthreads();
#pragma unroll 1
            for (int i = 0; i < 4; ++i) {
                const int o = tid + i * 512, jj = o >> 8, h = (o >> 4) & 15, hp = o & 15, j = jb * 8 + jj;
                if (j < 64) {
                    float sacc = 0.f;
#pragma unroll 8
                    for (int p = 0; p < 64; ++p) { const float cr = s_cr[h * 64 + p], ci = s_ci[h * 64 + p], pr = s_pw[(jj * 64 + p) * 2], pi = s_pw[(jj * 64 + p) * 2 + 1];
                        sacc += (cr * pr - ci * pi) * s_bbr[p * 16 + hp] - (cr * pi + ci * pr) * s_bbi[p * 16 + hp]; }
                    if (j == 0 && h == hp) sacc += sd[g * 16 + h];
                    KT[((size_t)(g * 64 + j) * 16 + h) * 16 + hp] = (bf16_t)f2bf(sacc);
                }
            }
#pragma unroll 4
            for (int i = 0; i < 16; ++i) {
                const int o = tid + i * 512, jj = o >> 10, j = jb * 8 + jj;
                if (j < 64) { const int p = (o >> 4) & 63, hp = o & 15; const float pr = s_pw[(jj * 64 + p) * 2], pi = s_pw[(jj * 64 + p) * 2 + 1], br = s_bbr[p * 16 + hp], bi = s_bbi[p * 16 + hp];
                    const int jp = 63 - j;
                    MET[((size_t)(g * 128 + p) * 64 + jp) * 16 + hp] = (bf16_t)f2bf(pr * br - pi * bi);
                    MET[((size_t)(g * 128 + 64 + p) * 64 + jp) * 16 + hp] = (bf16_t)f2bf(pr * bi + pi * br); }
                if (j >= 1 && j <= 64) { const int h = (o >> 6) & 15, p = o & 63; const float cr = s_cr[h * 64 + p], ci = s_ci[h * 64 + p], pr = s_pw[(jj * 64 + p) * 2], pi = s_pw[(jj * 64 + p) * 2 + 1];
                    const size_t base = ((size_t)g * 1024 + (j - 1) * 16 + h) * 128;
                    MCT[base + p] = (bf16_t)f2bf(cr * pr - ci * pi); MCT[base + 64 + p] = (bf16_t)f2bf(-(cr * pi + ci * pr)); }
            }
            __syncthreads();
        }
    }
    if (l == 0) {
        const float* x = a.in[I_X]; bf16_t* XB = (bf16_t*)(ws + WS_XB); unsigned long long* rss = (unsigned long long*)(ws + WS_RSS);
        for (int row = gw; row < T; row += NGW) {
            const f32x4* xr = (const f32x4*)(x + (size_t)row * DM) + lane; u32x2* o = (u32x2*)(XB + (size_t)row * DM) + lane;
            float ss = 0.f;
#pragma unroll
            for (int i = 0; i < 8; ++i) { const f32x4 v = xr[64 * i]; ss += v[0] * v[0] + v[1] * v[1] + v[2] * v[2] + v[3] * v[3]; u32x2 w; w.x = pk2(v[0], v[1]); w.y = pk2(v[2], v[3]); o[64 * i] = w; }
            ss = wave_sum(ss);
            if (lane == 0) rss[row] = (unsigned long long)(ss * 16777216.f);
        }
        for (int i = blockIdx.x * 512 + tid; i < 6 * T; i += G * 512) rss[T + i] = 0ull;
    }
}

__device__ __forceinline__ void phase_glr(const Args& a, const unsigned long long* rss, int G) {
    const int tid = otid(), lane = tid & 63, wave = tid >> 6, r16 = lane & 15, quad = lane >> 4;
    const int gw = blockIdx.x * 8 + wave, NGW = G * 8;
    const bf16_t* XB = (const bf16_t*)(a.ws + WS_XB); const bf16_t* WGT = (const bf16_t*)(a.ws + WS_WGT); float* GLR = (float*)(a.ws + WS_GLR);
    for (int task = gw; task < T / 16; task += NGW) {
        const int r0 = task * 16;
        f32x4 acc = (f32x4){0.f, 0.f, 0.f, 0.f};
        const bf16_t* ap = XB + (size_t)(r0 + r16) * DM + quad * 8; const bf16_t* bp = WGT + (size_t)r16 * DM + quad * 8;
#pragma unroll 8
        for (int kb = 0; kb < 64; ++kb) acc = mfma16(*(const bf16x8*)(ap + kb * 32), *(const bf16x8*)(bp + kb * 32), acc);
#pragma unroll
        for (int i = 0; i < 4; ++i) { const int row = r0 + quad * 4 + i; GLR[(size_t)row * 16 + r16] = acc[i] * rsqrtf((float)rss[row] * (1.f / (16777216.f * DM)) + EPS); }
    }
}

template <int W>
__device__ __forceinline__ void pool_group(const bf16_t* Z, bf16_t* Y, int c00, int G) {
    for (int idx = blockIdx.x * 512 + otid(); idx < T * 16; idx += G * 512) {
        const int t = idx >> 4, c0 = c00 + (idx & 15) * 8, s = t & (SEQ - 1);
        const int cnt = (s + 1) < W ? (s + 1) : W;
        u32x4 v[W];
#pragma unroll
        for (int j = 0; j < W; ++j) { const int tj = (j < cnt) ? (t - j) : t; v[j] = *(const u32x4*)(Z + (size_t)tj * ZW + ZC_POOL + c0); }
        float sum[8];
#pragma unroll
        for (int i = 0; i < 8; ++i) sum[i] = 0.f;
#pragma unroll
        for (int j = 0; j < W; ++j) { const float m = (j < cnt) ? 1.f : 0.f;
            sum[0] += m * bflo(v[j].x); sum[1] += m * bfhi(v[j].x); sum[2] += m * bflo(v[j].y); sum[3] += m * bfhi(v[j].y);
            sum[4] += m * bflo(v[j].z); sum[5] += m * bfhi(v[j].z); sum[6] += m * bflo(v[j].w); sum[7] += m * bfhi(v[j].w); }
        const float inv = 1.f / (float)cnt;
        u32x4 o; o.x = pk2(sum[0] * inv - bflo(v[0].x), sum[1] * inv - bfhi(v[0].x)); o.y = pk2(sum[2] * inv - bflo(v[0].y), sum[3] * inv - bfhi(v[0].y));
        o.z = pk2(sum[4] * inv - bflo(v[0].z), sum[5] * inv - bfhi(v[0].z)); o.w = pk2(sum[6] * inv - bflo(v[0].w), sum[7] * inv - bfhi(v[0].w));
        *(u32x4*)(Y + (size_t)t * DM + c0) = o;
    }
}
__device__ __forceinline__ void phase_pool(const Args& a, int G) {
    const bf16_t* Z = (const bf16_t*)(a.ws + WS_Z); bf16_t* Y = (bf16_t*)(a.ws + WS_Y);
    pool_group<2>(Z, Y, 0, G); pool_group<4>(Z, Y, 128, G); pool_group<8>(Z, Y, 256, G); pool_group<16>(Z, Y, 384, G);
}

constexpr int OFF_BC = 0, OFF_QP = 32768, OFF_KP = 50176, OFF_OB = 0, OFF_QD = 67584, OFF_VT = 84992, OFF_PB = 121856, OFF_GL = 131072, OFF_TOT = 135168;
constexpr int PQ = 136, PV = 72, POB = 260;

__device__ __forceinline__ void gla_bc(const Args& a, int l, unsigned char* lds, int t0, int h) {
    const int tid = otid(), d = tid & 127, jq = tid >> 7;
    float* BC = (float*)(lds + OFF_BC); float* GL = (float*)(lds + OFF_GL); float* TOT = (float*)(lds + OFF_TOT);
    const float* GLR = (const float*)(a.ws + WS_GLR);
    const float* w2 = a.in[I_GW2] + (size_t)l * 16 * 512; const float* gb = a.in[I_GB] + (size_t)l * 512;
    for (int i = tid; i < 1024; i += 512) GL[i] = GLR[(size_t)t0 * 16 + i];
    float w[16];
#pragma unroll
    for (int r = 0; r < 16; ++r) w[r] = w2[r * 512 + h * 128 + d];
    const float bias = gb[h * 128 + d];
    __syncthreads();
    float run = 0.f;
#pragma unroll 4
    for (int jj = 0; jj < 16; ++jj) {
        const int j = jq * 16 + jj;
        float z = bias;
#pragma unroll
        for (int r = 0; r < 16; ++r) z += GL[j * 16 + r] * w[r];
        const float la = (fminf(z, 0.f) - __logf(1.f + __expf(-fabsf(z)))) * (1.f / 16.f);
        run += la; BC[j * 128 + d] = run;
    }
    TOT[jq * 128 + d] = run;
    __syncthreads();
    float off = 0.f;
    for (int q = 0; q < jq; ++q) off += TOT[q * 128 + d];
    if (jq > 0) {
#pragma unroll 4
        for (int jj = 0; jj < 16; ++jj) BC[(jq * 16 + jj) * 128 + d] += off;
    }
    __syncthreads();
}

__device__ __forceinline__ int tsw(int x, int j) { return x * PV + ((((j >> 3) ^ ((x >> 3) & 7)) << 3) | (j & 7)); }
__device__ __forceinline__ int tsc(int x, int c) { return x * PV + ((c ^ ((x >> 3) & 7)) << 3); }
__device__ __forceinline__ float bfe(const u32x4& v, int e) { const unsigned w = (e < 2) ? v.x : (e < 4) ? v.y : (e < 6) ? v.z : v.w; return (e & 1) ? bfhi(w) : bflo(w); }
__device__ __forceinline__ unsigned short bfr(const u32x4& v, int e) { const unsigned w = (e < 2) ? v.x : (e < 4) ? v.y : (e < 6) ? v.z : v.w; return (unsigned short)((e & 1) ? (w >> 16) : (w & 0xffffu)); }

__device__ __forceinline__ void gla_kv_unit(const Args& a, int l, unsigned char* lds, int unit) {
    const int tid = otid(), lane = tid & 63, wave = tid >> 6, r16 = lane & 15, quad = lane >> 4;
    const int bh = unit >> 6, n = unit & 63, b = bh >> 2, h = bh & 3, t0 = b * SEQ + n * 64;
    const bf16_t* Z = (const bf16_t*)(a.ws + WS_Z); bf16_t* KV = (bf16_t*)(a.ws + WS_KV); float* DEC = (float*)(a.ws + WS_DEC);
    u32x4 kreg[2], vreg[4];
#pragma unroll
    for (int i = 0; i < 2; ++i) { const int p = tid + 512 * i; kreg[i] = *(const u32x4*)(Z + (size_t)(t0 + (p >> 4)) * ZW + ZC_K + h * 128 + (p & 15) * 8); }
#pragma unroll
    for (int i = 0; i < 4; ++i) { const int p = tid + 512 * i; vreg[i] = *(const u32x4*)(Z + (size_t)(t0 + (p >> 5)) * ZW + ZC_V + h * 256 + (p & 31) * 8); }
    gla_bc(a, l, lds, t0, h);
    const float* BC = (const float*)(lds + OFF_BC); bf16_t* KTl = (bf16_t*)(lds + OFF_QP); bf16_t* VT = (bf16_t*)(lds + OFF_VT);
#pragma unroll
    for (int i = 0; i < 2; ++i) {
        const int p = tid + 512 * i, j = p >> 4, d0 = (p & 15) * 8;
        const f32x4 bl0 = *(const f32x4*)(BC + 63 * 128 + d0), bl1 = *(const f32x4*)(BC + 63 * 128 + d0 + 4);
        const f32x4 bc0 = *(const f32x4*)(BC + j * 128 + d0), bc1 = *(const f32x4*)(BC + j * 128 + d0 + 4);
#pragma unroll
        for (int e = 0; e < 8; ++e) { const float bl = e < 4 ? bl0[e & 3] : bl1[e & 3], bc = e < 4 ? bc0[e & 3] : bc1[e & 3];
            KTl[tsw(d0 + e, j)] = (bf16_t)f2bf(bfe(kreg[i], e) * __expf(bl - bc)); }
    }
    if (tid < 128) DEC[(size_t)unit * 128 + tid] = __expf(BC[63 * 128 + tid]);
#pragma unroll
    for (int i = 0; i < 4; ++i) {
        const int p = tid + 512 * i, j = p >> 5, v0 = (p & 31) * 8;
#pragma unroll
        for (int e = 0; e < 8; ++e) VT[tsw(v0 + e, j)] = bfr(vreg[i], e);
    }
    __syncthreads();
    f32x4 acc[8][2];
#pragma unroll
    for (int i = 0; i < 8; ++i) { acc[i][0] = (f32x4){0.f, 0.f, 0.f, 0.f}; acc[i][1] = (f32x4){0.f, 0.f, 0.f, 0.f}; }
#pragma unroll
    for (int kb = 0; kb < 2; ++kb) {
        bf16x8 bf[2];
#pragma unroll
        for (int v2 = 0; v2 < 2; ++v2) bf[v2] = *(const bf16x8*)(VT + tsc((wave * 2 + v2) * 16 + r16, kb * 4 + quad));
#pragma unroll
        for (int db = 0; db < 8; ++db) { const bf16x8 af = *(const bf16x8*)(KTl + tsc(db * 16 + r16, kb * 4 + quad));
            acc[db][0] = mfma16(af, bf[0], acc[db][0]); acc[db][1] = mfma16(af, bf[1], acc[db][1]); }
    }
#pragma unroll
    for (int db = 0; db < 8; ++db)
#pragma unroll
        for (int v2 = 0; v2 < 2; ++v2) { const int v = (wave * 2 + v2) * 16 + r16; u32x2 o; o.x = pk2(acc[db][v2][0], acc[db][v2][1]); o.y = pk2(acc[db][v2][2], acc[db][v2][3]);
            *(u32x2*)(KV + ((size_t)unit * 256 + v) * 128 + db * 16 + quad * 4) = o; }
    __syncthreads();
}

__device__ __forceinline__ void gla_scan(const Args& a, int G) {
    bf16_t* KV = (bf16_t*)(a.ws + WS_KV); const float* DEC = (const float*)(a.ws + WS_DEC);
    for (int id = blockIdx.x * 512 + otid(); id < 16 * 256 * 32; id += G * 512) {
        const int bh = id >> 13, v = (id >> 5) & 255, d0 = (id & 31) * 4;
        float s0 = 0.f, s1 = 0.f, s2 = 0.f, s3 = 0.f;
#pragma unroll 8
        for (int n = 0; n < 64; ++n) {
            const int unit = bh * 64 + n;
            u32x2* p = (u32x2*)(KV + ((size_t)unit * 256 + v) * 128 + d0);
            const u32x2 kv = *p; const f32x4 dc = *(const f32x4*)(DEC + (size_t)unit * 128 + d0);
            u32x2 o; o.x = pk2(s0, s1); o.y = pk2(s2, s3); *p = o;
            s0 = dc[0] * s0 + bflo(kv.x); s1 = dc[1] * s1 + bfhi(kv.x); s2 = dc[2] * s2 + bflo(kv.y); s3 = dc[3] * s3 + bfhi(kv.y);
        }
    }
}

__device__ __forceinline__ void gla_out_unit(const Args& a, int l, unsigned char* lds, int unit) {
    const int tid = otid(), lane = tid & 63, wave = tid >> 6, r16 = lane & 15, quad = lane >> 4;
    const int bh = unit >> 6, n = unit & 63, b = bh >> 2, h = bh & 3, t0 = b * SEQ + n * 64;
    const bf16_t* Z = (const bf16_t*)(a.ws + WS_Z); const bf16_t* KV = (const bf16_t*)(a.ws + WS_KV); bf16_t* Y = (bf16_t*)(a.ws + WS_Y);
    u32x4 qreg[2], kreg[2], vreg[4];
#pragma unroll
    for (int i = 0; i < 2; ++i) { const int p = tid + 512 * i; const bf16_t* rp = Z + (size_t)(t0 + (p >> 4)) * ZW + h * 128 + (p & 15) * 8;
        qreg[i] = *(const u32x4*)(rp + ZC_Q); kreg[i] = *(const u32x4*)(rp + ZC_K); }
#pragma unroll
    for (int i = 0; i < 4; ++i) { const int p = tid + 512 * i; vreg[i] = *(const u32x4*)(Z + (size_t)(t0 + (p >> 5)) * ZW + ZC_V + h * 256 + (p & 31) * 8); }
    gla_bc(a, l, lds, t0, h);
    const float* BC = (const float*)(lds + OFF_BC);
    bf16_t* QP = (bf16_t*)(lds + OFF_QP); bf16_t* KP = (bf16_t*)(lds + OFF_KP); bf16_t* QD = (bf16_t*)(lds + OFF_QD); bf16_t* VT = (bf16_t*)(lds + OFF_VT); bf16_t* PB = (bf16_t*)(lds + OFF_PB);
    float* OB = (float*)(lds + OFF_OB);
#pragma unroll
    for (int i = 0; i < 2; ++i) {
        const int p = tid + 512 * i, j = p >> 4, d0 = (p & 15) * 8;
        const f32x4 bm0 = *(const f32x4*)(BC + 31 * 128 + d0), bm1 = *(const f32x4*)(BC + 31 * 128 + d0 + 4);
        const f32x4 bc0 = *(const f32x4*)(BC + j * 128 + d0), bc1 = *(const f32x4*)(BC + j * 128 + d0 + 4);
        float qp[8], kp[8], qd[8];
#pragma unroll
        for (int e = 0; e < 8; ++e) { const float bm = e < 4 ? bm0[e & 3] : bm1[e & 3], bc = e < 4 ? bc0[e & 3] : bc1[e & 3];
            const float qv = bfe(qreg[i], e) * 0.08838834764831845f, kv = bfe(kreg[i], e);
            qp[e] = qv * __expf(bc - bm); kp[e] = kv * __expf(bm - bc); qd[e] = qv * __expf(bc); }
        u32x4 o; o.x = pk2(qp[0], qp[1]); o.y = pk2(qp[2], qp[3]); o.z = pk2(qp[4], qp[5]); o.w = pk2(qp[6], qp[7]); *(u32x4*)(QP + j * PQ + d0) = o;
        o.x = pk2(kp[0], kp[1]); o.y = pk2(kp[2], kp[3]); o.z = pk2(kp[4], kp[5]); o.w = pk2(kp[6], kp[7]); *(u32x4*)(KP + j * PQ + d0) = o;
        o.x = pk2(qd[0], qd[1]); o.y = pk2(qd[2], qd[3]); o.z = pk2(qd[4], qd[5]); o.w = pk2(qd[6], qd[7]); *(u32x4*)(QD + j * PQ + d0) = o;
    }
#pragma unroll
    for (int i = 0; i < 4; ++i) {
        const int p = tid + 512 * i, j = p >> 5, v0 = (p & 31) * 8;
#pragma unroll
        for (int e = 0; e < 8; ++e) VT[tsw(v0 + e, j)] = bfr(vreg[i], e);
    }
    bf16x8 bfk[4][2];
#pragma unroll
    for (int kb = 0; kb < 4; ++kb)
#pragma unroll
        for (int v2 = 0; v2 < 2; ++v2) bfk[kb][v2] = *(const bf16x8*)(KV + ((size_t)unit * 256 + (wave * 2 + v2) * 16 + r16) * 128 + kb * 32 + quad * 8);
    u32x2 rv8[8];
#pragma unroll
    for (int rr = 0; rr < 8; ++rr) rv8[rr] = *(const u32x2*)(Z + (size_t)(t0 + wave * 8 + rr) * ZW + ZC_R + h * 256 + lane * 4);
    __syncthreads();
    {
        const int ib = wave >> 1;
#pragma unroll
        for (int jbi = 0; jbi < 2; ++jbi) {
            const int jb = (wave & 1) * 2 + jbi;
            f32x4 sc = (f32x4){0.f, 0.f, 0.f, 0.f};
            if (jb <= ib) {
#pragma unroll
                for (int kb = 0; kb < 4; ++kb) sc = mfma16(*(const bf16x8*)(QP + (ib * 16 + r16) * PQ + kb * 32 + quad * 8), *(const bf16x8*)(KP + (jb * 16 + r16) * PQ + kb * 32 + quad * 8), sc);
            }
#pragma unroll
            for (int i = 0; i < 4; ++i) { const int row = ib * 16 + quad * 4 + i, col = jb * 16 + r16; PB[row * PV + col] = (bf16_t)f2bf(col <= row ? sc[i] : 0.f); }
        }
    }
    __syncthreads();
    f32x4 acc[4][2];
#pragma unroll
    for (int i = 0; i < 4; ++i) { acc[i][0] = (f32x4){0.f, 0.f, 0.f, 0.f}; acc[i][1] = (f32x4){0.f, 0.f, 0.f, 0.f}; }
#pragma unroll
    for (int kb = 0; kb < 2; ++kb) {
        bf16x8 bf[2];
#pragma unroll
        for (int v2 = 0; v2 < 2; ++v2) bf[v2] = *(const bf16x8*)(VT + tsc((wave * 2 + v2) * 16 + r16, kb * 4 + quad));
#pragma unroll
        for (int ib = 0; ib < 4; ++ib) { const bf16x8 af = *(const bf16x8*)(PB + (ib * 16 + r16) * PV + kb * 32 + quad * 8);
            acc[ib][0] = mfma16(af, bf[0], acc[ib][0]); acc[ib][1] = mfma16(af, bf[1], acc[ib][1]); }
    }
#pragma unroll
    for (int kb = 0; kb < 4; ++kb) {
#pragma unroll
        for (int ib = 0; ib < 4; ++ib) { const bf16x8 af = *(const bf16x8*)(QD + (ib * 16 + r16) * PQ + kb * 32 + quad * 8);
            acc[ib][0] = mfma16(af, bfk[kb][0], acc[ib][0]); acc[ib][1] = mfma16(af, bfk[kb][1], acc[ib][1]); }
    }
#pragma unroll
    for (int ib = 0; ib < 4; ++ib)
#pragma unroll
        for (int v2 = 0; v2 < 2; ++v2)
#pragma unroll
            for (int i = 0; i < 4; ++i) OB[(ib * 16 + quad * 4 + i) * POB + (wave * 2 + v2) * 16 + r16] = acc[ib][v2][i];
    __syncthreads();
    {
        const float* gn = a.in[I_GNORM] + (size_t)l * 1024 + h * 256 + lane * 4;
        const f32x4 gain = *(const f32x4*)gn;
#pragma unroll
        for (int rr = 0; rr < 8; ++rr) {
            const int i = wave * 8 + rr;
            const f32x4 v = *(const f32x4*)(OB + i * POB + lane * 4);
            const float ss = wave_sum(v[0] * v[0] + v[1] * v[1] + v[2] * v[2] + v[3] * v[3]);
            const float rinv = rsqrtf(ss * (1.f / 256.f) + EPS);
            const u32x2 rv = rv8[rr];
            const float r0 = bflo(rv.x), r1 = bfhi(rv.x), r2 = bflo(rv.y), r3 = bfhi(rv.y);
            u32x2 o; o.x = pk2(v[0] * rinv * gain[0] * r0 * sigmoid_f(r0), v[1] * rinv * gain[1] * r1 * sigmoid_f(r1));
            o.y = pk2(v[2] * rinv * gain[2] * r2 * sigmoid_f(r2), v[3] * rinv * gain[3] * r3 * sigmoid_f(r3));
            *(u32x2*)(Y + (size_t)(t0 + i) * DM + YC_GLA + h * 256 + lane * 4) = o;
        }
    }
    __syncthreads();
}

__device__ __forceinline__ void ssm_end_unit(const Args& a, int unit) {
    const int tid = otid(), lane = tid & 63, wave = tid >> 6, r16 = lane & 15, quad = lane >> 4;
    const int g = unit >> 2, rb = unit & 3;
    const bf16_t* Z = (const bf16_t*)(a.ws + WS_Z); const bf16_t* MET = (const bf16_t*)(a.ws + WS_MET); float* E = (float*)(a.ws + WS_E);
    const int crow = rb * 64 + (wave & 3) * 16, qg = (wave >> 2) * 64;
    const int ch = (quad & 1) * 8, jo = quad >> 1;
    f32x4 acc[4];
#pragma unroll
    for (int i = 0; i < 4; ++i) acc[i] = (f32x4){0.f, 0.f, 0.f, 0.f};
    const bf16_t* ap = Z + (size_t)((crow + r16) * 64 + jo) * ZW + ZC_S + g * 16 + ch;
    const bf16_t* bp = MET + ((size_t)(g * 128 + qg + r16) * 64 + jo) * 16 + ch;
#pragma unroll 4
    for (int kb = 0; kb < 32; ++kb) {
        const bf16x8 af = *(const bf16x8*)(ap + (size_t)kb * 2 * ZW);
#pragma unroll
        for (int nb = 0; nb < 4; ++nb) acc[nb] = mfma16(af, *(const bf16x8*)(bp + (size_t)nb * 16 * 1024 + kb * 32), acc[nb]);
    }
#pragma unroll
    for (int nb = 0; nb < 4; ++nb)
#pragma unroll
        for (int i = 0; i < 4; ++i) E[((size_t)(crow + quad * 4 + i) * 32 + g) * 128 + qg + nb * 16 + r16] = acc[nb][i];
}
__device__ __forceinline__ void ssm_scan(const Args& a, int id) {
    const int b = id >> 11, g = (id >> 6) & 31, p = id & 63;
    const float* E = (const float*)(a.ws + WS_E); bf16_t* HC = (bf16_t*)(a.ws + WS_HC); const float* L64 = (const float*)(a.ws + WS_L64);
    const float lr = L64[(g * 64 + p) * 2], li = L64[(g * 64 + p) * 2 + 1];
    float hr = 0.f, hi = 0.f;
#pragma unroll 8
    for (int n = 0; n < 64; ++n) {
        const size_t base = ((size_t)(b * 64 + n) * 32 + g) * 128;
        HC[base + p] = (bf16_t)f2bf(hr); HC[base + 64 + p] = (bf16_t)f2bf(hi);
        const float er = E[base + p], ei = E[base + 64 + p];
        const float nr = lr * hr - li * hi + er, ni = lr * hi + li * hr + ei;
        hr = nr; hi = ni;
    }
}
__device__ __forceinline__ void ssm_out_unit(const Args& a, int unit) {
    const int tid = otid(), lane = tid & 63, wave = tid >> 6, r16 = lane & 15, quad = lane >> 4;
    const int g = unit >> 4, cb = unit & 15;
    const bf16_t* Z = (const bf16_t*)(a.ws + WS_Z); const bf16_t* KT = (const bf16_t*)(a.ws + WS_KT); const bf16_t* MCT = (const bf16_t*)(a.ws + WS_MCT);
    const bf16_t* HC = (const bf16_t*)(a.ws + WS_HC); bf16_t* YS = (bf16_t*)(a.ws + WS_YS);
    const int ch = (quad & 1) * 8, jo = quad >> 1;
    f32x4 acc[2][4];
#pragma unroll
    for (int i = 0; i < 2; ++i)
#pragma unroll
        for (int k = 0; k < 4; ++k) acc[i][k] = (f32x4){0.f, 0.f, 0.f, 0.f};
    const int kbn = cb * 2 + 2;
    const bf16x8 zero8 = (bf16x8){0, 0, 0, 0, 0, 0, 0, 0};
    for (int kb0 = 0; kb0 < kbn; kb0 += 2) {
        bf16x8 af[2][2], bf[2][4];
#pragma unroll
        for (int u = 0; u < 2; ++u) {
            const int kb = kb0 + u, jp = kb * 2 + jo; const bool on = kb < kbn;
#pragma unroll
            for (int rk = 0; rk < 2; ++rk) af[u][rk] = on ? *(const bf16x8*)(Z + (size_t)((wave * 32 + rk * 16 + r16) * 64 + jp) * ZW + ZC_S + g * 16 + ch) : zero8;
#pragma unroll
            for (int nb = 0; nb < 4; ++nb) { const int dl = cb * 4 + nb - jp; bf[u][nb] = (on && dl >= 0) ? *(const bf16x8*)(KT + ((size_t)(g * 64 + dl) * 16 + r16) * 16 + ch) : zero8; }
        }
#pragma unroll
        for (int u = 0; u < 2; ++u)
#pragma unroll
            for (int nb = 0; nb < 4; ++nb) { acc[0][nb] = mfma16(af[u][0], bf[u][nb], acc[0][nb]); acc[1][nb] = mfma16(af[u][1], bf[u][nb], acc[1][nb]); }
    }
#pragma unroll
    for (int kb = 0; kb < 4; ++kb) {
        bf16x8 af[2];
#pragma unroll
        for (int rk = 0; rk < 2; ++rk) af[rk] = *(const bf16x8*)(HC + ((size_t)(wave * 32 + rk * 16 + r16) * 32 + g) * 128 + kb * 32 + quad * 8);
#pragma unroll
        for (int nb = 0; nb < 4; ++nb) { const bf16x8 bf = *(const bf16x8*)(MCT + ((size_t)g * 1024 + (cb * 4 + nb) * 16 + r16) * 128 + kb * 32 + quad * 8);
            acc[0][nb] = mfma16(af[0], bf, acc[0][nb]); acc[1][nb] = mfma16(af[1], bf, acc[1][nb]); }
    }
#pragma unroll
    for (int rk = 0; rk < 2; ++rk)
#pragma unroll
        for (int nb = 0; nb < 4; ++nb)
#pragma unroll
            for (int i = 0; i < 4; ++i) { const int chunk = wave * 32 + rk * 16 + quad * 4 + i, t = chunk * 64 + cb * 4 + nb;
                YS[(size_t)t * 512 + g * 16 + r16] = (bf16_t)f2bf(gelu_tanh_f(acc[rk][nb][i])); }
}

__device__ __forceinline__ void phase_final(const Args& a, int G) {
    const int tid = otid(), lane = tid & 63, wave = tid >> 6;
    const int gw = blockIdx.x * 8 + wave, NGW = G * 8;
    const unsigned long long* rss = (const unsigned long long*)(a.ws + WS_RSS) + (size_t)6 * T; const float* gf = a.in[I_FINN];
    for (int row = gw; row < T; row += NGW) {
        const float rinv = rsqrtf((float)rss[row] * (1.f / (16777216.f * DM)) + EPS);
        f32x4* xr = (f32x4*)(a.out + (size_t)row * DM) + lane; const f32x4* gr = (const f32x4*)gf + lane;
#pragma unroll
        for (int i = 0; i < 8; ++i) { f32x4 v = xr[64 * i]; const f32x4 gg = gr[64 * i]; v = v * rinv * gg; xr[64 * i] = v; }
    }
}


#define XB_TMO      128
#define XB_XCNT(j)  (256  + 64 * (j))
#define XB_XSUB(j)  (1280 + 64 * (j))
#define XB_XGEN(j)  (2304 + 64 * (j))
#define XB_TOP      3328
#define XB_TOPGEN   3392
#define XCD_BAR_WORDS 3456
#define XB_SPIN_CAP (1u << 18)
__device__ __forceinline__ unsigned xb_ld(unsigned* p)              { return __hip_atomic_load(p, __ATOMIC_RELAXED, __HIP_MEMORY_SCOPE_AGENT); }
__device__ __forceinline__ unsigned xb_add(unsigned* p, unsigned v) { return __hip_atomic_fetch_add(p, v, __ATOMIC_RELAXED, __HIP_MEMORY_SCOPE_AGENT); }
__device__ __forceinline__ unsigned xb_xcc_id() { return (unsigned)__builtin_amdgcn_s_getreg((3 << 11) | 20) & 0xFu; }
#define XB_SPIN(cond, bar) do { unsigned _sp = 0; while (cond) { __builtin_amdgcn_s_sleep(1); \
    if ((++_sp & 255u) == 0u) { if (xb_ld(&(bar)[XB_TMO])) break; if (_sp > XB_SPIN_CAP) { atomicAdd(&(bar)[XB_TMO], 1u); break; } } } } while (0)
struct XcdBarrier { unsigned* bar; unsigned x; volatile LAS unsigned* st; };
__device__ __forceinline__ XcdBarrier xcd_barrier_post(unsigned* bar, volatile LAS unsigned* st) {
    XcdBarrier b; b.bar = bar; b.x = xb_xcc_id(); b.st = st;
    if (threadIdx.x == 0) (void)xb_add(&bar[XB_XCNT(b.x)], 1u);
    return b;
}
__device__ __forceinline__ void xcd_barrier_complete(unsigned* bar, unsigned x, unsigned& nloc, unsigned& nx) {
    const unsigned G = gridDim.x * gridDim.y * gridDim.z;
    unsigned sum, cnt, mine, sp = 0u;
    for (;;) {
        sum = 0u; cnt = 0u; mine = 0u;
#pragma unroll
        for (unsigned j = 0; j < 16; ++j) { const unsigned c = xb_ld(&bar[XB_XCNT(j)]); sum += c; cnt += (c > 0u) ? 1u : 0u; mine = (j == x) ? c : mine; }
        if (sum == G) break;
        __builtin_amdgcn_s_sleep(1);
        if ((++sp & 255u) == 0u) { if (xb_ld(&bar[XB_TMO])) break; if (sp > XB_SPIN_CAP) { atomicAdd(&bar[XB_TMO], 1u); break; } }
    }
    nloc = mine > 0u ? mine : 1u; nx = cnt > 0u ? cnt : 1u;
}
__device__ __forceinline__ void xcd_barrier(const XcdBarrier& b) {
    asm volatile("s_waitcnt vmcnt(0)" ::: "memory");
    __syncthreads();
    if (threadIdx.x == 0) {
        unsigned* bar = b.bar;
        __builtin_amdgcn_s_waitcnt(0);
        unsigned nloc = b.st[0], nx = b.st[1];
        if (nloc == 0u) { xcd_barrier_complete(bar, b.x, nloc, nx); b.st[0] = nloc; b.st[1] = nx; }
        const unsigned old = xb_add(&bar[XB_XSUB(b.x)], 1u);
        const unsigned gen = old / nloc;
        if (old + 1u == (gen + 1u) * nloc) {
            __builtin_amdgcn_fence(__ATOMIC_RELEASE, "agent");
            asm volatile("s_waitcnt vmcnt(0)" ::: "memory");
            const unsigned og = xb_add(&bar[XB_TOP], 1u);
            const unsigned tg = og / nx;
            if (og + 1u == (tg + 1u) * nx) xb_add(&bar[XB_TOPGEN], 1u);
            else XB_SPIN(xb_ld(&bar[XB_TOPGEN]) == tg, bar);
            __builtin_amdgcn_fence(__ATOMIC_ACQUIRE, "agent");
            xb_add(&bar[XB_XGEN(b.x)], 1u);
            asm volatile("s_waitcnt vmcnt(0)" ::: "memory");
        } else {
            XB_SPIN(xb_ld(&bar[XB_XGEN(b.x)]) == gen, bar);
            __builtin_amdgcn_fence(__ATOMIC_ACQUIRE, "agent");
            asm volatile("s_waitcnt vmcnt(0)" ::: "memory");
        }
    }
    __syncthreads();
}

constexpr int PH_PER_LAYER = 12, N_PHASES = 2 * PH_PER_LAYER + 1;

__global__ void __launch_bounds__(512, 2) mega_fwd(Args a) {
    extern __shared__ __attribute__((aligned(16))) unsigned char lds[];
    cg::grid_group grid = cg::this_grid();
    constexpr int G = 256;
    unsigned char* ws = a.ws;
    LAS unsigned char* ldsl = (LAS unsigned char*)lds;
    unsigned long long* rssb = (unsigned long long*)(ws + WS_RSS);
    volatile LAS unsigned* bst = (volatile LAS unsigned*)(ldsl + (LDS_BYTES - 64));
    if (threadIdx.x < 2) bst[threadIdx.x] = 0u;
    __syncthreads();
    XcdBarrier bar = xcd_barrier_post((unsigned*)(ws + WS_BAR), bst);
#if !MK_MULTI_LAUNCH
    if (a.ph_hi - a.ph_lo > 1) grid.sync();
#endif
    for (int ph = a.ph_lo; ph < a.ph_hi; ++ph) {
        if (ph != a.ph_lo) xcd_barrier(bar);
        if (ph == N_PHASES - 1) { phase_final(a, G); continue; }
        const int l = ph / PH_PER_LAYER, k = ph % PH_PER_LAYER;
#ifdef PROBE_K
        for (int rep = 0; rep < ((k == PROBE_K) ? 2 : 1); ++rep) {
        if (rep) xcd_barrier(bar);
#endif
        if (k == 0) {
#ifndef NO_PREP
            phase_prep(a, l, lds, G);
#endif
        } else if (k == 1 || k == 10) {
            const int second = (k == 10);
            pg8::Gemm g{(const bf16_t*)(ws + WS_XB), (const bf16_t*)(ws + (second ? WS_W2U : WS_W1U)), T, 2 * FF, DM, DM, DM};
            pg8::StaticOrder S; S.init(T, 2 * FF, G, (int)blockIdx.x);
            pg8::EpiFfnUp E{(bf16_t*)(ws + WS_Z), rssb + (size_t)(3 * l + (second ? 2 : 0)) * T};
            pg8::gemm_phase(ldsl, g, S, E);
        } else if (k == 2 || k == 11) {
            const int second = (k == 11);
            pg8::Gemm g{(const bf16_t*)(ws + WS_Z), (const bf16_t*)(ws + (second ? WS_W2D : WS_W1D)), T, DM, FF, FF, FF};
            pg8::StaticOrder S; S.init(T, DM, G, (int)blockIdx.x);
            const float* xin = (l == 0 && !second) ? a.in[I_X] : a.out;
            pg8::EpiResid E{xin, a.out, (bf16_t*)(ws + WS_XB), rssb + (size_t)(3 * l + (second ? 3 : 1)) * T, 0.5f};
            pg8::gemm_phase(ldsl, g, S, E);
        } else if (k == 3) {
            pg8::Gemm g{(const bf16_t*)(ws + WS_XB), (const bf16_t*)(ws + WS_WIN), T, ZW, DM, DM, DM};
            pg8::StaticOrder S; S.init(T, ZW, G, (int)blockIdx.x);
            pg8::EpiWin E{(bf16_t*)(ws + WS_Z), rssb + (size_t)(3 * l + 1) * T};
            pg8::gemm_phase(ldsl, g, S, E);
#ifndef NO_GLR
            phase_glr(a, rssb + (size_t)(3 * l + 1) * T, G);
#endif
        } else if (k == 4) {
#ifndef NO_GLA
            for (int u = blockIdx.x; u < 1024; u += G) gla_kv_unit(a, l, lds, u);
#endif
#ifndef NO_SSM
            for (int u = G - 1 - (int)blockIdx.x; u < 128; u += G) ssm_end_unit(a, u);
#endif
#ifndef NO_POOL
            phase_pool(a, G);
#endif
        } else if (k == 5) {
#ifndef NO_GLA
            gla_scan(a, G);
#endif
#ifndef NO_SSM
            { const int id = (G - 1 - (int)blockIdx.x) * 512 + otid(); if (id < 8192) ssm_scan(a, id); }
#endif
        } else if (k == 6) {
#ifndef NO_GLA
            for (int u = blockIdx.x; u < 1024; u += G) gla_out_unit(a, l, lds, u);
#endif
#ifndef NO_SSM
            for (int u = blockIdx.x; u < 512; u += G) ssm_out_unit(a, u);
#endif
        } else if (k == 7) {
            pg8::Gemm g{(const bf16_t*)(ws + WS_YS), (const bf16_t*)(ws + WS_WGLU), T, 512, 512, 512, 512};
            pg8::StaticOrder S; S.init(T, 512, G, (int)blockIdx.x);
            pg8::EpiGlu E{(const bf16_t*)(ws + WS_YS), (bf16_t*)(ws + WS_Y)};
            pg8::gemm_phase(ldsl, g, S, E);
        } else if (k == 8) {
            const bf16_t* Y = (const bf16_t*)(ws + WS_Y); const bf16_t* Wb = (const bf16_t*)(ws + WS_WBR); const bf16_t* Zg = (const bf16_t*)(ws + WS_Z) + ZC_G;
            pg8::BranchOrder S; S.init(T, DM, G, (int)blockIdx.x);
            pg8::Gemm g{Y, Wb, T, DM, DM, DM, DM}; pg8::EpiBranch E{Zg, (bf16_t*)(ws + WS_MB)};
            pg8::gemm_phase(ldsl, g, S, E);
        } else if (k == 9) {
            pg8::Gemm g{(const bf16_t*)(ws + WS_MB), (const bf16_t*)(ws + WS_WO), T, DM, DM, DM, DM};
            pg8::StaticOrder S; S.init(T, DM, G, (int)blockIdx.x);
            pg8::EpiResid E{a.out, a.out, (bf16_t*)(ws + WS_XB), rssb + (size_t)(3 * l + 2) * T, 1.0f};
            pg8::gemm_phase(ldsl, g, S, E);
        }
#ifdef PROBE_K
        }
#endif
    }
}

extern "C" void kernel_launch(void* const* d_in, const int* in_sizes, int n_in, void* d_out, int out_size, void* d_ws, size_t ws_size, hipStream_t stream) {
    static int grid = 0;
    if (grid == 0) {
        if (n_in != 28 || in_sizes[0] != T * DM || out_size != T * DM || ws_size < WS_END) {
            fprintf(stderr, "kernel_launch: unexpected problem (n_in %d, in0 %d, out %d, ws %zu, need %zu)\n", n_in, n_in > 0 ? in_sizes[0] : -1, out_size, ws_size, (size_t)WS_END);
            grid = -1; return;
        }
        int dev = 0, cus = 0, per_cu = 0;
        hipGetDevice(&dev);
        hipDeviceGetAttribute(&cus, hipDeviceAttributeMultiprocessorCount, dev);
        hipFuncSetAttribute((const void*)mega_fwd, hipFuncAttributeMaxDynamicSharedMemorySize, LDS_BYTES);
        hipOccupancyMaxActiveBlocksPerMultiprocessor(&per_cu, (const void*)mega_fwd, 512, LDS_BYTES);
        if (per_cu < 1) per_cu = 1;
        if (per_cu > 1) per_cu = 1;
        grid = 256;
        if (cus * per_cu < 256) { fprintf(stderr, "kernel_launch: needs 256 co-resident workgroups (have %d x %d)\n", cus, per_cu); grid = -1; return; }
        (void)hipGetLastError();
    }
    if (grid < 0) return;
    Args a{};
    for (int i = 0; i < 28; ++i) a.in[i] = (const float*)d_in[i];
    a.out = (float*)d_out; a.ws = (unsigned char*)d_ws;
    (void)hipMemsetAsync((char*)d_ws + WS_BAR, 0, 16384, stream);
#if MK_MULTI_LAUNCH
    for (int ph = 0; ph < N_PHASES; ++ph) {
        a.ph_lo = ph; a.ph_hi = ph + 1;
        hipLaunchKernelGGL(mega_fwd, dim3(grid), dim3(512), LDS_BYTES, stream, a);
    }
#else
    a.ph_lo = 0; a.ph_hi = N_PHASES;
    void* args[] = {&a};
    hipError_t e = hipLaunchCooperativeKernel((const void*)mega_fwd, dim3(grid), dim3(512), args, LDS_BYTES, stream);
    if (e != hipSuccess) fprintf(stderr, "cooperative launch failed: %s (grid %d)\n", hipGetErrorString(e), grid);
#endif
}
```

```cpp
#include <hip/hip_runtime.h>
#include <hip/hip_cooperative_groups.h>
#include <cstdio>
#include <cstdint>
namespace cg = cooperative_groups;

#ifndef MK_MULTI_LAUNCH
#define MK_MULTI_LAUNCH 0
#endif

#define LAS __attribute__((address_space(3)))
typedef unsigned short bf16_t;
typedef short bf16x8 __attribute__((ext_vector_type(8)));
typedef float f32x4 __attribute__((ext_vector_type(4)));
typedef unsigned u32x4 __attribute__((ext_vector_type(4)));
typedef unsigned u32x2 __attribute__((ext_vector_type(2)));

constexpr int T = 16384, DM = 2048, FF = 5632, SEQ = 4096;
constexpr int ZW = 10240;
constexpr int ZC_POOL = 0, ZC_Q = 512, ZC_K = 1024, ZC_V = 1536, ZC_R = 2560, ZC_S = 3584, ZC_G = 4096;
constexpr int YC_GLA = 512, YC_SSM = 1536;
constexpr int INW = 10256;
constexpr float EPS = 1e-6f;

constexpr size_t MiB = 1u << 20;
constexpr size_t WS_RSS = 0;
constexpr size_t WS_BAR = 917504;
constexpr size_t WS_WGT = 1 * MiB;
constexpr size_t WS_L64 = 1 * MiB + 131072;
constexpr size_t WS_GLR = 2 * MiB;
constexpr size_t WS_DEC = 3 * MiB;
constexpr size_t WS_KT = 4 * MiB;
constexpr size_t WS_E = 5 * MiB;
constexpr size_t WS_HC = 9 * MiB;
constexpr size_t WS_MET = 11 * MiB;
constexpr size_t WS_MCT = 19 * MiB;
constexpr size_t WS_YS = 27 * MiB;
constexpr size_t WS_W1U = 43 * MiB, WS_W1D = 87 * MiB, WS_WIN = 109 * MiB, WS_WBR = 149 * MiB, WS_WO = 157 * MiB, WS_WGLU = 165 * MiB;
constexpr size_t WS_W2U = 166 * MiB, WS_W2D = 210 * MiB;
constexpr size_t WS_XB = 232 * MiB, WS_Y = 296 * MiB, WS_MB = 360 * MiB, WS_KV = 424 * MiB, WS_Z = 488 * MiB, WS_BCG = 808 * MiB, WS_XS = 840 * MiB, WS_END = 856 * MiB;

constexpr int LDS_BYTES = 147456;

typedef __bf16 bf16v2_t __attribute__((ext_vector_type(2)));
typedef float f32v2_t __attribute__((ext_vector_type(2)));
__device__ __forceinline__ unsigned pk2(float lo, float hi) { const f32v2_t v = {lo, hi}; const bf16v2_t b = __builtin_convertvector(v, bf16v2_t); return __builtin_bit_cast(unsigned, b); }
__device__ __forceinline__ unsigned f2bf(float f) { return pk2(f, 0.f) & 0xffffu; }
__device__ __forceinline__ float bf2f(unsigned short b) { return __uint_as_float(((unsigned)b) << 16); }
__device__ __forceinline__ float bflo(unsigned w) { return __uint_as_float(w << 16); }
__device__ __forceinline__ float bfhi(unsigned w) { return __uint_as_float(w & 0xffff0000u); }
__device__ __forceinline__ float wave_sum(float v) {
#pragma unroll
    for (int o = 1; o < 64; o <<= 1) v += __shfl_xor(v, o);
    return v;
}
__device__ __forceinline__ float sigmoid_f(float x) { return __builtin_amdgcn_rcpf(1.f + __expf(-x)); }
__device__ __forceinline__ float gelu_tanh_f(float x) {
    const float u = 0.7978845608028654f * (x + 0.044715f * x * x * x);
    const float t = 1.f - 2.f * __builtin_amdgcn_rcpf(1.f + __expf(2.f * u));
    return 0.5f * x * (1.f + t);
}
#define LDS_WAIT() asm volatile("s_waitcnt lgkmcnt(0)" ::: "memory")
__device__ __forceinline__ int otid() { int t = threadIdx.x; asm volatile("" : "+v"(t)); return t; }
__device__ __forceinline__ f32x4 mfma16(bf16x8 a, bf16x8 b, f32x4 c) { return __builtin_amdgcn_mfma_f32_16x16x32_bf16(a, b, c, 0, 0, 0); }

namespace pg8 {
constexpr int BM = 256, BK = 64, HALF = 128, HTB = HALF * BK * 2, STAGE_BYTES = 8 * HTB, NXCD = 8, WGM = 8;
__host__ __device__ __forceinline__ int lds_byte(int r, int c) { const int st = (r >> 4) * 2 + (c >> 5), rr = r & 15, cc = c & 31, ob = rr * 64 + cc * 2; return st * 1024 + (ob ^ (((ob >> 9) & 1) << 5)); }
__host__ __device__ __forceinline__ void stage_rc(int b, int& R, int& C) { const int st = b / 1024, sb = b % 1024, swz = sb ^ (((sb >> 9) & 1) << 5); R = (st >> 1) * 16 + swz / 64; C = (st & 1) * 32 + (swz % 64) / 2; }
__host__ __device__ __forceinline__ int perm32(int rho) { const int n = rho >> 4, i = rho & 15; return 8 * (i >> 2) + 4 * n + (i & 3); }

struct Unit { int pm, pn, seg; };
struct Gemm { const bf16_t* A; const bf16_t* Bt; int M, N, K, lda, ldb; };

struct StaticOrder {
    static constexpr bool SEGMENTED = false;
    int nM, nN, nwg, G, c;
    __device__ __forceinline__ int koff(const Unit&) const { return 0; }
    __device__ __forceinline__ int nt(const Unit&) const { return 0; }
    __device__ void init(int M, int N, int G_, int c_) { nM = M / BM; nN = N / BM; nwg = nM * nN; G = G_; c = c_; }
    __device__ bool next(int i, Unit& u) const {
        const long L = (long)i * G + c; if (L >= nwg) return false;
        int wgid = (int)L; { const int q = nwg / NXCD, r = nwg % NXCD, xcd = wgid % NXCD, off = wgid / NXCD; wgid = (xcd < r ? xcd * (q + 1) : r * (q + 1) + (xcd - r) * q) + off; }
        const int nig = WGM * nN, gid = wgid / nig, fm = gid * WGM, gsz = (nM - fm) < WGM ? (nM - fm) : WGM;
        u.pm = fm + ((wgid % nig) % gsz); u.pn = (wgid % nig) / gsz; u.seg = 0; return true;
    }
};
struct BranchOrder : StaticOrder {
    static constexpr bool SEGMENTED = true;
    __device__ bool next(int i, Unit& u) const { const bool ok = StaticOrder::next(i / 3, u); u.seg = i % 3; return ok; }
    __device__ __forceinline__ int koff(const Unit& u) const { return u.seg == 0 ? 0 : (u.seg == 1 ? 512 : 1536); }
    __device__ __forceinline__ int nt(const Unit& u) const { return u.seg == 1 ? 16 : 8; }
};

template <class Epi, class Sched>
__device__ __forceinline__ void gemm_phase(LAS unsigned char* lds, const Gemm g, const Sched& S, const Epi& E) {
    const int tid = otid(), wid = __builtin_amdgcn_readfirstlane(tid >> 6), lane = tid & 63, wr = wid >> 2, wc = wid & 3, fr = lane & 15, fq = lane >> 4;
    unsigned voffA[2], voffB[2];
#pragma unroll
    for (int i = 0; i < 2; ++i) { int R, C; stage_rc(tid * 16 + i * 8192, R, C); const int Rb = (R & ~31) + perm32(R & 31);
        voffA[i] = (unsigned)(R * g.lda + C) * 2u; voffB[i] = (unsigned)(Rb * g.ldb + C) * 2u; }
    const size_t kstep = (size_t)(BK * 2);
    const size_t hstepA = (size_t)HALF * g.lda * 2, hstepB = (size_t)HALF * g.ldb * 2;
    const size_t tstepA = 2 * hstepA, tstepB = 2 * hstepB;
    const unsigned ldsw = (unsigned)wid * 1024u;
    const int aoff = lds_byte(wr * 64 + fr, fq * 8), boff = lds_byte(wc * 32 + fr, fq * 8);
#define PG8_SA(b, h) (((b) * 2 + (h)) * HTB)
#define PG8_SB(b, h) ((4 + (b) * 2 + (h)) * HTB)
#define PG8_STAGE(bufoff, gbase, voff) do { _Pragma("unroll") for (int _i = 0; _i < 2; ++_i) \
        __builtin_amdgcn_global_load_lds((const unsigned*)((const char*)(gbase) + (voff)[_i]), (LAS unsigned*)(lds + (bufoff) + ldsw + _i * 8192), 16, 0, 0); } while (0)
#define PG8_LDA(dst, b, h) do { _Pragma("unroll") for (int m = 0; m < 4; ++m) _Pragma("unroll") for (int k = 0; k < 2; ++k) dst[m][k] = *(const LAS bf16x8*)(lds + PG8_SA(b, h) + aoff + m * 2048 + k * 1024); } while (0)
#define PG8_LDB(dst, b, h) do { _Pragma("unroll") for (int n = 0; n < 2; ++n) _Pragma("unroll") for (int k = 0; k < 2; ++k) dst[n][k] = *(const LAS bf16x8*)(lds + PG8_SB(b, h) + boff + n * 2048 + k * 1024); } while (0)
#define PG8_MMA(ai, bj, At, Bt) do { __builtin_amdgcn_s_setprio(1); _Pragma("unroll") for (int m = 0; m < 4; ++m) _Pragma("unroll") for (int n = 0; n < 2; ++n) _Pragma("unroll") for (int k = 0; k < 2; ++k) \
        acc[ai][bj][m][n] = __builtin_amdgcn_mfma_f32_16x16x32_bf16(Bt[n][k], At[m][k], acc[ai][bj][m][n], 0, 0, 0); __builtin_amdgcn_s_setprio(0); } while (0)
#define PG8_WAIT_V(n) asm volatile("s_waitcnt vmcnt(" #n ")" ::: "memory")
#define PG8_WAIT_L(n) asm volatile("s_waitcnt lgkmcnt(" #n ")" ::: "memory")
#define PG8_BAR __builtin_amdgcn_s_barrier()
#define PG8_SCHED __builtin_amdgcn_sched_barrier(0)
    Unit cur, nxt; int ui = 0;
    if (!S.next(0, cur)) return;
    f32x4 acc[2][2][4][2];
#pragma unroll
    for (int a = 0; a < 2; ++a)
#pragma unroll
        for (int b = 0; b < 2; ++b)
#pragma unroll
            for (int m = 0; m < 4; ++m)
#pragma unroll
                for (int n = 0; n < 2; ++n) acc[a][b][m][n] = (f32x4){0.f, 0.f, 0.f, 0.f};
    bf16x8 At[4][2], B0[2][2], B1[2][2];
    int nt = Sched::SEGMENTED ? S.nt(cur) : g.K / BK;
    const char* cA = (const char*)g.A + (size_t)cur.pm * tstepA + (size_t)S.koff(cur) * 2; const char* cB = (const char*)g.Bt + (size_t)cur.pn * tstepB + (size_t)S.koff(cur) * 2;
    PG8_STAGE(PG8_SB(0, 0), cB, voffB); PG8_STAGE(PG8_SB(0, 1), cB + hstepB, voffB); PG8_STAGE(PG8_SA(0, 0), cA, voffA); PG8_STAGE(PG8_SA(0, 1), cA + hstepA, voffA);
    if (wr == 1) PG8_BAR;
    PG8_WAIT_V(2); PG8_BAR;
    PG8_STAGE(PG8_SB(1, 0), cB + kstep, voffB); PG8_STAGE(PG8_SA(1, 0), cA + kstep, voffA); PG8_STAGE(PG8_SB(1, 1), cB + hstepB + kstep, voffB);
    PG8_WAIT_V(6); PG8_BAR;
    for (;;) {
        const bool has_next = S.next(ui + 1, nxt);
        const char* nA = has_next ? (const char*)g.A + (size_t)nxt.pm * tstepA + (size_t)S.koff(nxt) * 2 : cA; const char* nB = has_next ? (const char*)g.Bt + (size_t)nxt.pn * tstepB + (size_t)S.koff(nxt) * 2 : cB;
        for (int t = 0; t < nt; t += 2) {
            const bool last = (t == nt - 2);
            const char* a1 = cA + (size_t)(t + 1) * kstep;
            const char* a2 = last ? nA : cA + (size_t)(t + 2) * kstep; const char* b2 = last ? nB : cB + (size_t)(t + 2) * kstep;
            const char* a3 = a2 + kstep; const char* b3 = b2 + kstep;
            PG8_LDB(B0, 0, 0); PG8_LDB(B1, 0, 1); PG8_SCHED; PG8_LDA(At, 0, 0); PG8_STAGE(PG8_SA(1, 1), a1 + hstepA, voffA);
            PG8_WAIT_V(8); PG8_WAIT_L(0); PG8_BAR; PG8_MMA(0, 0, At, B0); PG8_MMA(0, 1, At, B1); PG8_BAR; PG8_SCHED;
            PG8_LDA(At, 0, 1); PG8_STAGE(PG8_SB(0, 0), b2, voffB); PG8_STAGE(PG8_SB(0, 1), b2 + hstepB, voffB); PG8_STAGE(PG8_SA(0, 0), a2, voffA);
            PG8_WAIT_V(8); PG8_WAIT_L(0); PG8_BAR; PG8_MMA(1, 0, At, B0); PG8_MMA(1, 1, At, B1); PG8_BAR; PG8_SCHED;
            PG8_LDB(B0, 1, 0); PG8_LDB(B1, 1, 1); PG8_SCHED; PG8_LDA(At, 1, 0); PG8_STAGE(PG8_SA(0, 1), a2 + hstepA, voffA);
            PG8_WAIT_V(8); PG8_WAIT_L(0); PG8_BAR; PG8_MMA(0, 0, At, B0); PG8_MMA(0, 1, At, B1); PG8_BAR; PG8_SCHED;
            PG8_LDA(At, 1, 1); PG8_STAGE(PG8_SB(1, 0), b3, voffB); PG8_STAGE(PG8_SB(1, 1), b3 + hstepB, voffB); PG8_STAGE(PG8_SA(1, 0), a3, voffA);
            PG8_WAIT_V(8); PG8_WAIT_L(0); PG8_BAR; PG8_MMA(1, 0, At, B0); PG8_MMA(1, 1, At, B1); PG8_BAR; PG8_SCHED;
        }
        if (wr == 0) PG8_BAR;
        E(acc, cur, wr, wc, fr, fq);
        if (!has_next) break;
#pragma unroll
        for (int a = 0; a < 2; ++a)
#pragma unroll
            for (int b = 0; b < 2; ++b)
#pragma unroll
                for (int m = 0; m < 4; ++m)
#pragma unroll
                    for (int n = 0; n < 2; ++n) acc[a][b][m][n] = (f32x4){0.f, 0.f, 0.f, 0.f};
        cur = nxt; cA = nA; cB = nB; ++ui;
        if (Sched::SEGMENTED) nt = S.nt(cur);
        if (wr == 1) PG8_BAR;
    }
    PG8_WAIT_V(0);
    PG8_BAR;
#undef PG8_SA
#undef PG8_SB
#undef PG8_STAGE
#undef PG8_LDA
#undef PG8_LDB
#undef PG8_MMA
#undef PG8_WAIT_V
#undef PG8_WAIT_L
#undef PG8_BAR
#undef PG8_SCHED
}

typedef const f32x4 (&AccRef)[2][2][4][2];

struct EpiFfnUp {
    bf16_t* H; const unsigned long long* rss;
    __device__ __forceinline__ void operator()(AccRef acc, const Unit& u, int wr, int wc, int fr, int fq) const {
        const int row0 = u.pm * BM + wr * 64 + fr, col0 = u.pn * 128 + wc * 32 + 8 * fq;
#pragma unroll
        for (int ai = 0; ai < 2; ++ai)
#pragma unroll
            for (int m = 0; m < 4; ++m) {
                const int row = row0 + ai * HALF + m * 16;
                const float rinv = rsqrtf((float)rss[row] * (1.f / (16777216.f * DM)) + EPS);
                float h[8];
#pragma unroll
                for (int n = 0; n < 2; ++n)
#pragma unroll
                    for (int j = 0; j < 4; ++j) { const float gg = acc[ai][0][m][n][j] * rinv, uu = acc[ai][1][m][n][j] * rinv; h[n * 4 + j] = gg * uu * sigmoid_f(gg); }
                u32x4 o; o.x = pk2(h[0], h[1]); o.y = pk2(h[2], h[3]); o.z = pk2(h[4], h[5]); o.w = pk2(h[6], h[7]);
                *(u32x4*)(H + (size_t)row * FF + col0) = o;
            }
    }
};
struct EpiWin {
    bf16_t* Z; const unsigned long long* rss; bf16_t* XS;
    __device__ __forceinline__ void operator()(AccRef acc, const Unit& u, int wr, int wc, int fr, int fq) const {
        const int row0 = u.pm * BM + wr * 64 + fr, col0 = u.pn * BM + wc * 32 + 8 * fq;
        const bool sg = u.pn >= 16;
        const bool ssm = (u.pn == 14) | (u.pn == 15);
        const int cs = col0 - ZC_S;
        bf16_t* const dst = ssm ? XS + (size_t)(cs >> 4) * T * 16 + (cs & 15) : Z + col0; const size_t pitch = ssm ? 16 : ZW; const size_t bjstep = ssm ? (size_t)8 * T * 16 : (size_t)HALF;
#pragma unroll
        for (int ai = 0; ai < 2; ++ai)
#pragma unroll
            for (int m = 0; m < 4; ++m) {
                const int row = row0 + ai * HALF + m * 16;
                const float rinv = rsqrtf((float)rss[row] * (1.f / (16777216.f * DM)) + EPS);
#pragma unroll
                for (int bj = 0; bj < 2; ++bj) {
                    float h[8];
#pragma unroll
                    for (int n = 0; n < 2; ++n)
#pragma unroll
                        for (int j = 0; j < 4; ++j) { const float v = acc[ai][bj][m][n][j] * rinv; h[n * 4 + j] = sg ? sigmoid_f(v) : v; }
                    u32x4 o; o.x = pk2(h[0], h[1]); o.y = pk2(h[2], h[3]); o.z = pk2(h[4], h[5]); o.w = pk2(h[6], h[7]);
                    *(u32x4*)(dst + (size_t)row * pitch + bj * bjstep) = o;
                }
            }
    }
};
struct EpiResid {
    const float* xin; float* xout; bf16_t* XB; unsigned long long* rssn; float scale;
    __device__ __forceinline__ void operator()(AccRef acc, const Unit& u, int wr, int wc, int fr, int fq) const {
        const int row0 = u.pm * BM + wr * 64 + fr, col0 = u.pn * BM + wc * 32 + 8 * fq;
#pragma unroll
        for (int ai = 0; ai < 2; ++ai)
#pragma unroll
            for (int m = 0; m < 4; ++m) {
                const int row = row0 + ai * HALF + m * 16;
                float ss = 0.f;
#pragma unroll
                for (int bj = 0; bj < 2; ++bj) {
                    const size_t off = (size_t)row * DM + col0 + bj * HALF;
                    f32x4 x0 = *(const f32x4*)(xin + off), x1 = *(const f32x4*)(xin + off + 4);
                    x0 = x0 + acc[ai][bj][m][0] * scale; x1 = x1 + acc[ai][bj][m][1] * scale;
                    *(f32x4*)(xout + off) = x0; *(f32x4*)(xout + off + 4) = x1;
                    u32x4 o; o.x = pk2(x0[0], x0[1]); o.y = pk2(x0[2], x0[3]); o.z = pk2(x1[0], x1[1]); o.w = pk2(x1[2], x1[3]);
                    *(u32x4*)(XB + off) = o;
                    ss += x0[0] * x0[0] + x0[1] * x0[1] + x0[2] * x0[2] + x0[3] * x0[3] + x1[0] * x1[0] + x1[1] * x1[1] + x1[2] * x1[2] + x1[3] * x1[3];
                }
                ss += __shfl_xor(ss, 16); ss += __shfl_xor(ss, 32);
                if (fq == 0) atomicAdd(rssn + row, (unsigned long long)(ss * 16777216.f));
            }
    }
};
struct EpiBranch {
    const bf16_t* G0; bf16_t* MB;
    __device__ __forceinline__ void operator()(AccRef acc, const Unit& u, int wr, int wc, int fr, int fq) const {
        const int row0 = u.pm * BM + wr * 64 + fr, col0 = u.pn * BM + wc * 32 + 8 * fq;
        const bf16_t* G = G0 + u.seg * 2048; const bool accum = u.seg > 0;
#pragma unroll
        for (int ai = 0; ai < 2; ++ai)
#pragma unroll
            for (int m = 0; m < 4; ++m) {
                const int row = row0 + ai * HALF + m * 16;
#pragma unroll
                for (int bj = 0; bj < 2; ++bj) {
                    const int col = col0 + bj * HALF;
                    const u32x4 gv = *(const u32x4*)(G + (size_t)row * ZW + col);
                    u32x4 pv = (u32x4){0u, 0u, 0u, 0u};
                    if (accum) pv = *(const u32x4*)(MB + (size_t)row * DM + col);
                    const f32x4 a0 = acc[ai][bj][m][0], a1 = acc[ai][bj][m][1];
                    u32x4 o;
                    o.x = pk2(bflo(pv.x) + bflo(gv.x) * a0[0], bfhi(pv.x) + bfhi(gv.x) * a0[1]);
                    o.y = pk2(bflo(pv.y) + bflo(gv.y) * a0[2], bfhi(pv.y) + bfhi(gv.y) * a0[3]);
                    o.z = pk2(bflo(pv.z) + bflo(gv.z) * a1[0], bfhi(pv.z) + bfhi(gv.z) * a1[1]);
                    o.w = pk2(bflo(pv.w) + bflo(gv.w) * a1[2], bfhi(pv.w) + bfhi(gv.w) * a1[3]);
                    *(u32x4*)(MB + (size_t)row * DM + col) = o;
                }
            }
    }
};
struct EpiGlu {
    const bf16_t* YS; bf16_t* Y;
    __device__ __forceinline__ void operator()(AccRef acc, const Unit& u, int wr, int wc, int fr, int fq) const {
        const int row0 = u.pm * BM + wr * 64 + fr, col0 = u.pn * BM + wc * 32 + 8 * fq;
#pragma unroll
        for (int ai = 0; ai < 2; ++ai)
#pragma unroll
            for (int m = 0; m < 4; ++m) {
                const int row = row0 + ai * HALF + m * 16;
#pragma unroll
                for (int bj = 0; bj < 2; ++bj) {
                    const int col = col0 + bj * HALF;
                    const u32x4 yv = *(const u32x4*)(YS + (size_t)row * 512 + col);
                    const f32x4 a0 = acc[ai][bj][m][0], a1 = acc[ai][bj][m][1];
                    u32x4 o;
                    o.x = pk2(bflo(yv.x) * sigmoid_f(a0[0]), bfhi(yv.x) * sigmoid_f(a0[1]));
                    o.y = pk2(bflo(yv.y) * sigmoid_f(a0[2]), bfhi(yv.y) * sigmoid_f(a0[3]));
                    o.z = pk2(bflo(yv.z) * sigmoid_f(a1[0]), bfhi(yv.z) * sigmoid_f(a1[1]));
                    o.w = pk2(bflo(yv.w) * sigmoid_f(a1[2]), bfhi(yv.w) * sigmoid_f(a1[3]));
                    *(u32x4*)(Y + (size_t)row * DM + YC_SSM + col) = o;
                }
            }
    }
};
}

struct Args { const float* in[28]; float* out; unsigned char* ws; int ph_lo, ph_hi; };
enum { I_X = 0, I_F1N, I_F1G, I_F1U, I_F1D, I_MIXN, I_WIN, I_POOLW, I_POOLS, I_GW2, I_GB, I_GNORM, I_ARE, I_AIM, I_LDT, I_BRE, I_BIM, I_CRE, I_CIM,
       I_SD, I_WGLU, I_WBR, I_WOUT, I_F2N, I_F2G, I_F2U, I_F2D, I_FINN };

__device__ __forceinline__ void tr_item(const float* W, int ldw, int col0, const float* ksc, bf16_t* WT, int ldt, int drow, int k0, int n0, unsigned* scr, int lane) {
    const int a = lane & 15, b = lane >> 4;
    const float* src = W + (size_t)(k0 + 2 * b) * ldw + col0 + n0 + a * 4;
    f32x4 v[16];
#pragma unroll
    for (int m = 0; m < 8; ++m) { v[2 * m] = *(const f32x4*)(src + (size_t)(8 * m) * ldw); v[2 * m + 1] = *(const f32x4*)(src + (size_t)(8 * m + 1) * ldw); }
#pragma unroll
    for (int m = 0; m < 8; ++m) {
        const float s0 = ksc ? ksc[k0 + 8 * m + 2 * b] : 1.f, s1 = ksc ? ksc[k0 + 8 * m + 2 * b + 1] : 1.f;
#pragma unroll
        for (int e = 0; e < 4; ++e) scr[(4 * a + e) * 32 + (((m ^ (a & 7)) << 2) | b)] = pk2(v[2 * m][e] * s0, v[2 * m + 1][e] * s1);
    }
    LDS_WAIT();
#pragma unroll
    for (int j = 0; j < 8; ++j) { const int n = (lane >> 3) + 8 * j, c = lane & 7;
        const u32x4 o = *(const u32x4*)(scr + n * 32 + ((c ^ ((n >> 2) & 7)) << 2));
        *(u32x4*)(WT + (size_t)(drow + n) * ldt + k0 + c * 8) = o; }
    LDS_WAIT();
}
__device__ __forceinline__ bool tr_try(int& r, const float* W, int ldw, int K, int N, int col0, const float* ksc, bf16_t* WT, int ldt, int drow0, int mode, unsigned* scr, int lane) {
    const int nblk = N / 64, items = (K / 64) * nblk;
    if (r >= items) { r -= items; return false; }
    const int kb = r / nblk, n0 = (r % nblk) * 64;
    const int drow = drow0 + (mode ? ((n0 >> 7) * 256 + (n0 & 127)) : n0);
    tr_item(W, ldw, col0, ksc, WT, ldt, drow, kb * 64, n0, scr, lane);
    return true;
}

__device__ __forceinline__ void cpow_d(double th, double la, int j, double& pr, double& pi) {
    const double y = th * (double)j;
    const double kq = __builtin_rint(y * 0.63661977236758134308);
    double r = __builtin_fma(-kq, 1.57079632679489655800, y); r = __builtin_fma(-kq, 6.12323399573676603587e-17, r);
    const double r2 = r * r;
    double s = 1.0 - r2 * (1.0 / 272.0); s = 1.0 - r2 * (1.0 / 210.0) * s; s = 1.0 - r2 * (1.0 / 156.0) * s; s = 1.0 - r2 * (1.0 / 110.0) * s; s = 1.0 - r2 * (1.0 / 72.0) * s; s = 1.0 - r2 * (1.0 / 42.0) * s; s = 1.0 - r2 * (1.0 / 20.0) * s; s = 1.0 - r2 * (1.0 / 6.0) * s; s *= r;
    double c = 1.0 - r2 * (1.0 / 240.0); c = 1.0 - r2 * (1.0 / 182.0) * c; c = 1.0 - r2 * (1.0 / 132.0) * c; c = 1.0 - r2 * (1.0 / 90.0) * c; c = 1.0 - r2 * (1.0 / 56.0) * c; c = 1.0 - r2 * (1.0 / 30.0) * c; c = 1.0 - r2 * (1.0 / 12.0) * c; c = 1.0 - r2 * (1.0 / 2.0) * c;
    const int q = ((int)kq) & 3;
    double sn = s, cs = c;
    if (q == 1) { sn = c; cs = -s; } else if (q == 2) { sn = -s; cs = -c; } else if (q == 3) { sn = -c; cs = s; }
    const double x = la * (double)j * (1.0 * (1.0 / 64.0));
    double e = 1.0 + x * (1.0 / 10.0); e = 1.0 + x * (1.0 / 9.0) * e; e = 1.0 + x * (1.0 / 8.0) * e; e = 1.0 + x * (1.0 / 7.0) * e; e = 1.0 + x * (1.0 / 6.0) * e; e = 1.0 + x * (1.0 / 5.0) * e; e = 1.0 + x * (1.0 / 4.0) * e; e = 1.0 + x * (1.0 / 3.0) * e; e = 1.0 + x * (1.0 / 2.0) * e; e = 1.0 + x * e;
#pragma unroll
    for (int i = 0; i < 6; ++i) e = e * e;
    pr = e * cs; pi = e * sn;
}

__device__ __forceinline__ void phase_prep(const Args& a, int l, unsigned char* lds, int G) {
    const int tid = otid(), lane = tid & 63, wave = tid >> 6;
    unsigned char* ws = a.ws;
    const int gw = blockIdx.x * 8 + wave, NGW = G * 8;
    unsigned* scr = (unsigned*)(lds + wave * 16384);
    const float* f1n = a.in[I_F1N] + (size_t)l * DM; const float* f2n = a.in[I_F2N] + (size_t)l * DM; const float* mxn = a.in[I_MIXN] + (size_t)l * DM;
    const float* f1g = a.in[I_F1G] + (size_t)l * DM * FF; const float* f1u = a.in[I_F1U] + (size_t)l * DM * FF; const float* f1d = a.in[I_F1D] + (size_t)l * FF * DM;
    const float* f2g = a.in[I_F2G] + (size_t)l * DM * FF; const float* f2u = a.in[I_F2U] + (size_t)l * DM * FF; const float* f2d = a.in[I_F2D] + (size_t)l * FF * DM;
    const float* win = a.in[I_WIN] + (size_t)l * DM * INW; const float* wbr = a.in[I_WBR] + (size_t)l * DM * DM; const float* wout = a.in[I_WOUT] + (size_t)l * DM * DM;
    const float* wglu = a.in[I_WGLU] + (size_t)l * 512 * 512;
    constexpr int IT_FU = (DM / 64) * (FF / 64), IT_FD = (FF / 64) * (DM / 64), IT_WA = (DM / 64) * (3584 / 64), IT_WB = (DM / 64) * (6656 / 64),
                  IT_BR = (1536 / 64) * (DM / 64), IT_WO = (DM / 64) * (DM / 64), IT_GL = (512 / 64) * (512 / 64);
    constexpr int IT_TOTAL = 4 * IT_FU + 2 * IT_FD + IT_WA + IT_WB + IT_BR + IT_WO + IT_GL;
    for (int it = gw; it < IT_TOTAL; it += NGW) {
        int r = it;
        if (tr_try(r, f1g, FF, DM, FF, 0, f1n, (bf16_t*)(ws + WS_W1U), DM, 0, 1, scr, lane)) continue;
        if (tr_try(r, f1u, FF, DM, FF, 0, f1n, (bf16_t*)(ws + WS_W1U), DM, 128, 1, scr, lane)) continue;
        if (tr_try(r, f2g, FF, DM, FF, 0, f2n, (bf16_t*)(ws + WS_W2U), DM, 0, 1, scr, lane)) continue;
        if (tr_try(r, f2u, FF, DM, FF, 0, f2n, (bf16_t*)(ws + WS_W2U), DM, 128, 1, scr, lane)) continue;
        if (tr_try(r, f1d, DM, FF, DM, 0, nullptr, (bf16_t*)(ws + WS_W1D), FF, 0, 0, scr, lane)) continue;
        if (tr_try(r, f2d, DM, FF, DM, 0, nullptr, (bf16_t*)(ws + WS_W2D), FF, 0, 0, scr, lane)) continue;
        if (tr_try(r, win, INW, DM, 3584, 0, mxn, (bf16_t*)(ws + WS_WIN), DM, 0, 0, scr, lane)) continue;
        if (tr_try(r, win, INW, DM, 6656, 3600, mxn, (bf16_t*)(ws + WS_WIN), DM, 3584, 0, scr, lane)) continue;
        if (tr_try(r, wbr + (size_t)512 * DM, DM, 1536, DM, 0, nullptr, (bf16_t*)(ws + WS_WBR) + 512, DM, 0, 0, scr, lane)) continue;
        if (tr_try(r, wout, DM, DM, DM, 0, nullptr, (bf16_t*)(ws + WS_WO), DM, 0, 0, scr, lane)) continue;
        tr_try(r, wglu, 512, 512, 512, 0, nullptr, (bf16_t*)(ws + WS_WGLU), 512, 0, 0, scr, lane);
    }
    {
        const float* pw = a.in[I_POOLW] + (size_t)l * 4 * 128 * 128; const float* ps = a.in[I_POOLS] + (size_t)l * 512;
        bf16_t* WbT = (bf16_t*)(ws + WS_WBR);
        const int n0 = blockIdx.x * 8, k = tid, g = k >> 7;
        const float* pr = pw + (size_t)k * 128;
        float s[8];
#pragma unroll
        for (int i = 0; i < 8; ++i) s[i] = 0.f;
#pragma unroll 4
        for (int d = 0; d < 128; ++d) {
            const float pv = pr[d] * ps[g * 128 + d];
            const f32x4 w0 = *(const f32x4*)(wbr + (size_t)(g * 128 + d) * DM + n0), w1 = *(const f32x4*)(wbr + (size_t)(g * 128 + d) * DM + n0 + 4);
            s[0] += pv * w0[0]; s[1] += pv * w0[1]; s[2] += pv * w0[2]; s[3] += pv * w0[3]; s[4] += pv * w1[0]; s[5] += pv * w1[1]; s[6] += pv * w1[2]; s[7] += pv * w1[3];
        }
#pragma unroll
        for (int i = 0; i < 8; ++i) WbT[(size_t)(n0 + i) * DM + k] = (bf16_t)f2bf(s[i]);
    }
    {
        bf16_t* WGT = (bf16_t*)(ws + WS_WGT);
        for (int i = blockIdx.x * 512 + tid; i < 16 * DM; i += G * 512) { const int j = i >> 11, k = i & 2047; WGT[i] = (bf16_t)f2bf(mxn[k] * win[(size_t)k * INW + 3584 + j]); }
    }
    {
        const float* are = a.in[I_ARE] + (size_t)l * 32 * 64; const float* aim = a.in[I_AIM] + (size_t)l * 32 * 64; const float* ldt = a.in[I_LDT] + (size_t)l * 32;
        const float* bre = a.in[I_BRE] + (size_t)l * 32 * 64 * 16; const float* bim = a.in[I_BIM] + (size_t)l * 32 * 64 * 16;
        const float* cre = a.in[I_CRE] + (size_t)l * 32 * 16 * 64; const float* cim = a.in[I_CIM] + (size_t)l * 32 * 16 * 64;
        const float* sd = a.in[I_SD] + (size_t)l * 512;
        bf16_t* KT = (bf16_t*)(ws + WS_KT); bf16_t* MET = (bf16_t*)(ws + WS_MET); bf16_t* MCT = (bf16_t*)(ws + WS_MCT); float* L64 = (float*)(ws + WS_L64);
        float* s_cr = (float*)lds;
        float* s_ci = s_cr + 1024;
        float* s_bbr = s_ci + 1024;
        float* s_bbi = s_bbr + 1024;
        float* s_pw = s_bbi + 1024;
        float* s_f = s_pw + 1024;
        __syncthreads();
        for (int it = blockIdx.x; it < 32 * 9; it += G) {
            const int g = it / 9, jb = it % 9;
            {
                const int p = tid & 63, jj = tid >> 6, j = jb * 8 + jj;
                const double dt = (double)expf(ldt[g]);
                const double ar = (double)are[g * 64 + p], ai = (double)aim[g * 64 + p];
                if (j <= 64) { double pr, pi; cpow_d(dt * ai, dt * ar, j, pr, pi); s_pw[(jj * 64 + p) * 2] = (float)pr; s_pw[(jj * 64 + p) * 2 + 1] = (float)pi;
                    if (j == 64) { L64[(g * 64 + p) * 2] = (float)pr; L64[(g * 64 + p) * 2 + 1] = (float)pi; } }
                if (tid < 64) {
                    double l1r, l1i; cpow_d(dt * ai, dt * ar, 1, l1r, l1i);
                    const double den = ar * ar + ai * ai;
                    s_f[2 * p] = (float)(((l1r - 1.0) * ar + l1i * ai) / den); s_f[2 * p + 1] = (float)((l1i * ar - (l1r - 1.0) * ai) / den);
                }
#pragma unroll
                for (int i = 0; i < 2; ++i) { const int idx = tid + i * 512; s_cr[idx] = cre[(size_t)g * 1024 + idx]; s_ci[idx] = cim[(size_t)g * 1024 + idx]; }
            }
            __syncthreads();
#pragma unroll
            for (int i = 0; i < 2; ++i) { const int idx = tid + i * 512, p = idx >> 4; const float fr = s_f[2 * p], fi = s_f[2 * p + 1];
                const float br = bre[(size_t)g * 1024 + idx], bi = bim[(size_t)g * 1024 + idx];
                s_bbr[idx] = fr * br - fi * bi; s_bbi[idx] = fr * bi + fi * br; }
            __syncthreads();
#pragma unroll 1
            for (int i = 0; i < 4; ++i) {
                const int o = tid + i * 512, jj = o >> 8, h = (o >> 4) & 15, hp = o & 15, j = jb * 8 + jj;
                if (j < 64) {
                    float sacc = 0.f;
#pragma unroll 8
                    for (int p = 0; p < 64; ++p) { const float cr = s_cr[h * 64 + p], ci = s_ci[h * 64 + p], pr = s_pw[(jj * 64 + p) * 2], pi = s_pw[(jj * 64 + p) * 2 + 1];
                        sacc += (cr * pr - ci * pi) * s_bbr[p * 16 + hp] - (cr * pi + ci * pr) * s_bbi[p * 16 + hp]; }
                    if (j == 0 && h == hp) sacc += sd[g * 16 + h];
                    KT[((size_t)(g * 64 + j) * 16 + h) * 16 + hp] = (bf16_t)f2bf(sacc);
                }
            }
#pragma unroll 4
            for (int i = 0; i < 16; ++i) {
                const int o = tid + i * 512, jj = o >> 10, j = jb * 8 + jj;
                if (j < 64) { const int p = (o >> 4) & 63, hp = o & 15; const float pr = s_pw[(jj * 64 + p) * 2], pi = s_pw[(jj * 64 + p) * 2 + 1], br = s_bbr[p * 16 + hp], bi = s_bbi[p * 16 + hp];
                    const int jp = 63 - j;
                    MET[((size_t)(g * 128 + p) * 64 + jp) * 16 + hp] = (bf16_t)f2bf(pr * br - pi * bi);
                    MET[((size_t)(g * 128 + 64 + p) * 64 + jp) * 16 + hp] = (bf16_t)f2bf(pr * bi + pi * br); }
                if (j >= 1 && j <= 64) { const int h = (o >> 6) & 15, p = o & 63; const float cr = s_cr[h * 64 + p], ci = s_ci[h * 64 + p], pr = s_pw[(jj * 64 + p) * 2], pi = s_pw[(jj * 64 + p) * 2 + 1];
                    const size_t base = ((size_t)g * 1024 + (j - 1) * 16 + h) * 128;
                    MCT[base + p] = (bf16_t)f2bf(cr * pr - ci * pi); MCT[base + 64 + p] = (bf16_t)f2bf(-(cr * pi + ci * pr)); }
            }
            __syncthreads();
        }
    }
    if (l == 0) {
        const float* x = a.in[I_X]; bf16_t* XB = (bf16_t*)(ws + WS_XB); unsigned long long* rss = (unsigned long long*)(ws + WS_RSS);
        for (int row = gw; row < T; row += NGW) {
            const f32x4* xr = (const f32x4*)(x + (size_t)row * DM) + lane; u32x2* o = (u32x2*)(XB + (size_t)row * DM) + lane;
            float ss = 0.f;
#pragma unroll
            for (int i = 0; i < 8; ++i) { const f32x4 v = xr[64 * i]; ss += v[0] * v[0] + v[1] * v[1] + v[2] * v[2] + v[3] * v[3]; u32x2 w; w.x = pk2(v[0], v[1]); w.y = pk2(v[2], v[3]); o[64 * i] = w; }
            ss = wave_sum(ss);
            if (lane == 0) rss[row] = (unsigned long long)(ss * 16777216.f);
        }
        for (int i = blockIdx.x * 512 + tid; i < 6 * T; i += G * 512) rss[T + i] = 0ull;
    }
}

__device__ __forceinline__ void phase_glr(const Args& a, const unsigned long long* rss, int G) {
    const int tid = otid(), lane = tid & 63, wave = tid >> 6, r16 = lane & 15, quad = lane >> 4;
    const int gw = blockIdx.x * 8 + wave, NGW = G * 8;
    const bf16_t* XB = (const bf16_t*)(a.ws + WS_XB); const bf16_t* WGT = (const bf16_t*)(a.ws + WS_WGT); float* GLR = (float*)(a.ws + WS_GLR);
    for (int task = gw; task < T / 16; task += NGW) {
        const int r0 = task * 16;
        f32x4 acc = (f32x4){0.f, 0.f, 0.f, 0.f};
        const bf16_t* ap = XB + (size_t)(r0 + r16) * DM + quad * 8; const bf16_t* bp = WGT + (size_t)r16 * DM + quad * 8;
#pragma unroll 8
        for (int kb = 0; kb < 64; ++kb) acc = mfma16(*(const bf16x8*)(ap + kb * 32), *(const bf16x8*)(bp + kb * 32), acc);
#pragma unroll
        for (int i = 0; i < 4; ++i) { const int row = r0 + quad * 4 + i; GLR[(size_t)row * 16 + r16] = acc[i] * rsqrtf((float)rss[row] * (1.f / (16777216.f * DM)) + EPS); }
    }
}

template <int W>
__device__ __forceinline__ void pool_group(const bf16_t* Z, bf16_t* Y, int c00, int G) {
    for (int idx = blockIdx.x * 512 + otid(); idx < T * 16; idx += G * 512) {
        const int t = idx >> 4, c0 = c00 + (idx & 15) * 8, s = t & (SEQ - 1);
        const int cnt = (s + 1) < W ? (s + 1) : W;
        u32x4 v[W];
#pragma unroll
        for (int j = 0; j < W; ++j) { const int tj = (j < cnt) ? (t - j) : t; v[j] = *(const u32x4*)(Z + (size_t)tj * ZW + ZC_POOL + c0); }
        float sum[8];
#pragma unroll
        for (int i = 0; i < 8; ++i) sum[i] = 0.f;
#pragma unroll
        for (int j = 0; j < W; ++j) { const float m = (j < cnt) ? 1.f : 0.f;
            sum[0] += m * bflo(v[j].x); sum[1] += m * bfhi(v[j].x); sum[2] += m * bflo(v[j].y); sum[3] += m * bfhi(v[j].y);
            sum[4] += m * bflo(v[j].z); sum[5] += m * bfhi(v[j].z); sum[6] += m * bflo(v[j].w); sum[7] += m * bfhi(v[j].w); }
        const float inv = 1.f / (float)cnt;
        u32x4 o; o.x = pk2(sum[0] * inv - bflo(v[0].x), sum[1] * inv - bfhi(v[0].x)); o.y = pk2(sum[2] * inv - bflo(v[0].y), sum[3] * inv - bfhi(v[0].y));
        o.z = pk2(sum[4] * inv - bflo(v[0].z), sum[5] * inv - bfhi(v[0].z)); o.w = pk2(sum[6] * inv - bflo(v[0].w), sum[7] * inv - bfhi(v[0].w));
        *(u32x4*)(Y + (size_t)t * DM + c0) = o;
    }
}
__device__ __forceinline__ void phase_pool(const Args& a, int G) {
    const bf16_t* Z = (const bf16_t*)(a.ws + WS_Z); bf16_t* Y = (bf16_t*)(a.ws + WS_Y);
    pool_group<2>(Z, Y, 0, G); pool_group<4>(Z, Y, 128, G); pool_group<8>(Z, Y, 256, G); pool_group<16>(Z, Y, 384, G);
}

constexpr int OFF_BC = 0, OFF_QP = 32768, OFF_KP = 50176, OFF_OB = 0, OFF_QD = 67584, OFF_VT = 84992, OFF_PB = 121856, OFF_GL = 131072, OFF_TOT = 135168;
constexpr int PQ = 136, PV = 72, POB = 260;

__device__ __forceinline__ void gla_bc(const Args& a, int l, unsigned char* lds, int t0, int h) {
    const int tid = otid(), d = tid & 127, jq = tid >> 7;
    float* BC = (float*)(lds + OFF_BC); float* GL = (float*)(lds + OFF_GL); float* TOT = (float*)(lds + OFF_TOT);
    const float* GLR = (const float*)(a.ws + WS_GLR);
    const float* w2 = a.in[I_GW2] + (size_t)l * 16 * 512; const float* gb = a.in[I_GB] + (size_t)l * 512;
    for (int i = tid; i < 1024; i += 512) GL[i] = GLR[(size_t)t0 * 16 + i];
    float w[16];
#pragma unroll
    for (int r = 0; r < 16; ++r) w[r] = w2[r * 512 + h * 128 + d];
    const float bias = gb[h * 128 + d];
    __syncthreads();
    float run = 0.f;
#pragma unroll 4
    for (int jj = 0; jj < 16; ++jj) {
        const int j = jq * 16 + jj;
        float z = bias;
#pragma unroll
        for (int r = 0; r < 16; ++r) z += GL[j * 16 + r] * w[r];
        const float la = (fminf(z, 0.f) - __logf(1.f + __expf(-fabsf(z)))) * (1.f / 16.f);
        run += la; BC[j * 128 + d] = run;
    }
    TOT[jq * 128 + d] = run;
    __syncthreads();
    float off = 0.f;
    for (int q = 0; q < jq; ++q) off += TOT[q * 128 + d];
    if (jq > 0) {
#pragma unroll 4
        for (int jj = 0; jj < 16; ++jj) BC[(jq * 16 + jj) * 128 + d] += off;
    }
    __syncthreads();
}

__device__ __forceinline__ int tsw(int x, int j) { return x * PV + ((((j >> 3) ^ ((x >> 3) & 7)) << 3) | (j & 7)); }
__device__ __forceinline__ int tsc(int x, int c) { return x * PV + ((c ^ ((x >> 3) & 7)) << 3); }
__device__ __forceinline__ float bfe(const u32x4& v, int e) { const unsigned w = (e < 2) ? v.x : (e < 4) ? v.y : (e < 6) ? v.z : v.w; return (e & 1) ? bfhi(w) : bflo(w); }
__device__ __forceinline__ unsigned short bfr(const u32x4& v, int e) { const unsigned w = (e < 2) ? v.x : (e < 4) ? v.y : (e < 6) ? v.z : v.w; return (unsigned short)((e & 1) ? (w >> 16) : (w & 0xffffu)); }

__device__ __forceinline__ void gla_kv_unit(const Args& a, int l, unsigned char* lds, int unit) {
    const int tid = otid(), lane = tid & 63, wave = tid >> 6, r16 = lane & 15, quad = lane >> 4;
    const int bh = unit >> 6, n = unit & 63, b = bh >> 2, h = bh & 3, t0 = b * SEQ + n * 64;
    const bf16_t* Z = (const bf16_t*)(a.ws + WS_Z); bf16_t* KV = (bf16_t*)(a.ws + WS_KV); float* DEC = (float*)(a.ws + WS_DEC);
    u32x4 kreg[2], vreg[4];
#pragma unroll
    for (int i = 0; i < 2; ++i) { const int p = tid + 512 * i; kreg[i] = *(const u32x4*)(Z + (size_t)(t0 + (p >> 4)) * ZW + ZC_K + h * 128 + (p & 15) * 8); }
#pragma unroll
    for (int i = 0; i < 4; ++i) { const int p = tid + 512 * i; vreg[i] = *(const u32x4*)(Z + (size_t)(t0 + (p >> 5)) * ZW + ZC_V + h * 256 + (p & 31) * 8); }
    gla_bc(a, l, lds, t0, h);
    const float* BC = (const float*)(lds + OFF_BC); bf16_t* KTl = (bf16_t*)(lds + OFF_QP); bf16_t* VT = (bf16_t*)(lds + OFF_VT);
    {
        float* BCG = (float*)(a.ws + WS_BCG);
#pragma unroll
        for (int i = 0; i < 4; ++i) { const int p = tid + 512 * i, j = p >> 5, d0 = (p & 31) * 4; *(f32x4*)(BCG + (size_t)(t0 + j) * 512 + h * 128 + d0) = *(const f32x4*)(BC + j * 128 + d0); }
    }
#pragma unroll
    for (int i = 0; i < 2; ++i) {
        const int p = tid + 512 * i, j = p >> 4, d0 = (p & 15) * 8;
        const f32x4 bl0 = *(const f32x4*)(BC + 63 * 128 + d0), bl1 = *(const f32x4*)(BC + 63 * 128 + d0 + 4);
        const f32x4 bc0 = *(const f32x4*)(BC + j * 128 + d0), bc1 = *(const f32x4*)(BC + j * 128 + d0 + 4);
#pragma unroll
        for (int e = 0; e < 8; ++e) { const float bl = e < 4 ? bl0[e & 3] : bl1[e & 3], bc = e < 4 ? bc0[e & 3] : bc1[e & 3];
            KTl[tsw(d0 + e, j)] = (bf16_t)f2bf(bfe(kreg[i], e) * __expf(bl - bc)); }
    }
    if (tid < 128) DEC[(size_t)unit * 128 + tid] = __expf(BC[63 * 128 + tid]);
#pragma unroll
    for (int i = 0; i < 4; ++i) {
        const int p = tid + 512 * i, j = p >> 5, v0 = (p & 31) * 8;
#pragma unroll
        for (int e = 0; e < 8; ++e) VT[tsw(v0 + e, j)] = bfr(vreg[i], e);
    }
    __syncthreads();
    f32x4 acc[8][2];
#pragma unroll
    for (int i = 0; i < 8; ++i) { acc[i][0] = (f32x4){0.f, 0.f, 0.f, 0.f}; acc[i][1] = (f32x4){0.f, 0.f, 0.f, 0.f}; }
#pragma unroll
    for (int kb = 0; kb < 2; ++kb) {
        bf16x8 bf[2];
#pragma unroll
        for (int v2 = 0; v2 < 2; ++v2) bf[v2] = *(const bf16x8*)(VT + tsc((wave * 2 + v2) * 16 + r16, kb * 4 + quad));
#pragma unroll
        for (int db = 0; db < 8; ++db) { const bf16x8 af = *(const bf16x8*)(KTl + tsc(db * 16 + r16, kb * 4 + quad));
            acc[db][0] = mfma16(af, bf[0], acc[db][0]); acc[db][1] = mfma16(af, bf[1], acc[db][1]); }
    }
#pragma unroll
    for (int db = 0; db < 8; ++db)
#pragma unroll
        for (int v2 = 0; v2 < 2; ++v2) { const int v = (wave * 2 + v2) * 16 + r16; u32x2 o; o.x = pk2(acc[db][v2][0], acc[db][v2][1]); o.y = pk2(acc[db][v2][2], acc[db][v2][3]);
            *(u32x2*)(KV + ((size_t)unit * 256 + v) * 128 + db * 16 + quad * 4) = o; }
    __syncthreads();
}

__device__ __forceinline__ void gla_scan(const Args& a, int G) {
    bf16_t* KV = (bf16_t*)(a.ws + WS_KV); const float* DEC = (const float*)(a.ws + WS_DEC);
    for (int id = blockIdx.x * 512 + otid(); id < 16 * 256 * 32; id += G * 512) {
        const int bh = id >> 13, v = (id >> 5) & 255, d0 = (id & 31) * 4;
        float s0 = 0.f, s1 = 0.f, s2 = 0.f, s3 = 0.f;
#pragma unroll 8
        for (int n = 0; n < 64; ++n) {
            const int unit = bh * 64 + n;
            u32x2* p = (u32x2*)(KV + ((size_t)unit * 256 + v) * 128 + d0);
            const u32x2 kv = *p; const f32x4 dc = *(const f32x4*)(DEC + (size_t)unit * 128 + d0);
            u32x2 o; o.x = pk2(s0, s1); o.y = pk2(s2, s3); *p = o;
            s0 = dc[0] * s0 + bflo(kv.x); s1 = dc[1] * s1 + bfhi(kv.x); s2 = dc[2] * s2 + bflo(kv.y); s3 = dc[3] * s3 + bfhi(kv.y);
        }
    }
}

__device__ __forceinline__ void gla_out_unit(const Args& a, int l, unsigned char* lds, int unit) {
    const int tid = otid(), lane = tid & 63, wave = tid >> 6, r16 = lane & 15, quad = lane >> 4;
    const int bh = unit >> 6, n = unit & 63, b = bh >> 2, h = bh & 3, t0 = b * SEQ + n * 64;
    const bf16_t* Z = (const bf16_t*)(a.ws + WS_Z); const bf16_t* KV = (const bf16_t*)(a.ws + WS_KV); bf16_t* Y = (bf16_t*)(a.ws + WS_Y);
    u32x4 qreg[2], kreg[2], vreg[4];
#pragma unroll
    for (int i = 0; i < 2; ++i) { const int p = tid + 512 * i; const bf16_t* rp = Z + (size_t)(t0 + (p >> 4)) * ZW + h * 128 + (p & 15) * 8;
        qreg[i] = *(const u32x4*)(rp + ZC_Q); kreg[i] = *(const u32x4*)(rp + ZC_K); }
#pragma unroll
    for (int i = 0; i < 4; ++i) { const int p = tid + 512 * i; vreg[i] = *(const u32x4*)(Z + (size_t)(t0 + (p >> 5)) * ZW + ZC_V + h * 256 + (p & 31) * 8); }
    const float* BCG = (const float*)(a.ws + WS_BCG);
    f32x4 bcr[2][2], bmr[2][2];
#pragma unroll
    for (int i = 0; i < 2; ++i) { const int p = tid + 512 * i, j = p >> 4, d0 = (p & 15) * 8;
        bcr[i][0] = *(const f32x4*)(BCG + (size_t)(t0 + j) * 512 + h * 128 + d0); bcr[i][1] = *(const f32x4*)(BCG + (size_t)(t0 + j) * 512 + h * 128 + d0 + 4);
        bmr[i][0] = *(const f32x4*)(BCG + (size_t)(t0 + 31) * 512 + h * 128 + d0); bmr[i][1] = *(const f32x4*)(BCG + (size_t)(t0 + 31) * 512 + h * 128 + d0 + 4); }
    bf16_t* QP = (bf16_t*)(lds + OFF_QP); bf16_t* KP = (bf16_t*)(lds + OFF_KP); bf16_t* QD = (bf16_t*)(lds + OFF_QD); bf16_t* VT = (bf16_t*)(lds + OFF_VT); bf16_t* PB = (bf16_t*)(lds + OFF_PB);
    float* OB = (float*)(lds + OFF_OB);
#pragma unroll
    for (int i = 0; i < 2; ++i) {
        const int p = tid + 512 * i, j = p >> 4, d0 = (p & 15) * 8;
        const f32x4 bm0 = bmr[i][0], bm1 = bmr[i][1];
        const f32x4 bc0 = bcr[i][0], bc1 = bcr[i][1];
        float qp[8], kp[8], qd[8];
#pragma unroll
        for (int e = 0; e < 8; ++e) { const float bm = e < 4 ? bm0[e & 3] : bm1[e & 3], bc = e < 4 ? bc0[e & 3] : bc1[e & 3];
            const float qv = bfe(qreg[i], e) * 0.08838834764831845f, kv = bfe(kreg[i], e);
            qp[e] = qv * __expf(bc - bm); kp[e] = kv * __expf(bm - bc); qd[e] = qv * __expf(bc); }
        u32x4 o; o.x = pk2(qp[0], qp[1]); o.y = pk2(qp[2], qp[3]); o.z = pk2(qp[4], qp[5]); o.w = pk2(qp[6], qp[7]); *(u32x4*)(QP + j * PQ + d0) = o;
        o.x = pk2(kp[0], kp[1]); o.y = pk2(kp[2], kp[3]); o.z = pk2(kp[4], kp[5]); o.w = pk2(kp[6], kp[7]); *(u32x4*)(KP + j * PQ + d0) = o;
        o.x = pk2(qd[0], qd[1]); o.y = pk2(qd[2], qd[3]); o.z = pk2(qd[4], qd[5]); o.w = pk2(qd[6], qd[7]); *(u32x4*)(QD + j * PQ + d0) = o;
    }
#pragma unroll
    for (int i = 0; i < 4; ++i) {
        const int p = tid + 512 * i, j = p >> 5, v0 = (p & 31) * 8;
#pragma unroll
        for (int e = 0; e < 8; ++e) VT[tsw(v0 + e, j)] = bfr(vreg[i], e);
    }
    bf16x8 bfk[4][2];
#pragma unroll
    for (int kb = 0; kb < 4; ++kb)
#pragma unroll
        for (int v2 = 0; v2 < 2; ++v2) bfk[kb][v2] = *(const bf16x8*)(KV + ((size_t)unit * 256 + (wave * 2 + v2) * 16 + r16) * 128 + kb * 32 + quad * 8);
    u32x2 rv8[8];
#pragma unroll
    for (int rr = 0; rr < 8; ++rr) rv8[rr] = *(const u32x2*)(Z + (size_t)(t0 + wave * 8 + rr) * ZW + ZC_R + h * 256 + lane * 4);
    __syncthreads();
    {
        const int ib = wave >> 1;
#pragma unroll
        for (int jbi = 0; jbi < 2; ++jbi) {
            const int jb = (wave & 1) * 2 + jbi;
            f32x4 sc = (f32x4){0.f, 0.f, 0.f, 0.f};
            if (jb <= ib) {
#pragma unroll
                for (int kb = 0; kb < 4; ++kb) sc = mfma16(*(const bf16x8*)(QP + (ib * 16 + r16) * PQ + kb * 32 + quad * 8), *(const bf16x8*)(KP + (jb * 16 + r16) * PQ + kb * 32 + quad * 8), sc);
            }
#pragma unroll
            for (int i = 0; i < 4; ++i) { const int row = ib * 16 + quad * 4 + i, col = jb * 16 + r16; PB[row * PV + col] = (bf16_t)f2bf(col <= row ? sc[i] : 0.f); }
        }
    }
    __syncthreads();
    f32x4 acc[4][2];
#pragma unroll
    for (int i = 0; i < 4; ++i) { acc[i][0] = (f32x4){0.f, 0.f, 0.f, 0.f}; acc[i][1] = (f32x4){0.f, 0.f, 0.f, 0.f}; }
#pragma unroll
    for (int kb = 0; kb < 2; ++kb) {
        bf16x8 bf[2];
#pragma unroll
        for (int v2 = 0; v2 < 2; ++v2) bf[v2] = *(const bf16x8*)(VT + tsc((wave * 2 + v2) * 16 + r16, kb * 4 + quad));
#pragma unroll
        for (int ib = 0; ib < 4; ++ib) { const bf16x8 af = *(const bf16x8*)(PB + (ib * 16 + r16) * PV + kb * 32 + quad * 8);
            acc[ib][0] = mfma16(af, bf[0], acc[ib][0]); acc[ib][1] = mfma16(af, bf[1], acc[ib][1]); }
    }
#pragma unroll
    for (int kb = 0; kb < 4; ++kb) {
#pragma unroll
        for (int ib = 0; ib < 4; ++ib) { const bf16x8 af = *(const bf16x8*)(QD + (ib * 16 + r16) * PQ + kb * 32 + quad * 8);
            acc[ib][0] = mfma16(af, bfk[kb][0], acc[ib][0]); acc[ib][1] = mfma16(af, bfk[kb][1], acc[ib][1]); }
    }
#pragma unroll
    for (int ib = 0; ib < 4; ++ib)
#pragma unroll
        for (int v2 = 0; v2 < 2; ++v2)
#pragma unroll
            for (int i = 0; i < 4; ++i) OB[(ib * 16 + quad * 4 + i) * POB + (wave * 2 + v2) * 16 + r16] = acc[ib][v2][i];
    __syncthreads();
    {
        const float* gn = a.in[I_GNORM] + (size_t)l * 1024 + h * 256 + lane * 4;
        const f32x4 gain = *(const f32x4*)gn;
#pragma unroll
        for (int rr = 0; rr < 8; ++rr) {
            const int i = wave * 8 + rr;
            const f32x4 v = *(const f32x4*)(OB + i * POB + lane * 4);
            const float ss = wave_sum(v[0] * v[0] + v[1] * v[1] + v[2] * v[2] + v[3] * v[3]);
            const float rinv = rsqrtf(ss * (1.f / 256.f) + EPS);
            const u32x2 rv = rv8[rr];
            const float r0 = bflo(rv.x), r1 = bfhi(rv.x), r2 = bflo(rv.y), r3 = bfhi(rv.y);
            u32x2 o; o.x = pk2(v[0] * rinv * gain[0] * r0 * sigmoid_f(r0), v[1] * rinv * gain[1] * r1 * sigmoid_f(r1));
            o.y = pk2(v[2] * rinv * gain[2] * r2 * sigmoid_f(r2), v[3] * rinv * gain[3] * r3 * sigmoid_f(r3));
            *(u32x2*)(Y + (size_t)(t0 + i) * DM + YC_GLA + h * 256 + lane * 4) = o;
        }
    }
    __syncthreads();
}

__device__ __forceinline__ void ssm_end_unit(const Args& a, int unit) {
    const int tid = otid(), lane = tid & 63, wave = tid >> 6, r16 = lane & 15, quad = lane >> 4;
    const int g = unit >> 2, rb = unit & 3;
    const bf16_t* XS = (const bf16_t*)(a.ws + WS_XS); const bf16_t* MET = (const bf16_t*)(a.ws + WS_MET); float* E = (float*)(a.ws + WS_E);
    const int crow = rb * 64 + (wave & 3) * 16, qg = (wave >> 2) * 64;
    const int ch = (quad & 1) * 8, jo = quad >> 1;
    f32x4 acc[4];
#pragma unroll
    for (int i = 0; i < 4; ++i) acc[i] = (f32x4){0.f, 0.f, 0.f, 0.f};
    const bf16_t* ap = XS + ((size_t)g * T + (crow + r16) * 64 + jo) * 16 + ch;
    const bf16_t* bp = MET + ((size_t)(g * 128 + qg + r16) * 64 + jo) * 16 + ch;
#pragma unroll 4
    for (int kb = 0; kb < 32; ++kb) {
        const bf16x8 af = *(const bf16x8*)(ap + (size_t)kb * 2 * 16);
#pragma unroll
        for (int nb = 0; nb < 4; ++nb) acc[nb] = mfma16(af, *(const bf16x8*)(bp + (size_t)nb * 16 * 1024 + kb * 32), acc[nb]);
    }
#pragma unroll
    for (int nb = 0; nb < 4; ++nb)
#pragma unroll
        for (int i = 0; i < 4; ++i) E[((size_t)(crow + quad * 4 + i) * 32 + g) * 128 + qg + nb * 16 + r16] = acc[nb][i];
}
__device__ __forceinline__ void ssm_scan(const Args& a, int id) {
    const int b = id >> 11, g = (id >> 6) & 31, p = id & 63;
    const float* E = (const float*)(a.ws + WS_E); bf16_t* HC = (bf16_t*)(a.ws + WS_HC); const float* L64 = (const float*)(a.ws + WS_L64);
    const float lr = L64[(g * 64 + p) * 2], li = L64[(g * 64 + p) * 2 + 1];
    float hr = 0.f, hi = 0.f;
#pragma unroll 8
    for (int n = 0; n < 64; ++n) {
        const size_t base = ((size_t)(b * 64 + n) * 32 + g) * 128;
        HC[base + p] = (bf16_t)f2bf(hr); HC[base + 64 + p] = (bf16_t)f2bf(hi);
        const float er = E[base + p], ei = E[base + 64 + p];
        const float nr = lr * hr - li * hi + er, ni = lr * hi + li * hr + ei;
        hr = nr; hi = ni;
    }
}
__device__ __forceinline__ void ssm_out_unit(const Args& a, int unit) {
    const int tid = otid(), lane = tid & 63, wave = tid >> 6, r16 = lane & 15, quad = lane >> 4;
    const int g = unit >> 4, cb = unit & 15;
    const bf16_t* XS = (const bf16_t*)(a.ws + WS_XS); const bf16_t* KT = (const bf16_t*)(a.ws + WS_KT); const bf16_t* MCT = (const bf16_t*)(a.ws + WS_MCT);
    const bf16_t* HC = (const bf16_t*)(a.ws + WS_HC); bf16_t* YS = (bf16_t*)(a.ws + WS_YS);
    const int ch = (quad & 1) * 8, jo = quad >> 1;
    f32x4 acc[2][4];
#pragma unroll
    for (int i = 0; i < 2; ++i)
#pragma unroll
        for (int k = 0; k < 4; ++k) acc[i][k] = (f32x4){0.f, 0.f, 0.f, 0.f};
    const int kbn = cb * 2 + 2;
    const bf16x8 zero8 = (bf16x8){0, 0, 0, 0, 0, 0, 0, 0};
    for (int kb0 = 0; kb0 < kbn; kb0 += 4) {
        bf16x8 af[4][2], bf[4][4];
#pragma unroll
        for (int u = 0; u < 4; ++u) {
            const int kb = kb0 + u, jp = kb * 2 + jo; const bool on = kb < kbn;
#pragma unroll
            for (int rk = 0; rk < 2; ++rk) af[u][rk] = on ? *(const bf16x8*)(XS + ((size_t)g * T + (wave * 32 + rk * 16 + r16) * 64 + jp) * 16 + ch) : zero8;
#pragma unroll
            for (int nb = 0; nb < 4; ++nb) { const int dl = cb * 4 + nb - jp; bf[u][nb] = (on && dl >= 0) ? *(const bf16x8*)(KT + ((size_t)(g * 64 + dl) * 16 + r16) * 16 + ch) : zero8; }
        }
#pragma unroll
        for (int u = 0; u < 4; ++u)
#pragma unroll
            for (int nb = 0; nb < 4; ++nb) { acc[0][nb] = mfma16(af[u][0], bf[u][nb], acc[0][nb]); acc[1][nb] = mfma16(af[u][1], bf[u][nb], acc[1][nb]); }
    }
#pragma unroll
    for (int kb = 0; kb < 4; ++kb) {
        bf16x8 af[2];
#pragma unroll
        for (int rk = 0; rk < 2; ++rk) af[rk] = *(const bf16x8*)(HC + ((size_t)(wave * 32 + rk * 16 + r16) * 32 + g) * 128 + kb * 32 + quad * 8);
#pragma unroll
        for (int nb = 0; nb < 4; ++nb) { const bf16x8 bf = *(const bf16x8*)(MCT + ((size_t)g * 1024 + (cb * 4 + nb) * 16 + r16) * 128 + kb * 32 + quad * 8);
            acc[0][nb] = mfma16(af[0], bf, acc[0][nb]); acc[1][nb] = mfma16(af[1], bf, acc[1][nb]); }
    }
#pragma unroll
    for (int rk = 0; rk < 2; ++rk)
#pragma unroll
        for (int nb = 0; nb < 4; ++nb)
#pragma unroll
            for (int i = 0; i < 4; ++i) { const int chunk = wave * 32 + rk * 16 + quad * 4 + i, t = chunk * 64 + cb * 4 + nb;
                YS[(size_t)t * 512 + g * 16 + r16] = (bf16_t)f2bf(gelu_tanh_f(acc[rk][nb][i])); }
}

__device__ __forceinline__ void phase_final(const Args& a, int G) {
    const int tid = otid(), lane = tid & 63, wave = tid >> 6;
    const int gw = blockIdx.x * 8 + wave, NGW = G * 8;
    const unsigned long long* rss = (const unsigned long long*)(a.ws + WS_RSS) + (size_t)6 * T; const float* gf = a.in[I_FINN];
    for (int row = gw; row < T; row += NGW) {
        const float rinv = rsqrtf((float)rss[row] * (1.f / (16777216.f * DM)) + EPS);
        f32x4* xr = (f32x4*)(a.out + (size_t)row * DM) + lane; const f32x4* gr = (const f32x4*)gf + lane;
#pragma unroll
        for (int i = 0; i < 8; ++i) { f32x4 v = xr[64 * i]; const f32x4 gg = gr[64 * i]; v = v * rinv * gg; xr[64 * i] = v; }
    }
}


#define XB_TMO      128
#define XB_XCNT(j)  (256  + 64 * (j))
#define XB_XSUB(j)  (1280 + 64 * (j))
#define XB_XGEN(j)  (2304 + 64 * (j))
#define XB_TOP      3328
#define XB_TOPGEN   3392
#define XCD_BAR_WORDS 3456
#define XB_SPIN_CAP (1u << 18)
__device__ __forceinline__ unsigned xb_ld(unsigned* p)              { return __hip_atomic_load(p, __ATOMIC_RELAXED, __HIP_MEMORY_SCOPE_AGENT); }
__device__ __forceinline__ unsigned xb_add(unsigned* p, unsigned v) { return __hip_atomic_fetch_add(p, v, __ATOMIC_RELAXED, __HIP_MEMORY_SCOPE_AGENT); }
__device__ __forceinline__ unsigned xb_xcc_id() { return (unsigned)__builtin_amdgcn_s_getreg((3 << 11) | 20) & 0xFu; }
#define XB_SPIN(cond, bar) do { unsigned _sp = 0; while (cond) { __builtin_amdgcn_s_sleep(1); \
    if ((++_sp & 255u) == 0u) { if (xb_ld(&(bar)[XB_TMO])) break; if (_sp > XB_SPIN_CAP) { atomicAdd(&(bar)[XB_TMO], 1u); break; } } } } while (0)
struct XcdBarrier { unsigned* bar; unsigned x; volatile LAS unsigned* st; };
__device__ __forceinline__ XcdBarrier xcd_barrier_post(unsigned* bar, volatile LAS unsigned* st) {
    XcdBarrier b; b.bar = bar; b.x = xb_xcc_id(); b.st = st;
    if (threadIdx.x == 0) (void)xb_add(&bar[XB_XCNT(b.x)], 1u);
    return b;
}
__device__ __forceinline__ void xcd_barrier_complete(unsigned* bar, unsigned x, unsigned& nloc, unsigned& nx) {
    const unsigned G = gridDim.x * gridDim.y * gridDim.z;
    unsigned sum, cnt, mine, sp = 0u;
    for (;;) {
        sum = 0u; cnt = 0u; mine = 0u;
#pragma unroll
        for (unsigned j = 0; j < 16; ++j) { const unsigned c = xb_ld(&bar[XB_XCNT(j)]); sum += c; cnt += (c > 0u) ? 1u : 0u; mine = (j == x) ? c : mine; }
        if (sum == G) break;
        __builtin_amdgcn_s_sleep(1);
        if ((++sp & 255u) == 0u) { if (xb_ld(&bar[XB_TMO])) break; if (sp > XB_SPIN_CAP) { atomicAdd(&bar[XB_TMO], 1u); break; } }
    }
    nloc = mine > 0u ? mine : 1u; nx = cnt > 0u ? cnt : 1u;
}
__device__ __forceinline__ void xcd_barrier(const XcdBarrier& b) {
    asm volatile("s_waitcnt vmcnt(0)" ::: "memory");
    __syncthreads();
    if (threadIdx.x == 0) {
        unsigned* bar = b.bar;
        __builtin_amdgcn_s_waitcnt(0);
        unsigned nloc = b.st[0], nx = b.st[1];
        if (nloc == 0u) { xcd_barrier_complete(bar, b.x, nloc, nx); b.st[0] = nloc; b.st[1] = nx; }
        const unsigned old = xb_add(&bar[XB_XSUB(b.x)], 1u);
        const unsigned gen = old / nloc;
        if (old + 1u == (gen + 1u) * nloc) {
            __builtin_amdgcn_fence(__ATOMIC_RELEASE, "agent");
            asm volatile("s_waitcnt vmcnt(0)" ::: "memory");
            const unsigned og = xb_add(&bar[XB_TOP], 1u);
            const unsigned tg = og / nx;
            if (og + 1u == (tg + 1u) * nx) xb_add(&bar[XB_TOPGEN], 1u);
            else XB_SPIN(xb_ld(&bar[XB_TOPGEN]) == tg, bar);
            __builtin_amdgcn_fence(__ATOMIC_ACQUIRE, "agent");
            xb_add(&bar[XB_XGEN(b.x)], 1u);
            asm volatile("s_waitcnt vmcnt(0)" ::: "memory");
        } else {
            XB_SPIN(xb_ld(&bar[XB_XGEN(b.x)]) == gen, bar);
            __builtin_amdgcn_fence(__ATOMIC_ACQUIRE, "agent");
            asm volatile("s_waitcnt vmcnt(0)" ::: "memory");
        }
    }
    __syncthreads();
}

constexpr int PH_PER_LAYER = 12, N_PHASES = 2 * PH_PER_LAYER + 1;

__global__ void __launch_bounds__(512, 2) mega_fwd(Args a) {
    extern __shared__ __attribute__((aligned(16))) unsigned char lds[];
    cg::grid_group grid = cg::this_grid();
    constexpr int G = 256;
    unsigned char* ws = a.ws;
    LAS unsigned char* ldsl = (LAS unsigned char*)lds;
    unsigned long long* rssb = (unsigned long long*)(ws + WS_RSS);
    volatile LAS unsigned* bst = (volatile LAS unsigned*)(ldsl + (LDS_BYTES - 64));
    if (threadIdx.x < 2) bst[threadIdx.x] = 0u;
    __syncthreads();
    XcdBarrier bar = xcd_barrier_post((unsigned*)(ws + WS_BAR), bst);
#if !MK_MULTI_LAUNCH
    if (a.ph_hi - a.ph_lo > 1) grid.sync();
#endif
    for (int ph = a.ph_lo; ph < a.ph_hi; ++ph) {
        if (ph != a.ph_lo) {
            xcd_barrier(bar);
#ifdef PROBE_SYNC
            for (int q = 0; q < 4; ++q) xcd_barrier(bar);
#endif
        }
        if (ph == N_PHASES - 1) { phase_final(a, G); continue; }
        const int l = ph / PH_PER_LAYER, k = ph % PH_PER_LAYER;
#ifdef PROBE_K
        for (int rep = 0; rep < ((k == PROBE_K) ? 2 : 1); ++rep) {
        if (rep) xcd_barrier(bar);
#endif
        if (k == 0) {
#ifndef NO_PREP
            phase_prep(a, l, lds, G);
#endif
        } else if (k == 1 || k == 10) {
            const int second = (k == 10);
            pg8::Gemm g{(const bf16_t*)(ws + WS_XB), (const bf16_t*)(ws + (second ? WS_W2U : WS_W1U)), T, 2 * FF, DM, DM, DM};
            pg8::StaticOrder S; S.init(T, 2 * FF, G, (int)blockIdx.x);
            pg8::EpiFfnUp E{(bf16_t*)(ws + WS_Z), rssb + (size_t)(3 * l + (second ? 2 : 0)) * T};
            pg8::gemm_phase(ldsl, g, S, E);
        } else if (k == 2 || k == 11) {
            const int second = (k == 11);
            pg8::Gemm g{(const bf16_t*)(ws + WS_Z), (const bf16_t*)(ws + (second ? WS_W2D : WS_W1D)), T, DM, FF, FF, FF};
            pg8::StaticOrder S; S.init(T, DM, G, (int)blockIdx.x);
            const float* xin = (l == 0 && !second) ? a.in[I_X] : a.out;
            pg8::EpiResid E{xin, a.out, (bf16_t*)(ws + WS_XB), rssb + (size_t)(3 * l + (second ? 3 : 1)) * T, 0.5f};
            pg8::gemm_phase(ldsl, g, S, E);
        } else if (k == 3) {
            pg8::Gemm g{(const bf16_t*)(ws + WS_XB), (const bf16_t*)(ws + WS_WIN), T, ZW, DM, DM, DM};
            pg8::StaticOrder S; S.init(T, ZW, G, (int)blockIdx.x);
            pg8::EpiWin E{(bf16_t*)(ws + WS_Z), rssb + (size_t)(3 * l + 1) * T, (bf16_t*)(ws + WS_XS)};
            pg8::gemm_phase(ldsl, g, S, E);
#ifndef NO_GLR
            phase_glr(a, rssb + (size_t)(3 * l + 1) * T, G);
#endif
        } else if (k == 4) {
#ifndef NO_GLA
            for (int u = blockIdx.x; u < 1024; u += G) gla_kv_unit(a, l, lds, u);
#ifdef PROBE_GLA1
            for (int u = blockIdx.x; u < 1024; u += G) gla_kv_unit(a, l, lds, u);
#endif
#endif
#ifndef NO_SSM
            for (int u = G - 1 - (int)blockIdx.x; u < 128; u += G) ssm_end_unit(a, u);
#endif
#ifndef NO_POOL
            phase_pool(a, G);
#endif
        } else if (k == 5) {
#ifndef NO_GLA
            gla_scan(a, G);
#endif
#ifndef NO_SSM
            { const int id = (G - 1 - (int)blockIdx.x) * 512 + otid(); if (id < 8192) ssm_scan(a, id); }
#endif
        } else if (k == 6) {
#ifndef NO_GLA
            for (int u = blockIdx.x; u < 1024; u += G) gla_out_unit(a, l, lds, u);
#ifdef PROBE_GLA3
            for (int u = blockIdx.x; u < 1024; u += G) gla_out_unit(a, l, lds, u);
#endif
#endif
#ifndef NO_SSM
            for (int u = blockIdx.x; u < 512; u += G) ssm_out_unit(a, u);
#ifdef PROBE_SSM3
            for (int u = blockIdx.x; u < 512; u += G) ssm_out_unit(a, u);
#endif
#endif
        } else if (k == 7) {
            pg8::Gemm g{(const bf16_t*)(ws + WS_YS), (const bf16_t*)(ws + WS_WGLU), T, 512, 512, 512, 512};
            pg8::StaticOrder S; S.init(T, 512, G, (int)blockIdx.x);
            pg8::EpiGlu E{(const bf16_t*)(ws + WS_YS), (bf16_t*)(ws + WS_Y)};
            pg8::gemm_phase(ldsl, g, S, E);
        } else if (k == 8) {
            const bf16_t* Y = (const bf16_t*)(ws + WS_Y); const bf16_t* Wb = (const bf16_t*)(ws + WS_WBR); const bf16_t* Zg = (const bf16_t*)(ws + WS_Z) + ZC_G;
            pg8::BranchOrder S; S.init(T, DM, G, (int)blockIdx.x);
            pg8::Gemm g{Y, Wb, T, DM, DM, DM, DM}; pg8::EpiBranch E{Zg, (bf16_t*)(ws + WS_MB)};
            pg8::gemm_phase(ldsl, g, S, E);
        } else if (k == 9) {
            pg8::Gemm g{(const bf16_t*)(ws + WS_MB), (const bf16_t*)(ws + WS_WO), T, DM, DM, DM, DM};
            pg8::StaticOrder S; S.init(T, DM, G, (int)blockIdx.x);
            pg8::EpiResid E{a.out, a.out, (bf16_t*)(ws + WS_XB), rssb + (size_t)(3 * l + 2) * T, 1.0f};
            pg8::gemm_phase(ldsl, g, S, E);
        }
#ifdef PROBE_K
        }
#endif
    }
}

extern "C" void kernel_launch(void* const* d_in, const int* in_sizes, int n_in, void* d_out, int out_size, void* d_ws, size_t ws_size, hipStream_t stream) {
    static int grid = 0;
    if (grid == 0) {
        if (n_in != 28 || in_sizes[0] != T * DM || out_size != T * DM || ws_size < WS_END) {
            fprintf(stderr, "kernel_launch: unexpected problem (n_in %d, in0 %d, out %d, ws %zu, need %zu)\n", n_in, n_in > 0 ? in_sizes[0] : -1, out_size, ws_size, (size_t)WS_END);
            grid = -1; return;
        }
        int dev = 0, cus = 0, per_cu = 0;
        hipGetDevice(&dev);
        hipDeviceGetAttribute(&cus, hipDeviceAttributeMultiprocessorCount, dev);
        hipFuncSetAttribute((const void*)mega_fwd, hipFuncAttributeMaxDynamicSharedMemorySize, LDS_BYTES);
        hipOccupancyMaxActiveBlocksPerMultiprocessor(&per_cu, (const void*)mega_fwd, 512, LDS_BYTES);
        if (per_cu < 1) per_cu = 1;
        if (per_cu > 1) per_cu = 1;
        grid = 256;
        if (cus * per_cu < 256) { fprintf(stderr, "kernel_launch: needs 256 co-resident workgroups (have %d x %d)\n", cus, per_cu); grid = -1; return; }
        (void)hipGetLastError();
    }
    if (grid < 0) return;
    Args a{};
    for (int i = 0; i < 28; ++i) a.in[i] = (const float*)d_in[i];
    a.out = (float*)d_out; a.ws = (unsigned char*)d_ws;
    (void)hipMemsetAsync((char*)d_ws + WS_BAR, 0, 16384, stream);
#if MK_MULTI_LAUNCH
    for (int ph = 0; ph < N_PHASES; ++ph) {
        a.ph_lo = ph; a.ph_hi = ph + 1;
        hipLaunchKernelGGL(mega_fwd, dim3(grid), dim3(512), LDS_BYTES, stream, a);
    }
#else
    a.ph_lo = 0; a.ph_hi = N_PHASES;
    void* args[] = {&a};
    hipError_t e = hipLaunchCooperativeKernel((const void*)mega_fwd, dim3(grid), dim3(512), args, LDS_BYTES, stream);
    if (e != hipSuccess) fprintf(stderr, "cooperative launch failed: %s (grid %d)\n", hipGetErrorString(e), grid);
#endif
}
```

```cpp
#include <hip/hip_runtime.h>
#include <hip/hip_cooperative_groups.h>
#include <cstdio>
#include <cstdint>
namespace cg = cooperative_groups;

#ifndef MK_MULTI_LAUNCH
#define MK_MULTI_LAUNCH 0
#endif

#define LAS __attribute__((address_space(3)))
typedef unsigned short bf16_t;
typedef short bf16x8 __attribute__((ext_vector_type(8)));
typedef float f32x4 __attribute__((ext_vector_type(4)));
typedef unsigned u32x4 __attribute__((ext_vector_type(4)));
typedef unsigned u32x2 __attribute__((ext_vector_type(2)));

constexpr int T = 16384, DM = 2048, FF = 5632, SEQ = 4096;
constexpr int ZW = 10240;
constexpr int ZC_POOL = 0, ZC_Q = 512, ZC_K = 1024, ZC_V = 1536, ZC_R = 2560, ZC_S = 3584, ZC_G = 4096;
constexpr int YC_GLA = 512, YC_SSM = 1536;
constexpr int INW = 10256;
constexpr float EPS = 1e-6f;

constexpr size_t MiB = 1u << 20;
constexpr size_t WS_RSS = 0;
constexpr size_t WS_BAR = 917504;
constexpr size_t WS_WGT = 1 * MiB;
constexpr size_t WS_L64 = 1 * MiB + 131072;
constexpr size_t WS_GLR = 2 * MiB;
constexpr size_t WS_DEC = 3 * MiB;
constexpr size_t WS_KT = 4 * MiB;
constexpr size_t WS_E = 5 * MiB;
constexpr size_t WS_HC = 9 * MiB;
constexpr size_t WS_MET = 11 * MiB;
constexpr size_t WS_MCT = 19 * MiB;
constexpr size_t WS_YS = 27 * MiB;
constexpr size_t WS_W1U = 43 * MiB, WS_W1D = 87 * MiB, WS_WIN = 109 * MiB, WS_WBR = 149 * MiB, WS_WO = 157 * MiB, WS_WGLU = 165 * MiB;
constexpr size_t WS_W2U = 166 * MiB, WS_W2D = 210 * MiB;
constexpr size_t WS_XB = 232 * MiB, WS_Y = 296 * MiB, WS_MB = 360 * MiB, WS_KV = 424 * MiB, WS_Z = 488 * MiB, WS_BCG = 808 * MiB, WS_XS = 840 * MiB, WS_END = 856 * MiB;

constexpr int LDS_BYTES = 147456;

typedef __bf16 bf16v2_t __attribute__((ext_vector_type(2)));
typedef float f32v2_t __attribute__((ext_vector_type(2)));
__device__ __forceinline__ unsigned pk2(float lo, float hi) { const f32v2_t v = {lo, hi}; const bf16v2_t b = __builtin_convertvector(v, bf16v2_t); return __builtin_bit_cast(unsigned, b); }
__device__ __forceinline__ unsigned f2bf(float f) { return pk2(f, 0.f) & 0xffffu; }
__device__ __forceinline__ float bf2f(unsigned short b) { return __uint_as_float(((unsigned)b) << 16); }
__device__ __forceinline__ float bflo(unsigned w) { return __uint_as_float(w << 16); }
__device__ __forceinline__ float bfhi(unsigned w) { return __uint_as_float(w & 0xffff0000u); }
__device__ __forceinline__ float wave_sum(float v) {
#pragma unroll
    for (int o = 1; o < 64; o <<= 1) v += __shfl_xor(v, o);
    return v;
}
__device__ __forceinline__ float sigmoid_f(float x) { return __builtin_amdgcn_rcpf(1.f + __expf(-x)); }
__device__ __forceinline__ float gelu_tanh_f(float x) {
    const float u = 0.7978845608028654f * (x + 0.044715f * x * x * x);
    const float t = 1.f - 2.f * __builtin_amdgcn_rcpf(1.f + __expf(2.f * u));
    return 0.5f * x * (1.f + t);
}
#define LDS_WAIT() asm volatile("s_waitcnt lgkmcnt(0)" ::: "memory")
__device__ __forceinline__ int otid() { int t = threadIdx.x; asm volatile("" : "+v"(t)); return t; }
__device__ __forceinline__ f32x4 mfma16(bf16x8 a, bf16x8 b, f32x4 c) { return __builtin_amdgcn_mfma_f32_16x16x32_bf16(a, b, c, 0, 0, 0); }

#ifndef PG8_AUX
#define PG8_AUX 0
#endif
#ifndef PG8_WGM
#define PG8_WGM 4
#endif
namespace pg8 {
constexpr int BM = 256, BK = 64, HALF = 128, HTB = HALF * BK * 2, STAGE_BYTES = 8 * HTB, NXCD = 8, WGM = PG8_WGM;
__host__ __device__ __forceinline__ int lds_byte(int r, int c) { const int st = (r >> 4) * 2 + (c >> 5), rr = r & 15, cc = c & 31, ob = rr * 64 + cc * 2; return st * 1024 + (ob ^ (((ob >> 9) & 1) << 5)); }
__host__ __device__ __forceinline__ void stage_rc(int b, int& R, int& C) { const int st = b / 1024, sb = b % 1024, swz = sb ^ (((sb >> 9) & 1) << 5); R = (st >> 1) * 16 + swz / 64; C = (st & 1) * 32 + (swz % 64) / 2; }
__host__ __device__ __forceinline__ int perm32(int rho) { const int n = rho >> 4, i = rho & 15; return 8 * (i >> 2) + 4 * n + (i & 3); }

struct Unit { int pm, pn, seg; };
struct Gemm { const bf16_t* A; const bf16_t* Bt; int M, N, K, lda, ldb; };

struct StaticOrder {
    static constexpr bool SEGMENTED = false;
    int nM, nN, nwg, G, c;
    __device__ __forceinline__ int koff(const Unit&) const { return 0; }
    __device__ __forceinline__ int nt(const Unit&) const { return 0; }
    __device__ void init(int M, int N, int G_, int c_) { nM = M / BM; nN = N / BM; nwg = nM * nN; G = G_; c = c_; }
    __device__ bool next(int i, Unit& u) const {
        const long L = (long)i * G + c; if (L >= nwg) return false;
        int wgid = (int)L; { const int q = nwg / NXCD, r = nwg % NXCD, xcd = wgid % NXCD, off = wgid / NXCD; wgid = (xcd < r ? xcd * (q + 1) : r * (q + 1) + (xcd - r) * q) + off; }
        const int nig = WGM * nN, gid = wgid / nig, fm = gid * WGM, gsz = (nM - fm) < WGM ? (nM - fm) : WGM;
        u.pm = fm + ((wgid % nig) % gsz); u.pn = (wgid % nig) / gsz; u.seg = 0; return true;
    }
};
struct BranchOrder : StaticOrder {
    static constexpr bool SEGMENTED = true;
    __device__ bool next(int i, Unit& u) const { const bool ok = StaticOrder::next(i / 3, u); u.seg = i % 3; return ok; }
    __device__ __forceinline__ int koff(const Unit& u) const { return u.seg == 0 ? 0 : (u.seg == 1 ? 512 : 1536); }
    __device__ __forceinline__ int nt(const Unit& u) const { return u.seg == 1 ? 16 : 8; }
};

template <class Epi, class Sched>
__device__ __forceinline__ void gemm_phase(LAS unsigned char* lds, const Gemm g, const Sched& S, const Epi& E) {
    const int tid = otid(), wid = __builtin_amdgcn_readfirstlane(tid >> 6), lane = tid & 63, wr = wid >> 2, wc = wid & 3, fr = lane & 15, fq = lane >> 4;
    unsigned voffA[2], voffB[2];
#pragma unroll
    for (int i = 0; i < 2; ++i) { int R, C; stage_rc(tid * 16 + i * 8192, R, C); const int Rb = (R & ~31) + perm32(R & 31);
        voffA[i] = (unsigned)(R * g.lda + C) * 2u; voffB[i] = (unsigned)(Rb * g.ldb + C) * 2u; }
    const size_t kstep = (size_t)(BK * 2);
    const size_t hstepA = (size_t)HALF * g.lda * 2, hstepB = (size_t)HALF * g.ldb * 2;
    const size_t tstepA = 2 * hstepA, tstepB = 2 * hstepB;
    const unsigned ldsw = (unsigned)wid * 1024u;
    const int aoff = lds_byte(wr * 64 + fr, fq * 8), boff = lds_byte(wc * 32 + fr, fq * 8);
#define PG8_SA(b, h) (((b) * 2 + (h)) * HTB)
#define PG8_SB(b, h) ((4 + (b) * 2 + (h)) * HTB)
#define PG8_STAGE(bufoff, gbase, voff) do { _Pragma("unroll") for (int _i = 0; _i < 2; ++_i) \
        __builtin_amdgcn_global_load_lds((const unsigned*)((const char*)(gbase) + (voff)[_i]), (LAS unsigned*)(lds + (bufoff) + ldsw + _i * 8192), 16, 0, PG8_AUX); } while (0)
#define PG8_LDA(dst, b, h) do { _Pragma("unroll") for (int m = 0; m < 4; ++m) _Pragma("unroll") for (int k = 0; k < 2; ++k) dst[m][k] = *(const LAS bf16x8*)(lds + PG8_SA(b, h) + aoff + m * 2048 + k * 1024); } while (0)
#define PG8_LDB(dst, b, h) do { _Pragma("unroll") for (int n = 0; n < 2; ++n) _Pragma("unroll") for (int k = 0; k < 2; ++k) dst[n][k] = *(const LAS bf16x8*)(lds + PG8_SB(b, h) + boff + n * 2048 + k * 1024); } while (0)
#define PG8_MMA(ai, bj, At, Bt) do { __builtin_amdgcn_s_setprio(1); _Pragma("unroll") for (int m = 0; m < 4; ++m) _Pragma("unroll") for (int n = 0; n < 2; ++n) _Pragma("unroll") for (int k = 0; k < 2; ++k) \
        acc[ai][bj][m][n] = __builtin_amdgcn_mfma_f32_16x16x32_bf16(Bt[n][k], At[m][k], acc[ai][bj][m][n], 0, 0, 0); __builtin_amdgcn_s_setprio(0); } while (0)
#define PG8_WAIT_V(n) asm volatile("s_waitcnt vmcnt(" #n ")" ::: "memory")
#define PG8_WAIT_L(n) asm volatile("s_waitcnt lgkmcnt(" #n ")" ::: "memory")
#define PG8_BAR __builtin_amdgcn_s_barrier()
#define PG8_SCHED __builtin_amdgcn_sched_barrier(0)
    Unit cur, nxt; int ui = 0;
    if (!S.next(0, cur)) return;
    f32x4 acc[2][2][4][2];
#pragma unroll
    for (int a = 0; a < 2; ++a)
#pragma unroll
        for (int b = 0; b < 2; ++b)
#pragma unroll
            for (int m = 0; m < 4; ++m)
#pragma unroll
                for (int n = 0; n < 2; ++n) acc[a][b][m][n] = (f32x4){0.f, 0.f, 0.f, 0.f};
    bf16x8 At[4][2], B0[2][2], B1[2][2];
    int nt = Sched::SEGMENTED ? S.nt(cur) : g.K / BK;
    const char* cA = (const char*)g.A + (size_t)cur.pm * tstepA + (size_t)S.koff(cur) * 2; const char* cB = (const char*)g.Bt + (size_t)cur.pn * tstepB + (size_t)S.koff(cur) * 2;
    PG8_STAGE(PG8_SB(0, 0), cB, voffB); PG8_STAGE(PG8_SB(0, 1), cB + hstepB, voffB); PG8_STAGE(PG8_SA(0, 0), cA, voffA); PG8_STAGE(PG8_SA(0, 1), cA + hstepA, voffA);
    if (wr == 1) PG8_BAR;
    PG8_WAIT_V(2); PG8_BAR;
    PG8_STAGE(PG8_SB(1, 0), cB + kstep, voffB); PG8_STAGE(PG8_SA(1, 0), cA + kstep, voffA); PG8_STAGE(PG8_SB(1, 1), cB + hstepB + kstep, voffB);
    PG8_WAIT_V(6); PG8_BAR;
    for (;;) {
        const bool has_next = S.next(ui + 1, nxt);
        const char* nA = has_next ? (const char*)g.A + (size_t)nxt.pm * tstepA + (size_t)S.koff(nxt) * 2 : cA; const char* nB = has_next ? (const char*)g.Bt + (size_t)nxt.pn * tstepB + (size_t)S.koff(nxt) * 2 : cB;
        for (int t = 0; t < nt; t += 2) {
            const bool last = (t == nt - 2);
            const char* a1 = cA + (size_t)(t + 1) * kstep;
            const char* a2 = last ? nA : cA + (size_t)(t + 2) * kstep; const char* b2 = last ? nB : cB + (size_t)(t + 2) * kstep;
            const char* a3 = a2 + kstep; const char* b3 = b2 + kstep;
            PG8_LDB(B0, 0, 0); PG8_LDB(B1, 0, 1); PG8_SCHED; PG8_LDA(At, 0, 0); PG8_STAGE(PG8_SA(1, 1), a1 + hstepA, voffA);
            PG8_WAIT_V(8); PG8_WAIT_L(0); PG8_BAR; PG8_MMA(0, 0, At, B0); PG8_MMA(0, 1, At, B1); PG8_BAR; PG8_SCHED;
            PG8_LDA(At, 0, 1); PG8_STAGE(PG8_SB(0, 0), b2, voffB); PG8_STAGE(PG8_SB(0, 1), b2 + hstepB, voffB); PG8_STAGE(PG8_SA(0, 0), a2, voffA);
            PG8_WAIT_V(8); PG8_WAIT_L(0); PG8_BAR; PG8_MMA(1, 0, At, B0); PG8_MMA(1, 1, At, B1); PG8_BAR; PG8_SCHED;
            PG8_LDB(B0, 1, 0); PG8_LDB(B1, 1, 1); PG8_SCHED; PG8_LDA(At, 1, 0); PG8_STAGE(PG8_SA(0, 1), a2 + hstepA, voffA);
            PG8_WAIT_V(8); PG8_WAIT_L(0); PG8_BAR; PG8_MMA(0, 0, At, B0); PG8_MMA(0, 1, At, B1); PG8_BAR; PG8_SCHED;
            PG8_LDA(At, 1, 1); PG8_STAGE(PG8_SB(1, 0), b3, voffB); PG8_STAGE(PG8_SB(1, 1), b3 + hstepB, voffB); PG8_STAGE(PG8_SA(1, 0), a3, voffA);
            PG8_WAIT_V(8); PG8_WAIT_L(0); PG8_BAR; PG8_MMA(1, 0, At, B0); PG8_MMA(1, 1, At, B1); PG8_BAR; PG8_SCHED;
        }
#ifndef NO_ALIGN
        if (wr == 0) PG8_BAR;
#endif
        E(acc, cur, wr, wc, fr, fq);
        if (!has_next) break;
#pragma unroll
        for (int a = 0; a < 2; ++a)
#pragma unroll
            for (int b = 0; b < 2; ++b)
#pragma unroll
                for (int m = 0; m < 4; ++m)
#pragma unroll
                    for (int n = 0; n < 2; ++n) acc[a][b][m][n] = (f32x4){0.f, 0.f, 0.f, 0.f};
        cur = nxt; cA = nA; cB = nB; ++ui;
        if (Sched::SEGMENTED) nt = S.nt(cur);
#ifndef NO_ALIGN
        if (wr == 1) PG8_BAR;
#endif
    }
    PG8_WAIT_V(0);
#ifdef NO_ALIGN
    if (wr == 0) PG8_BAR;
#endif
    PG8_BAR;
#undef PG8_SA
#undef PG8_SB
#undef PG8_STAGE
#undef PG8_LDA
#undef PG8_LDB
#undef PG8_MMA
#undef PG8_WAIT_V
#undef PG8_WAIT_L
#undef PG8_BAR
#undef PG8_SCHED
}

typedef const f32x4 (&AccRef)[2][2][4][2];

struct EpiFfnUp {
    bf16_t* H; const unsigned long long* rss;
    __device__ __forceinline__ void operator()(AccRef acc, const Unit& u, int wr, int wc, int fr, int fq) const {
        const int row0 = u.pm * BM + wr * 64 + fr, col0 = u.pn * 128 + wc * 32 + 8 * fq;
#pragma unroll
        for (int ai = 0; ai < 2; ++ai)
#pragma unroll
            for (int m = 0; m < 4; ++m) {
                const int row = row0 + ai * HALF + m * 16;
                const float rinv = rsqrtf((float)rss[row] * (1.f / (16777216.f * DM)) + EPS);
                float h[8];
#pragma unroll
                for (int n = 0; n < 2; ++n)
#pragma unroll
                    for (int j = 0; j < 4; ++j) { const float gg = acc[ai][0][m][n][j] * rinv, uu = acc[ai][1][m][n][j] * rinv; h[n * 4 + j] = gg * uu * sigmoid_f(gg); }
                u32x4 o; o.x = pk2(h[0], h[1]); o.y = pk2(h[2], h[3]); o.z = pk2(h[4], h[5]); o.w = pk2(h[6], h[7]);
                *(u32x4*)(H + (size_t)row * FF + col0) = o;
            }
    }
};
struct EpiWin {
    bf16_t* Z; const unsigned long long* rss; bf16_t* XS;
    __device__ __forceinline__ void operator()(AccRef acc, const Unit& u, int wr, int wc, int fr, int fq) const {
        const int row0 = u.pm * BM + wr * 64 + fr, col0 = u.pn * BM + wc * 32 + 8 * fq;
        const bool sg = u.pn >= 16;
        const bool ssm = (u.pn == 14) | (u.pn == 15);
        const int cs = col0 - ZC_S;
        bf16_t* const dst = ssm ? XS + (size_t)(cs >> 4) * T * 16 + (cs & 15) : Z + col0; const size_t pitch = ssm ? 16 : ZW; const size_t bjstep = ssm ? (size_t)8 * T * 16 : (size_t)HALF;
#pragma unroll
        for (int ai = 0; ai < 2; ++ai)
#pragma unroll
            for (int m = 0; m < 4; ++m) {
                const int row = row0 + ai * HALF + m * 16;
                const float rinv = rsqrtf((float)rss[row] * (1.f / (16777216.f * DM)) + EPS);
#pragma unroll
                for (int bj = 0; bj < 2; ++bj) {
                    float h[8];
#pragma unroll
                    for (int n = 0; n < 2; ++n)
#pragma unroll
                        for (int j = 0; j < 4; ++j) { const float v = acc[ai][bj][m][n][j] * rinv; h[n * 4 + j] = sg ? sigmoid_f(v) : v; }
                    u32x4 o; o.x = pk2(h[0], h[1]); o.y = pk2(h[2], h[3]); o.z = pk2(h[4], h[5]); o.w = pk2(h[6], h[7]);
                    *(u32x4*)(dst + (size_t)row * pitch + bj * bjstep) = o;
                }
            }
    }
};
struct EpiResid {
    const float* xin; float* xout; bf16_t* XB; unsigned long long* rssn; float scale;
    __device__ __forceinline__ void operator()(AccRef acc, const Unit& u, int wr, int wc, int fr, int fq) const {
        const int row0 = u.pm * BM + wr * 64 + fr, col0 = u.pn * BM + wc * 32 + 8 * fq;
#pragma unroll
        for (int ai = 0; ai < 2; ++ai)
#pragma unroll
            for (int m = 0; m < 4; ++m) {
                const int row = row0 + ai * HALF + m * 16;
                float ss = 0.f;
#pragma unroll
                for (int bj = 0; bj < 2; ++bj) {
                    const size_t off = (size_t)row * DM + col0 + bj * HALF;
                    f32x4 x0 = *(const f32x4*)(xin + off), x1 = *(const f32x4*)(xin + off + 4);
                    x0 = x0 + acc[ai][bj][m][0] * scale; x1 = x1 + acc[ai][bj][m][1] * scale;
                    *(f32x4*)(xout + off) = x0; *(f32x4*)(xout + off + 4) = x1;
                    u32x4 o; o.x = pk2(x0[0], x0[1]); o.y = pk2(x0[2], x0[3]); o.z = pk2(x1[0], x1[1]); o.w = pk2(x1[2], x1[3]);
                    *(u32x4*)(XB + off) = o;
                    ss += x0[0] * x0[0] + x0[1] * x0[1] + x0[2] * x0[2] + x0[3] * x0[3] + x1[0] * x1[0] + x1[1] * x1[1] + x1[2] * x1[2] + x1[3] * x1[3];
                }
                ss += __shfl_xor(ss, 16); ss += __shfl_xor(ss, 32);
                if (fq == 0) atomicAdd(rssn + row, (unsigned long long)(ss * 16777216.f));
            }
    }
};
struct EpiBranch {
    const bf16_t* G0; bf16_t* MB;
    __device__ __forceinline__ void operator()(AccRef acc, const Unit& u, int wr, int wc, int fr, int fq) const {
        const int row0 = u.pm * BM + wr * 64 + fr, col0 = u.pn * BM + wc * 32 + 8 * fq;
        const bf16_t* G = G0 + u.seg * 2048; const bool accum = u.seg > 0;
#pragma unroll
        for (int ai = 0; ai < 2; ++ai)
#pragma unroll
            for (int m = 0; m < 4; ++m) {
                const int row = row0 + ai * HALF + m * 16;
#pragma unroll
                for (int bj = 0; bj < 2; ++bj) {
                    const int col = col0 + bj * HALF;
                    const u32x4 gv = *(const u32x4*)(G + (size_t)row * ZW + col);
                    u32x4 pv = (u32x4){0u, 0u, 0u, 0u};
                    if (accum) pv = *(const u32x4*)(MB + (size_t)row * DM + col);
                    const f32x4 a0 = acc[ai][bj][m][0], a1 = acc[ai][bj][m][1];
                    u32x4 o;
                    o.x = pk2(bflo(pv.x) + bflo(gv.x) * a0[0], bfhi(pv.x) + bfhi(gv.x) * a0[1]);
                    o.y = pk2(bflo(pv.y) + bflo(gv.y) * a0[2], bfhi(pv.y) + bfhi(gv.y) * a0[3]);
                    o.z = pk2(bflo(pv.z) + bflo(gv.z) * a1[0], bfhi(pv.z) + bfhi(gv.z) * a1[1]);
                    o.w = pk2(bflo(pv.w) + bflo(gv.w) * a1[2], bfhi(pv.w) + bfhi(gv.w) * a1[3]);
                    *(u32x4*)(MB + (size_t)row * DM + col) = o;
                }
            }
    }
};
struct EpiGlu {
    const bf16_t* YS; bf16_t* Y;
    __device__ __forceinline__ void operator()(AccRef acc, const Unit& u, int wr, int wc, int fr, int fq) const {
        const int row0 = u.pm * BM + wr * 64 + fr, col0 = u.pn * BM + wc * 32 + 8 * fq;
#pragma unroll
        for (int ai = 0; ai < 2; ++ai)
#pragma unroll
            for (int m = 0; m < 4; ++m) {
                const int row = row0 + ai * HALF + m * 16;
#pragma unroll
                for (int bj = 0; bj < 2; ++bj) {
                    const int col = col0 + bj * HALF;
                    const u32x4 yv = *(const u32x4*)(YS + (size_t)row * 512 + col);
                    const f32x4 a0 = acc[ai][bj][m][0], a1 = acc[ai][bj][m][1];
                    u32x4 o;
                    o.x = pk2(bflo(yv.x) * sigmoid_f(a0[0]), bfhi(yv.x) * sigmoid_f(a0[1]));
                    o.y = pk2(bflo(yv.y) * sigmoid_f(a0[2]), bfhi(yv.y) * sigmoid_f(a0[3]));
                    o.z = pk2(bflo(yv.z) * sigmoid_f(a1[0]), bfhi(yv.z) * sigmoid_f(a1[1]));
                    o.w = pk2(bflo(yv.w) * sigmoid_f(a1[2]), bfhi(yv.w) * sigmoid_f(a1[3]));
                    *(u32x4*)(Y + (size_t)row * DM + YC_SSM + col) = o;
                }
            }
    }
};
}

struct Args { const float* in[28]; float* out; unsigned char* ws; int ph_lo, ph_hi; };
enum { I_X = 0, I_F1N, I_F1G, I_F1U, I_F1D, I_MIXN, I_WIN, I_POOLW, I_POOLS, I_GW2, I_GB, I_GNORM, I_ARE, I_AIM, I_LDT, I_BRE, I_BIM, I_CRE, I_CIM,
       I_SD, I_WGLU, I_WBR, I_WOUT, I_F2N, I_F2G, I_F2U, I_F2D, I_FINN };

__device__ __forceinline__ void tr_item(const float* W, int ldw, int col0, const float* ksc, bf16_t* WT, int ldt, int drow, int k0, int n0, unsigned* scr, int lane) {
    const int a = lane & 15, b = lane >> 4;
    const float* src = W + (size_t)(k0 + 2 * b) * ldw + col0 + n0 + a * 4;
    f32x4 v[16];
#pragma unroll
    for (int m = 0; m < 8; ++m) { v[2 * m] = *(const f32x4*)(src + (size_t)(8 * m) * ldw); v[2 * m + 1] = *(const f32x4*)(src + (size_t)(8 * m + 1) * ldw); }
#pragma unroll
    for (int m = 0; m < 8; ++m) {
        const float s0 = ksc ? ksc[k0 + 8 * m + 2 * b] : 1.f, s1 = ksc ? ksc[k0 + 8 * m + 2 * b + 1] : 1.f;
#pragma unroll
        for (int e = 0; e < 4; ++e) scr[(4 * a + e) * 32 + (((m ^ (a & 7)) << 2) | b)] = pk2(v[2 * m][e] * s0, v[2 * m + 1][e] * s1);
    }
    LDS_WAIT();
#pragma unroll
    for (int j = 0; j < 8; ++j) { const int n = (lane >> 3) + 8 * j, c = lane & 7;
        const u32x4 o = *(const u32x4*)(scr + n * 32 + ((c ^ ((n >> 2) & 7)) << 2));
        *(u32x4*)(WT + (size_t)(drow + n) * ldt + k0 + c * 8) = o; }
    LDS_WAIT();
}
__device__ __forceinline__ bool tr_try(int& r, const float* W, int ldw, int K, int N, int col0, const float* ksc, bf16_t* WT, int ldt, int drow0, int mode, unsigned* scr, int lane) {
    const int nblk = N / 64, items = (K / 64) * nblk;
    if (r >= items) { r -= items; return false; }
    const int kb = r / nblk, n0 = (r % nblk) * 64;
    const int drow = drow0 + (mode ? ((n0 >> 7) * 256 + (n0 & 127)) : n0);
    tr_item(W, ldw, col0, ksc, WT, ldt, drow, kb * 64, n0, scr, lane);
    return true;
}

__device__ __forceinline__ void cpow_d(double th, double la, int j, double& pr, double& pi) {
    const double y = th * (double)j;
    const double kq = __builtin_rint(y * 0.63661977236758134308);
    double r = __builtin_fma(-kq, 1.57079632679489655800, y); r = __builtin_fma(-kq, 6.12323399573676603587e-17, r);
    const double r2 = r * r;
    double s = 1.0 - r2 * (1.0 / 272.0); s = 1.0 - r2 * (1.0 / 210.0) * s; s = 1.0 - r2 * (1.0 / 156.0) * s; s = 1.0 - r2 * (1.0 / 110.0) * s; s = 1.0 - r2 * (1.0 / 72.0) * s; s = 1.0 - r2 * (1.0 / 42.0) * s; s = 1.0 - r2 * (1.0 / 20.0) * s; s = 1.0 - r2 * (1.0 / 6.0) * s; s *= r;
    double c = 1.0 - r2 * (1.0 / 240.0); c = 1.0 - r2 * (1.0 / 182.0) * c; c = 1.0 - r2 * (1.0 / 132.0) * c; c = 1.0 - r2 * (1.0 / 90.0) * c; c = 1.0 - r2 * (1.0 / 56.0) * c; c = 1.0 - r2 * (1.0 / 30.0) * c; c = 1.0 - r2 * (1.0 / 12.0) * c; c = 1.0 - r2 * (1.0 / 2.0) * c;
    const int q = ((int)kq) & 3;
    double sn = s, cs = c;
    if (q == 1) { sn = c; cs = -s; } else if (q == 2) { sn = -s; cs = -c; } else if (q == 3) { sn = -c; cs = s; }
    const double x = la * (double)j * (1.0 * (1.0 / 64.0));
    double e = 1.0 + x * (1.0 / 10.0); e = 1.0 + x * (1.0 / 9.0) * e; e = 1.0 + x * (1.0 / 8.0) * e; e = 1.0 + x * (1.0 / 7.0) * e; e = 1.0 + x * (1.0 / 6.0) * e; e = 1.0 + x * (1.0 / 5.0) * e; e = 1.0 + x * (1.0 / 4.0) * e; e = 1.0 + x * (1.0 / 3.0) * e; e = 1.0 + x * (1.0 / 2.0) * e; e = 1.0 + x * e;
#pragma unroll
    for (int i = 0; i < 6; ++i) e = e * e;
    pr = e * cs; pi = e * sn;
}

__device__ __forceinline__ void phase_prep(const Args& a, int l, unsigned char* lds, int G) {
    const int tid = otid(), lane = tid & 63, wave = tid >> 6;
    unsigned char* ws = a.ws;
    const int gw = blockIdx.x * 8 + wave, NGW = G * 8;
    unsigned* scr = (unsigned*)(lds + wave * 16384);
    const float* f1n = a.in[I_F1N] + (size_t)l * DM; const float* f2n = a.in[I_F2N] + (size_t)l * DM; const float* mxn = a.in[I_MIXN] + (size_t)l * DM;
    const float* f1g = a.in[I_F1G] + (size_t)l * DM * FF; const float* f1u = a.in[I_F1U] + (size_t)l * DM * FF; const float* f1d = a.in[I_F1D] + (size_t)l * FF * DM;
    const float* f2g = a.in[I_F2G] + (size_t)l * DM * FF; const float* f2u = a.in[I_F2U] + (size_t)l * DM * FF; const float* f2d = a.in[I_F2D] + (size_t)l * FF * DM;
    const float* win = a.in[I_WIN] + (size_t)l * DM * INW; const float* wbr = a.in[I_WBR] + (size_t)l * DM * DM; const float* wout = a.in[I_WOUT] + (size_t)l * DM * DM;
    const float* wglu = a.in[I_WGLU] + (size_t)l * 512 * 512;
    constexpr int IT_FU = (DM / 64) * (FF / 64), IT_FD = (FF / 64) * (DM / 64), IT_WA = (DM / 64) * (3584 / 64), IT_WB = (DM / 64) * (6656 / 64),
                  IT_BR = (1536 / 64) * (DM / 64), IT_WO = (DM / 64) * (DM / 64), IT_GL = (512 / 64) * (512 / 64);
    constexpr int IT_TOTAL = 4 * IT_FU + 2 * IT_FD + IT_WA + IT_WB + IT_BR + IT_WO + IT_GL;
    for (int it = gw; it < IT_TOTAL; it += NGW) {
        int r = it;
        if (tr_try(r, f1g, FF, DM, FF, 0, f1n, (bf16_t*)(ws + WS_W1U), DM, 0, 1, scr, lane)) continue;
        if (tr_try(r, f1u, FF, DM, FF, 0, f1n, (bf16_t*)(ws + WS_W1U), DM, 128, 1, scr, lane)) continue;
        if (tr_try(r, f2g, FF, DM, FF, 0, f2n, (bf16_t*)(ws + WS_W2U), DM, 0, 1, scr, lane)) continue;
        if (tr_try(r, f2u, FF, DM, FF, 0, f2n, (bf16_t*)(ws + WS_W2U), DM, 128, 1, scr, lane)) continue;
        if (tr_try(r, f1d, DM, FF, DM, 0, nullptr, (bf16_t*)(ws + WS_W1D), FF, 0, 0, scr, lane)) continue;
        if (tr_try(r, f2d, DM, FF, DM, 0, nullptr, (bf16_t*)(ws + WS_W2D), FF, 0, 0, scr, lane)) continue;
        if (tr_try(r, win, INW, DM, 3584, 0, mxn, (bf16_t*)(ws + WS_WIN), DM, 0, 0, scr, lane)) continue;
        if (tr_try(r, win, INW, DM, 6656, 3600, mxn, (bf16_t*)(ws + WS_WIN), DM, 3584, 0, scr, lane)) continue;
        if (tr_try(r, wbr + (size_t)512 * DM, DM, 1536, DM, 0, nullptr, (bf16_t*)(ws + WS_WBR) + 512, DM, 0, 0, scr, lane)) continue;
        if (tr_try(r, wout, DM, DM, DM, 0, nullptr, (bf16_t*)(ws + WS_WO), DM, 0, 0, scr, lane)) continue;
        tr_try(r, wglu, 512, 512, 512, 0, nullptr, (bf16_t*)(ws + WS_WGLU), 512, 0, 0, scr, lane);
    }
    {
        const float* pw = a.in[I_POOLW] + (size_t)l * 4 * 128 * 128; const float* ps = a.in[I_POOLS] + (size_t)l * 512;
        bf16_t* WbT = (bf16_t*)(ws + WS_WBR);
        const int n0 = blockIdx.x * 8, k = tid, g = k >> 7;
        const float* pr = pw + (size_t)k * 128;
        float s[8];
#pragma unroll
        for (int i = 0; i < 8; ++i) s[i] = 0.f;
#pragma unroll 4
        for (int d = 0; d < 128; ++d) {
            const float pv = pr[d] * ps[g * 128 + d];
            const f32x4 w0 = *(const f32x4*)(wbr + (size_t)(g * 128 + d) * DM + n0), w1 = *(const f32x4*)(wbr + (size_t)(g * 128 + d) * DM + n0 + 4);
            s[0] += pv * w0[0]; s[1] += pv * w0[1]; s[2] += pv * w0[2]; s[3] += pv * w0[3]; s[4] += pv * w1[0]; s[5] += pv * w1[1]; s[6] += pv * w1[2]; s[7] += pv * w1[3];
        }
#pragma unroll
        for (int i = 0; i < 8; ++i) WbT[(size_t)(n0 + i) * DM + k] = (bf16_t)f2bf(s[i]);
    }
    {
        bf16_t* WGT = (bf16_t*)(ws + WS_WGT);
        for (int i = blockIdx.x * 512 + tid; i < 16 * DM; i += G * 512) { const int j = i >> 11, k = i & 2047; WGT[i] = (bf16_t)f2bf(mxn[k] * win[(size_t)k * INW + 3584 + j]); }
    }
    {
        const float* are = a.in[I_ARE] + (size_t)l * 32 * 64; const float* aim = a.in[I_AIM] + (size_t)l * 32 * 64; const float* ldt = a.in[I_LDT] + (size_t)l * 32;
        const float* bre = a.in[I_BRE] + (size_t)l * 32 * 64 * 16; const float* bim = a.in[I_BIM] + (size_t)l * 32 * 64 * 16;
        const float* cre = a.in[I_CRE] + (size_t)l * 32 * 16 * 64; const float* cim = a.in[I_CIM] + (size_t)l * 32 * 16 * 64;
        const float* sd = a.in[I_SD] + (size_t)l * 512;
        bf16_t* KT = (bf16_t*)(ws + WS_KT); bf16_t* MET = (bf16_t*)(ws + WS_MET); bf16_t* MCT = (bf16_t*)(ws + WS_MCT); float* L64 = (float*)(ws + WS_L64);
        float* s_cr = (float*)lds;
        float* s_ci = s_cr + 1024;
        float* s_bbr = s_ci + 1024;
        float* s_bbi = s_bbr + 1024;
        float* s_pw = s_bbi + 1024;
        float* s_f = s_pw + 1024;
        __syncthreads();
        for (int it = blockIdx.x; it < 32 * 9; it += G) {
            const int g = it / 9, jb = it % 9;
            {
                const int p = tid & 63, jj = tid >> 6, j = jb * 8 + jj;
                const double dt = (double)expf(ldt[g]);
                const double ar = (double)are[g * 64 + p], ai = (double)aim[g * 64 + p];
                if (j <= 64) { double pr, pi; cpow_d(dt * ai, dt * ar, j, pr, pi); s_pw[(jj * 64 + p) * 2] = (float)pr; s_pw[(jj * 64 + p) * 2 + 1] = (float)pi;
                    if (j == 64) { L64[(g * 64 + p) * 2] = (float)pr; L64[(g * 64 + p) * 2 + 1] = (float)pi; } }
                if (tid < 64) {
                    double l1r, l1i; cpow_d(dt * ai, dt * ar, 1, l1r, l1i);
                    const double den = ar * ar + ai * ai;
                    s_f[2 * p] = (float)(((l1r - 1.0) * ar + l1i * ai) / den); s_f[2 * p + 1] = (float)((l1i * ar - (l1r - 1.0) * ai) / den);
                }
#pragma unroll
                for (int i = 0; i < 2; ++i) { const int idx = tid + i * 512; s_cr[idx] = cre[(size_t)g * 1024 + idx]; s_ci[idx] = cim[(size_t)g * 1024 + idx]; }
            }
            __syncthreads();
#pragma unroll
            for (int i = 0; i < 2; ++i) { const int idx = tid + i * 512, p = idx >> 4; const float fr = s_f[2 * p], fi = s_f[2 * p + 1];
                const float br = bre[(size_t)g * 1024 + idx], bi = bim[(size_t)g * 1024 + idx];
                s_bbr[idx] = fr * br - fi * bi; s_bbi[idx] = fr * bi + fi * br; }
            __syncthreads();
#pragma unroll 1
            for (int i = 0; i < 4; ++i) {
                const int o = tid + i * 512, jj = o >> 8, h = (o >> 4) & 15, hp = o & 15, j = jb * 8 + jj;
                if (j < 64) {
                    float sacc = 0.f;
#pragma unroll 8
                    for (int p = 0; p < 64; ++p) { const float cr = s_cr[h * 64 + p], ci = s_ci[h * 64 + p], pr = s_pw[(jj * 64 + p) * 2], pi = s_pw[(jj * 64 + p) * 2 + 1];
                        sacc += (cr * pr - ci * pi) * s_bbr[p * 16 + hp] - (cr * pi + ci * pr) * s_bbi[p * 16 + hp]; }
                    if (j == 0 && h == hp) sacc += sd[g * 16 + h];
                    KT[((size_t)(g * 64 + j) * 16 + h) * 16 + hp] = (bf16_t)f2bf(sacc);
                }
            }
#pragma unroll 4
            for (int i = 0; i < 16; ++i) {
                const int o = tid + i * 512, jj = o >> 10, j = jb * 8 + jj;
                if (j < 64) { const int p = (o >> 4) & 63, hp = o & 15; const float pr = s_pw[(jj * 64 + p) * 2], pi = s_pw[(jj * 64 + p) * 2 + 1], br = s_bbr[p * 16 + hp], bi = s_bbi[p * 16 + hp];
                    const int jp = 63 - j;
                    MET[((size_t)(g * 128 + p) * 64 + jp) * 16 + hp] = (bf16_t)f2bf(pr * br - pi * bi);
                    MET[((size_t)(g * 128 + 64 + p) * 64 + jp) * 16 + hp] = (bf16_t)f2bf(pr * bi + pi * br); }
                if (j >= 1 && j <= 64) { const int h = (o >> 6) & 15, p = o & 63; const float cr = s_cr[h * 64 + p], ci = s_ci[h * 64 + p], pr = s_pw[(jj * 64 + p) * 2], pi = s_pw[(jj * 64 + p) * 2 + 1];
                    const size_t base = ((size_t)g * 1024 + (j - 1) * 16 + h) * 128;
                    MCT[base + p] = (bf16_t)f2bf(cr * pr - ci * pi); MCT[base + 64 + p] = (bf16_t)f2bf(-(cr * pi + ci * pr)); }
            }
            __syncthreads();
        }
    }
    if (l == 0) {
        const float* x = a.in[I_X]; bf16_t* XB = (bf16_t*)(ws + WS_XB); unsigned long long* rss = (unsigned long long*)(ws + WS_RSS);
        for (int row = gw; row < T; row += NGW) {
            const f32x4* xr = (const f32x4*)(x + (size_t)row * DM) + lane; u32x2* o = (u32x2*)(XB + (size_t)row * DM) + lane;
            float ss = 0.f;
#pragma unroll
            for (int i = 0; i < 8; ++i) { const f32x4 v = xr[64 * i]; ss += v[0] * v[0] + v[1] * v[1] + v[2] * v[2] + v[3] * v[3]; u32x2 w; w.x = pk2(v[0], v[1]); w.y = pk2(v[2], v[3]); o[64 * i] = w; }
            ss = wave_sum(ss);
            if (lane == 0) rss[row] = (unsigned long long)(ss * 16777216.f);
        }
        for (int i = blockIdx.x * 512 + tid; i < 6 * T; i += G * 512) rss[T + i] = 0ull;
    }
}

__device__ __forceinline__ void phase_glr(const Args& a, const unsigned long long* rss, int G) {
    const int tid = otid(), lane = tid & 63, wave = tid >> 6, r16 = lane & 15, quad = lane >> 4;
    const int gw = blockIdx.x * 8 + wave, NGW = G * 8;
    const bf16_t* XB = (const bf16_t*)(a.ws + WS_XB); const bf16_t* WGT = (const bf16_t*)(a.ws + WS_WGT); float* GLR = (float*)(a.ws + WS_GLR);
    for (int task = gw; task < T / 16; task += NGW) {
        const int r0 = task * 16;
        f32x4 acc = (f32x4){0.f, 0.f, 0.f, 0.f};
        const bf16_t* ap = XB + (size_t)(r0 + r16) * DM + quad * 8; const bf16_t* bp = WGT + (size_t)r16 * DM + quad * 8;
#pragma unroll 8
        for (int kb = 0; kb < 64; ++kb) acc = mfma16(*(const bf16x8*)(ap + kb * 32), *(const bf16x8*)(bp + kb * 32), acc);
#pragma unroll
        for (int i = 0; i < 4; ++i) { const int row = r0 + quad * 4 + i; GLR[(size_t)row * 16 + r16] = acc[i] * rsqrtf((float)rss[row] * (1.f / (16777216.f * DM)) + EPS); }
    }
}

template <int W>
__device__ __forceinline__ void pool_group(const bf16_t* Z, bf16_t* Y, int c00, int G) {
    for (int idx = blockIdx.x * 512 + otid(); idx < T * 16; idx += G * 512) {
        const int t = idx >> 4, c0 = c00 + (idx & 15) * 8, s = t & (SEQ - 1);
        const int cnt = (s + 1) < W ? (s + 1) : W;
        u32x4 v[W];
#pragma unroll
        for (int j = 0; j < W; ++j) { const int tj = (j < cnt) ? (t - j) : t; v[j] = *(const u32x4*)(Z + (size_t)tj * ZW + ZC_POOL + c0); }
        float sum[8];
#pragma unroll
        for (int i = 0; i < 8; ++i) sum[i] = 0.f;
#pragma unroll
        for (int j = 0; j < W; ++j) { const float m = (j < cnt) ? 1.f : 0.f;
            sum[0] += m * bflo(v[j].x); sum[1] += m * bfhi(v[j].x); sum[2] += m * bflo(v[j].y); sum[3] += m * bfhi(v[j].y);
            sum[4] += m * bflo(v[j].z); sum[5] += m * bfhi(v[j].z); sum[6] += m * bflo(v[j].w); sum[7] += m * bfhi(v[j].w); }
        const float inv = 1.f / (float)cnt;
        u32x4 o; o.x = pk2(sum[0] * inv - bflo(v[0].x), sum[1] * inv - bfhi(v[0].x)); o.y = pk2(sum[2] * inv - bflo(v[0].y), sum[3] * inv - bfhi(v[0].y));
        o.z = pk2(sum[4] * inv - bflo(v[0].z), sum[5] * inv - bfhi(v[0].z)); o.w = pk2(sum[6] * inv - bflo(v[0].w), sum[7] * inv - bfhi(v[0].w));
        *(u32x4*)(Y + (size_t)t * DM + c0) = o;
    }
}
__device__ __forceinline__ void phase_pool(const Args& a, int G) {
    const bf16_t* Z = (const bf16_t*)(a.ws + WS_Z); bf16_t* Y = (bf16_t*)(a.ws + WS_Y);
    pool_group<2>(Z, Y, 0, G); pool_group<4>(Z, Y, 128, G); pool_group<8>(Z, Y, 256, G); pool_group<16>(Z, Y, 384, G);
}

constexpr int OFF_BC = 0, OFF_QP = 32768, OFF_KP = 50176, OFF_OB = 0, OFF_QD = 67584, OFF_VT = 84992, OFF_PB = 121856, OFF_GL = 131072, OFF_TOT = 135168;
constexpr int PQ = 136, PV = 72, POB = 260;

__device__ __forceinline__ void gla_bc(const Args& a, int l, unsigned char* lds, int t0, int h) {
    const int tid = otid(), d = tid & 127, jq = tid >> 7;
    float* BC = (float*)(lds + OFF_BC); float* GL = (float*)(lds + OFF_GL); float* TOT = (float*)(lds + OFF_TOT);
    const float* GLR = (const float*)(a.ws + WS_GLR);
    const float* w2 = a.in[I_GW2] + (size_t)l * 16 * 512; const float* gb = a.in[I_GB] + (size_t)l * 512;
    for (int i = tid; i < 1024; i += 512) GL[i] = GLR[(size_t)t0 * 16 + i];
    float w[16];
#pragma unroll
    for (int r = 0; r < 16; ++r) w[r] = w2[r * 512 + h * 128 + d];
    const float bias = gb[h * 128 + d];
    __syncthreads();
    float run = 0.f;
#pragma unroll 4
    for (int jj = 0; jj < 16; ++jj) {
        const int j = jq * 16 + jj;
        float z = bias;
#pragma unroll
        for (int r = 0; r < 16; ++r) z += GL[j * 16 + r] * w[r];
        const float la = (fminf(z, 0.f) - __logf(1.f + __expf(-fabsf(z)))) * (1.f / 16.f);
        run += la; BC[j * 128 + d] = run;
    }
    TOT[jq * 128 + d] = run;
    __syncthreads();
    float off = 0.f;
    for (int q = 0; q < jq; ++q) off += TOT[q * 128 + d];
    if (jq > 0) {
#pragma unroll 4
        for (int jj = 0; jj < 16; ++jj) BC[(jq * 16 + jj) * 128 + d] += off;
    }
    __syncthreads();
}

__device__ __forceinline__ int tsw(int x, int j) { return x * PV + ((((j >> 3) ^ ((x >> 3) & 7)) << 3) | (j & 7)); }
__device__ __forceinline__ int tsc(int x, int c) { return x * PV + ((c ^ ((x >> 3) & 7)) << 3); }
__device__ __forceinline__ float bfe(const u32x4& v, int e) { const unsigned w = (e < 2) ? v.x : (e < 4) ? v.y : (e < 6) ? v.z : v.w; return (e & 1) ? bfhi(w) : bflo(w); }
__device__ __forceinline__ unsigned short bfr(const u32x4& v, int e) { const unsigned w = (e < 2) ? v.x : (e < 4) ? v.y : (e < 6) ? v.z : v.w; return (unsigned short)((e & 1) ? (w >> 16) : (w & 0xffffu)); }

__device__ __forceinline__ void gla_kv_unit(const Args& a, int l, unsigned char* lds, int unit) {
    const int tid = otid(), lane = tid & 63, wave = tid >> 6, r16 = lane & 15, quad = lane >> 4;
    const int bh = unit >> 6, n = unit & 63, b = bh >> 2, h = bh & 3, t0 = b * SEQ + n * 64;
    const bf16_t* Z = (const bf16_t*)(a.ws + WS_Z); bf16_t* KV = (bf16_t*)(a.ws + WS_KV); float* DEC = (float*)(a.ws + WS_DEC);
    u32x4 kreg[2], vreg[4];
#pragma unroll
    for (int i = 0; i < 2; ++i) { const int p = tid + 512 * i; kreg[i] = *(const u32x4*)(Z + (size_t)(t0 + (p >> 4)) * ZW + ZC_K + h * 128 + (p & 15) * 8); }
#pragma unroll
    for (int i = 0; i < 4; ++i) { const int p = tid + 512 * i; vreg[i] = *(const u32x4*)(Z + (size_t)(t0 + (p >> 5)) * ZW + ZC_V + h * 256 + (p & 31) * 8); }
    gla_bc(a, l, lds, t0, h);
    const float* BC = (const float*)(lds + OFF_BC); bf16_t* KTl = (bf16_t*)(lds + OFF_QP); bf16_t* VT = (bf16_t*)(lds + OFF_VT);
    {
        float* BCG = (float*)(a.ws + WS_BCG);
#pragma unroll
        for (int i = 0; i < 4; ++i) { const int p = tid + 512 * i, j = p >> 5, d0 = (p & 31) * 4; *(f32x4*)(BCG + (size_t)(t0 + j) * 512 + h * 128 + d0) = *(const f32x4*)(BC + j * 128 + d0); }
    }
#pragma unroll
    for (int i = 0; i < 2; ++i) {
        const int p = tid + 512 * i, j = p >> 4, d0 = (p & 15) * 8;
        const f32x4 bl0 = *(const f32x4*)(BC + 63 * 128 + d0), bl1 = *(const f32x4*)(BC + 63 * 128 + d0 + 4);
        const f32x4 bc0 = *(const f32x4*)(BC + j * 128 + d0), bc1 = *(const f32x4*)(BC + j * 128 + d0 + 4);
#pragma unroll
        for (int e = 0; e < 8; ++e) { const float bl = e < 4 ? bl0[e & 3] : bl1[e & 3], bc = e < 4 ? bc0[e & 3] : bc1[e & 3];
            KTl[tsw(d0 + e, j)] = (bf16_t)f2bf(bfe(kreg[i], e) * __expf(bl - bc)); }
    }
    if (tid < 128) DEC[(size_t)unit * 128 + tid] = __expf(BC[63 * 128 + tid]);
#pragma unroll
    for (int i = 0; i < 4; ++i) {
        const int p = tid + 512 * i, j = p >> 5, v0 = (p & 31) * 8;
#pragma unroll
        for (int e = 0; e < 8; ++e) VT[tsw(v0 + e, j)] = bfr(vreg[i], e);
    }
    __syncthreads();
    f32x4 acc[8][2];
#pragma unroll
    for (int i = 0; i < 8; ++i) { acc[i][0] = (f32x4){0.f, 0.f, 0.f, 0.f}; acc[i][1] = (f32x4){0.f, 0.f, 0.f, 0.f}; }
#pragma unroll
    for (int kb = 0; kb < 2; ++kb) {
        bf16x8 bf[2];
#pragma unroll
        for (int v2 = 0; v2 < 2; ++v2) bf[v2] = *(const bf16x8*)(VT + tsc((wave * 2 + v2) * 16 + r16, kb * 4 + quad));
#pragma unroll
        for (int db = 0; db < 8; ++db) { const bf16x8 af = *(const bf16x8*)(KTl + tsc(db * 16 + r16, kb * 4 + quad));
            acc[db][0] = mfma16(af, bf[0], acc[db][0]); acc[db][1] = mfma16(af, bf[1], acc[db][1]); }
    }
#pragma unroll
    for (int db = 0; db < 8; ++db)
#pragma unroll
        for (int v2 = 0; v2 < 2; ++v2) { const int v = (wave * 2 + v2) * 16 + r16; u32x2 o; o.x = pk2(acc[db][v2][0], acc[db][v2][1]); o.y = pk2(acc[db][v2][2], acc[db][v2][3]);
            *(u32x2*)(KV + ((size_t)unit * 256 + v) * 128 + db * 16 + quad * 4) = o; }
    __syncthreads();
}

__device__ __forceinline__ void gla_scan(const Args& a, int G) {
    bf16_t* KV = (bf16_t*)(a.ws + WS_KV); const float* DEC = (const float*)(a.ws + WS_DEC);
    for (int id = blockIdx.x * 512 + otid(); id < 16 * 256 * 32; id += G * 512) {
        const int bh = id >> 13, v = (id >> 5) & 255, d0 = (id & 31) * 4;
        float s0 = 0.f, s1 = 0.f, s2 = 0.f, s3 = 0.f;
#pragma unroll 8
        for (int n = 0; n < 64; ++n) {
            const int unit = bh * 64 + n;
            u32x2* p = (u32x2*)(KV + ((size_t)unit * 256 + v) * 128 + d0);
            const u32x2 kv = *p; const f32x4 dc = *(const f32x4*)(DEC + (size_t)unit * 128 + d0);
            u32x2 o; o.x = pk2(s0, s1); o.y = pk2(s2, s3); *p = o;
            s0 = dc[0] * s0 + bflo(kv.x); s1 = dc[1] * s1 + bfhi(kv.x); s2 = dc[2] * s2 + bflo(kv.y); s3 = dc[3] * s3 + bfhi(kv.y);
        }
    }
}

__device__ __forceinline__ void gla_out_unit(const Args& a, int l, unsigned char* lds, int unit) {
    const int tid = otid(), lane = tid & 63, wave = tid >> 6, r16 = lane & 15, quad = lane >> 4;
    const int bh = unit >> 6, n = unit & 63, b = bh >> 2, h = bh & 3, t0 = b * SEQ + n * 64;
    const bf16_t* Z = (const bf16_t*)(a.ws + WS_Z); const bf16_t* KV = (const bf16_t*)(a.ws + WS_KV); bf16_t* Y = (bf16_t*)(a.ws + WS_Y);
    u32x4 qreg[2], kreg[2], vreg[4];
#pragma unroll
    for (int i = 0; i < 2; ++i) { const int p = tid + 512 * i; const bf16_t* rp = Z + (size_t)(t0 + (p >> 4)) * ZW + h * 128 + (p & 15) * 8;
        qreg[i] = *(const u32x4*)(rp + ZC_Q); kreg[i] = *(const u32x4*)(rp + ZC_K); }
#pragma unroll
    for (int i = 0; i < 4; ++i) { const int p = tid + 512 * i; vreg[i] = *(const u32x4*)(Z + (size_t)(t0 + (p >> 5)) * ZW + ZC_V + h * 256 + (p & 31) * 8); }
    const float* BCG = (const float*)(a.ws + WS_BCG);
    f32x4 bcr[2][2], bmr[2][2];
#pragma unroll
    for (int i = 0; i < 2; ++i) { const int p = tid + 512 * i, j = p >> 4, d0 = (p & 15) * 8;
        bcr[i][0] = *(const f32x4*)(BCG + (size_t)(t0 + j) * 512 + h * 128 + d0); bcr[i][1] = *(const f32x4*)(BCG + (size_t)(t0 + j) * 512 + h * 128 + d0 + 4);
        bmr[i][0] = *(const f32x4*)(BCG + (size_t)(t0 + 31) * 512 + h * 128 + d0); bmr[i][1] = *(const f32x4*)(BCG + (size_t)(t0 + 31) * 512 + h * 128 + d0 + 4); }
    bf16_t* QP = (bf16_t*)(lds + OFF_QP); bf16_t* KP = (bf16_t*)(lds + OFF_KP); bf16_t* QD = (bf16_t*)(lds + OFF_QD); bf16_t* VT = (bf16_t*)(lds + OFF_VT); bf16_t* PB = (bf16_t*)(lds + OFF_PB);
    float* OB = (float*)(lds + OFF_OB);
#pragma unroll
    for (int i = 0; i < 2; ++i) {
        const int p = tid + 512 * i, j = p >> 4, d0 = (p & 15) * 8;
        const f32x4 bm0 = bmr[i][0], bm1 = bmr[i][1];
        const f32x4 bc0 = bcr[i][0], bc1 = bcr[i][1];
        float qp[8], kp[8], qd[8];
#pragma unroll
        for (int e = 0; e < 8; ++e) { const float bm = e < 4 ? bm0[e & 3] : bm1[e & 3], bc = e < 4 ? bc0[e & 3] : bc1[e & 3];
            const float qv = bfe(qreg[i], e) * 0.08838834764831845f, kv = bfe(kreg[i], e);
            qp[e] = qv * __expf(bc - bm); kp[e] = kv * __expf(bm - bc); qd[e] = qv * __expf(bc); }
        u32x4 o; o.x = pk2(qp[0], qp[1]); o.y = pk2(qp[2], qp[3]); o.z = pk2(qp[4], qp[5]); o.w = pk2(qp[6], qp[7]); *(u32x4*)(QP + j * PQ + d0) = o;
        o.x = pk2(kp[0], kp[1]); o.y = pk2(kp[2], kp[3]); o.z = pk2(kp[4], kp[5]); o.w = pk2(kp[6], kp[7]); *(u32x4*)(KP + j * PQ + d0) = o;
        o.x = pk2(qd[0], qd[1]); o.y = pk2(qd[2], qd[3]); o.z = pk2(qd[4], qd[5]); o.w = pk2(qd[6], qd[7]); *(u32x4*)(QD + j * PQ + d0) = o;
    }
#pragma unroll
    for (int i = 0; i < 4; ++i) {
        const int p = tid + 512 * i, j = p >> 5, v0 = (p & 31) * 8;
#pragma unroll
        for (int e = 0; e < 8; ++e) VT[tsw(v0 + e, j)] = bfr(vreg[i], e);
    }
    bf16x8 bfk[4][2];
#pragma unroll
    for (int kb = 0; kb < 4; ++kb)
#pragma unroll
        for (int v2 = 0; v2 < 2; ++v2) bfk[kb][v2] = *(const bf16x8*)(KV + ((size_t)unit * 256 + (wave * 2 + v2) * 16 + r16) * 128 + kb * 32 + quad * 8);
    u32x2 rv8[8];
#pragma unroll
    for (int rr = 0; rr < 8; ++rr) rv8[rr] = *(const u32x2*)(Z + (size_t)(t0 + wave * 8 + rr) * ZW + ZC_R + h * 256 + lane * 4);
    __syncthreads();
    {
        const int ib = wave >> 1;
#pragma unroll
        for (int jbi = 0; jbi < 2; ++jbi) {
            const int jb = (wave & 1) * 2 + jbi;
            f32x4 sc = (f32x4){0.f, 0.f, 0.f, 0.f};
            if (jb <= ib) {
#pragma unroll
                for (int kb = 0; kb < 4; ++kb) sc = mfma16(*(const bf16x8*)(QP + (ib * 16 + r16) * PQ + kb * 32 + quad * 8), *(const bf16x8*)(KP + (jb * 16 + r16) * PQ + kb * 32 + quad * 8), sc);
            }
#pragma unroll
            for (int i = 0; i < 4; ++i) { const int row = ib * 16 + quad * 4 + i, col = jb * 16 + r16; PB[row * PV + col] = (bf16_t)f2bf(col <= row ? sc[i] : 0.f); }
        }
    }
    __syncthreads();
    f32x4 acc[4][2];
#pragma unroll
    for (int i = 0; i < 4; ++i) { acc[i][0] = (f32x4){0.f, 0.f, 0.f, 0.f}; acc[i][1] = (f32x4){0.f, 0.f, 0.f, 0.f}; }
#pragma unroll
    for (int kb = 0; kb < 2; ++kb) {
        bf16x8 bf[2];
#pragma unroll
        for (int v2 = 0; v2 < 2; ++v2) bf[v2] = *(const bf16x8*)(VT + tsc((wave * 2 + v2) * 16 + r16, kb * 4 + quad));
#pragma unroll
        for (int ib = 0; ib < 4; ++ib) { const bf16x8 af = *(const bf16x8*)(PB + (ib * 16 + r16) * PV + kb * 32 + quad * 8);
            acc[ib][0] = mfma16(af, bf[0], acc[ib][0]); acc[ib][1] = mfma16(af, bf[1], acc[ib][1]); }
    }
#pragma unroll
    for (int kb = 0; kb < 4; ++kb) {
#pragma unroll
        for (int ib = 0; ib < 4; ++ib) { const bf16x8 af = *(const bf16x8*)(QD + (ib * 16 + r16) * PQ + kb * 32 + quad * 8);
            acc[ib][0] = mfma16(af, bfk[kb][0], acc[ib][0]); acc[ib][1] = mfma16(af, bfk[kb][1], acc[ib][1]); }
    }
#pragma unroll
    for (int ib = 0; ib < 4; ++ib)
#pragma unroll
        for (int v2 = 0; v2 < 2; ++v2)
#pragma unroll
            for (int i = 0; i < 4; ++i) OB[(ib * 16 + quad * 4 + i) * POB + (wave * 2 + v2) * 16 + r16] = acc[ib][v2][i];
    __syncthreads();
    {
        const float* gn = a.in[I_GNORM] + (size_t)l * 1024 + h * 256 + lane * 4;
        const f32x4 gain = *(const f32x4*)gn;
#pragma unroll
        for (int rr = 0; rr < 8; ++rr) {
            const int i = wave * 8 + rr;
            const f32x4 v = *(const f32x4*)(OB + i * POB + lane * 4);
            const float ss = wave_sum(v[0] * v[0] + v[1] * v[1] + v[2] * v[2] + v[3] * v[3]);
            const float rinv = rsqrtf(ss * (1.f / 256.f) + EPS);
            const u32x2 rv = rv8[rr];
            const float r0 = bflo(rv.x), r1 = bfhi(rv.x), r2 = bflo(rv.y), r3 = bfhi(rv.y);
            u32x2 o; o.x = pk2(v[0] * rinv * gain[0] * r0 * sigmoid_f(r0), v[1] * rinv * gain[1] * r1 * sigmoid_f(r1));
            o.y = pk2(v[2] * rinv * gain[2] * r2 * sigmoid_f(r2), v[3] * rinv * gain[3] * r3 * sigmoid_f(r3));
            *(u32x2*)(Y + (size_t)(t0 + i) * DM + YC_GLA + h * 256 + lane * 4) = o;
        }
    }
    __syncthreads();
}

__device__ __forceinline__ void ssm_end_unit(const Args& a, int unit) {
    const int tid = otid(), lane = tid & 63, wave = tid >> 6, r16 = lane & 15, quad = lane >> 4;
    const int g = unit >> 2, rb = unit & 3;
    const bf16_t* XS = (const bf16_t*)(a.ws + WS_XS); const bf16_t* MET = (const bf16_t*)(a.ws + WS_MET); float* E = (float*)(a.ws + WS_E);
    const int crow = rb * 64 + (wave & 3) * 16, qg = (wave >> 2) * 64;
    const int ch = (quad & 1) * 8, jo = quad >> 1;
    f32x4 acc[4];
#pragma unroll
    for (int i = 0; i < 4; ++i) acc[i] = (f32x4){0.f, 0.f, 0.f, 0.f};
    const bf16_t* ap = XS + ((size_t)g * T + (crow + r16) * 64 + jo) * 16 + ch;
    const bf16_t* bp = MET + ((size_t)(g * 128 + qg + r16) * 64 + jo) * 16 + ch;
#pragma unroll 4
    for (int kb = 0; kb < 32; ++kb) {
        const bf16x8 af = *(const bf16x8*)(ap + (size_t)kb * 2 * 16);
#pragma unroll
        for (int nb = 0; nb < 4; ++nb) acc[nb] = mfma16(af, *(const bf16x8*)(bp + (size_t)nb * 16 * 1024 + kb * 32), acc[nb]);
    }
#pragma unroll
    for (int nb = 0; nb < 4; ++nb)
#pragma unroll
        for (int i = 0; i < 4; ++i) E[((size_t)(crow + quad * 4 + i) * 32 + g) * 128 + qg + nb * 16 + r16] = acc[nb][i];
}
__device__ __forceinline__ void ssm_scan(const Args& a, int id) {
    const int b = id >> 11, g = (id >> 6) & 31, p = id & 63;
    const float* E = (const float*)(a.ws + WS_E); bf16_t* HC = (bf16_t*)(a.ws + WS_HC); const float* L64 = (const float*)(a.ws + WS_L64);
    const float lr = L64[(g * 64 + p) * 2], li = L64[(g * 64 + p) * 2 + 1];
    float hr = 0.f, hi = 0.f;
#pragma unroll 8
    for (int n = 0; n < 64; ++n) {
        const size_t base = ((size_t)(b * 64 + n) * 32 + g) * 128;
        HC[base + p] = (bf16_t)f2bf(hr); HC[base + 64 + p] = (bf16_t)f2bf(hi);
        const float er = E[base + p], ei = E[base + 64 + p];
        const float nr = lr * hr - li * hi + er, ni = lr * hi + li * hr + ei;
        hr = nr; hi = ni;
    }
}
__device__ __forceinline__ void ssm_out_unit(const Args& a, int unit) {
    const int tid = otid(), lane = tid & 63, wave = tid >> 6, r16 = lane & 15, quad = lane >> 4;
    const int g = unit >> 4, cb = unit & 15;
    const bf16_t* XS = (const bf16_t*)(a.ws + WS_XS); const bf16_t* KT = (const bf16_t*)(a.ws + WS_KT); const bf16_t* MCT = (const bf16_t*)(a.ws + WS_MCT);
    const bf16_t* HC = (const bf16_t*)(a.ws + WS_HC); bf16_t* YS = (bf16_t*)(a.ws + WS_YS);
    const int ch = (quad & 1) * 8, jo = quad >> 1;
    f32x4 acc[2][4];
#pragma unroll
    for (int i = 0; i < 2; ++i)
#pragma unroll
        for (int k = 0; k < 4; ++k) acc[i][k] = (f32x4){0.f, 0.f, 0.f, 0.f};
    const int kbn = cb * 2 + 2;
    const bf16x8 zero8 = (bf16x8){0, 0, 0, 0, 0, 0, 0, 0};
    for (int kb0 = 0; kb0 < kbn; kb0 += 4) {
        bf16x8 af[4][2], bf[4][4];
#pragma unroll
        for (int u = 0; u < 4; ++u) {
            const int kb = kb0 + u, jp = kb * 2 + jo; const bool on = kb < kbn;
#pragma unroll
            for (int rk = 0; rk < 2; ++rk) af[u][rk] = on ? *(const bf16x8*)(XS + ((size_t)g * T + (wave * 32 + rk * 16 + r16) * 64 + jp) * 16 + ch) : zero8;
#pragma unroll
            for (int nb = 0; nb < 4; ++nb) { const int dl = cb * 4 + nb - jp; bf[u][nb] = (on && dl >= 0) ? *(const bf16x8*)(KT + ((size_t)(g * 64 + dl) * 16 + r16) * 16 + ch) : zero8; }
        }
#pragma unroll
        for (int u = 0; u < 4; ++u)
#pragma unroll
            for (int nb = 0; nb < 4; ++nb) { acc[0][nb] = mfma16(af[u][0], bf[u][nb], acc[0][nb]); acc[1][nb] = mfma16(af[u][1], bf[u][nb], acc[1][nb]); }
    }
#pragma unroll
    for (int kb = 0; kb < 4; ++kb) {
        bf16x8 af[2];
#pragma unroll
        for (int rk = 0; rk < 2; ++rk) af[rk] = *(const bf16x8*)(HC + ((size_t)(wave * 32 + rk * 16 + r16) * 32 + g) * 128 + kb * 32 + quad * 8);
#pragma unroll
        for (int nb = 0; nb < 4; ++nb) { const bf16x8 bf = *(const bf16x8*)(MCT + ((size_t)g * 1024 + (cb * 4 + nb) * 16 + r16) * 128 + kb * 32 + quad * 8);
            acc[0][nb] = mfma16(af[0], bf, acc[0][nb]); acc[1][nb] = mfma16(af[1], bf, acc[1][nb]); }
    }
#pragma unroll
    for (int rk = 0; rk < 2; ++rk)
#pragma unroll
        for (int nb = 0; nb < 4; ++nb)
#pragma unroll
            for (int i = 0; i < 4; ++i) { const int chunk = wave * 32 + rk * 16 + quad * 4 + i, t = chunk * 64 + cb * 4 + nb;
                YS[(size_t)t * 512 + g * 16 + r16] = (bf16_t)f2bf(gelu_tanh_f(acc[rk][nb][i])); }
}

__device__ __forceinline__ void phase_final(const Args& a, int G) {
    const int tid = otid(), lane = tid & 63, wave = tid >> 6;
    const int gw = blockIdx.x * 8 + wave, NGW = G * 8;
    const unsigned long long* rss = (const unsigned long long*)(a.ws + WS_RSS) + (size_t)6 * T; const float* gf = a.in[I_FINN];
    for (int row = gw; row < T; row += NGW) {
        const float rinv = rsqrtf((float)rss[row] * (1.f / (16777216.f * DM)) + EPS);
        f32x4* xr = (f32x4*)(a.out + (size_t)row * DM) + lane; const f32x4* gr = (const f32x4*)gf + lane;
#pragma unroll
        for (int i = 0; i < 8; ++i) { f32x4 v = xr[64 * i]; const f32x4 gg = gr[64 * i]; v = v * rinv * gg; xr[64 * i] = v; }
    }
}


#define XB_TMO      128
#define XB_XCNT(j)  (256  + 64 * (j))
#define XB_XSUB(j)  (1280 + 64 * (j))
#define XB_XGEN(j)  (2304 + 64 * (j))
#define XB_TOP      3328
#define XB_TOPGEN   3392
#define XCD_BAR_WORDS 3456
#define XB_SPIN_CAP (1u << 18)
__device__ __forceinline__ unsigned xb_ld(unsigned* p)              { return __hip_atomic_load(p, __ATOMIC_RELAXED, __HIP_MEMORY_SCOPE_AGENT); }
__device__ __forceinline__ unsigned xb_add(unsigned* p, unsigned v) { return __hip_atomic_fetch_add(p, v, __ATOMIC_RELAXED, __HIP_MEMORY_SCOPE_AGENT); }
__device__ __forceinline__ unsigned xb_xcc_id() { return (unsigned)__builtin_amdgcn_s_getreg((3 << 11) | 20) & 0xFu; }
#define XB_SPIN(cond, bar) do { unsigned _sp = 0; while (cond) { __builtin_amdgcn_s_sleep(1); \
    if ((++_sp & 255u) == 0u) { if (xb_ld(&(bar)[XB_TMO])) break; if (_sp > XB_SPIN_CAP) { atomicAdd(&(bar)[XB_TMO], 1u); break; } } } } while (0)
struct XcdBarrier { unsigned* bar; unsigned x; volatile LAS unsigned* st; };
__device__ __forceinline__ XcdBarrier xcd_barrier_post(unsigned* bar, volatile LAS unsigned* st) {
    XcdBarrier b; b.bar = bar; b.x = xb_xcc_id(); b.st = st;
    if (threadIdx.x == 0) (void)xb_add(&bar[XB_XCNT(b.x)], 1u);
    return b;
}
__device__ __forceinline__ void xcd_barrier_complete(unsigned* bar, unsigned x, unsigned& nloc, unsigned& nx) {
    const unsigned G = gridDim.x * gridDim.y * gridDim.z;
    unsigned sum, cnt, mine, sp = 0u;
    for (;;) {
        sum = 0u; cnt = 0u; mine = 0u;
#pragma unroll
        for (unsigned j = 0; j < 16; ++j) { const unsigned c = xb_ld(&bar[XB_XCNT(j)]); sum += c; cnt += (c > 0u) ? 1u : 0u; mine = (j == x) ? c : mine; }
        if (sum == G) break;
        __builtin_amdgcn_s_sleep(1);
        if ((++sp & 255u) == 0u) { if (xb_ld(&bar[XB_TMO])) break; if (sp > XB_SPIN_CAP) { atomicAdd(&bar[XB_TMO], 1u); break; } }
    }
    nloc = mine > 0u ? mine : 1u; nx = cnt > 0u ? cnt : 1u;
}
__device__ __forceinline__ void xcd_barrier(const XcdBarrier& b) {
    asm volatile("s_waitcnt vmcnt(0)" ::: "memory");
    __syncthreads();
    if (threadIdx.x == 0) {
        unsigned* bar = b.bar;
        __builtin_amdgcn_s_waitcnt(0);
        unsigned nloc = b.st[0], nx = b.st[1];
        if (nloc == 0u) { xcd_barrier_complete(bar, b.x, nloc, nx); b.st[0] = nloc; b.st[1] = nx; }
        const unsigned old = xb_add(&bar[XB_XSUB(b.x)], 1u);
        const unsigned gen = old / nloc;
        if (old + 1u == (gen + 1u) * nloc) {
            __builtin_amdgcn_fence(__ATOMIC_RELEASE, "agent");
            asm volatile("s_waitcnt vmcnt(0)" ::: "memory");
            const unsigned og = xb_add(&bar[XB_TOP], 1u);
            const unsigned tg = og / nx;
            if (og + 1u == (tg + 1u) * nx) xb_add(&bar[XB_TOPGEN], 1u);
            else XB_SPIN(xb_ld(&bar[XB_TOPGEN]) == tg, bar);
            __builtin_amdgcn_fence(__ATOMIC_ACQUIRE, "agent");
            xb_add(&bar[XB_XGEN(b.x)], 1u);
            asm volatile("s_waitcnt vmcnt(0)" ::: "memory");
        } else {
            XB_SPIN(xb_ld(&bar[XB_XGEN(b.x)]) == gen, bar);
            __builtin_amdgcn_fence(__ATOMIC_ACQUIRE, "agent");
            asm volatile("s_waitcnt vmcnt(0)" ::: "memory");
        }
    }
    __syncthreads();
}

constexpr int PH_PER_LAYER = 12, N_PHASES = 2 * PH_PER_LAYER + 1;

__global__ void __launch_bounds__(512, 2) mega_fwd(Args a) {
    extern __shared__ __attribute__((aligned(16))) unsigned char lds[];
    cg::grid_group grid = cg::this_grid();
    constexpr int G = 256;
    unsigned char* ws = a.ws;
    LAS unsigned char* ldsl = (LAS unsigned char*)lds;
    unsigned long long* rssb = (unsigned long long*)(ws + WS_RSS);
    volatile LAS unsigned* bst = (volatile LAS unsigned*)(ldsl + (LDS_BYTES - 64));
    if (threadIdx.x < 2) bst[threadIdx.x] = 0u;
    __syncthreads();
    XcdBarrier bar = xcd_barrier_post((unsigned*)(ws + WS_BAR), bst);
#if !MK_MULTI_LAUNCH
    if (a.ph_hi - a.ph_lo > 1) grid.sync();
#endif
    for (int ph = a.ph_lo; ph < a.ph_hi; ++ph) {
        if (ph != a.ph_lo) {
            xcd_barrier(bar);
#ifdef PROBE_SYNC
            for (int q = 0; q < 4; ++q) xcd_barrier(bar);
#endif
        }
        if (ph == N_PHASES - 1) { phase_final(a, G); continue; }
        const int l = ph / PH_PER_LAYER, k = ph % PH_PER_LAYER;
#ifdef PROBE_K
        for (int rep = 0; rep < ((k == PROBE_K) ? 2 : 1); ++rep) {
        if (rep) xcd_barrier(bar);
#endif
        if (k == 0) {
#ifndef NO_PREP
            phase_prep(a, l, lds, G);
#endif
        } else if (k == 1 || k == 10) {
            const int second = (k == 10);
            pg8::Gemm g{(const bf16_t*)(ws + WS_XB), (const bf16_t*)(ws + (second ? WS_W2U : WS_W1U)), T, 2 * FF, DM, DM, DM};
            pg8::StaticOrder S; S.init(T, 2 * FF, G, (int)blockIdx.x);
            pg8::EpiFfnUp E{(bf16_t*)(ws + WS_Z), rssb + (size_t)(3 * l + (second ? 2 : 0)) * T};
            pg8::gemm_phase(ldsl, g, S, E);
        } else if (k == 2 || k == 11) {
            const int second = (k == 11);
            pg8::Gemm g{(const bf16_t*)(ws + WS_Z), (const bf16_t*)(ws + (second ? WS_W2D : WS_W1D)), T, DM, FF, FF, FF};
            pg8::StaticOrder S; S.init(T, DM, G, (int)blockIdx.x);
            const float* xin = (l == 0 && !second) ? a.in[I_X] : a.out;
            pg8::EpiResid E{xin, a.out, (bf16_t*)(ws + WS_XB), rssb + (size_t)(3 * l + (second ? 3 : 1)) * T, 0.5f};
            pg8::gemm_phase(ldsl, g, S, E);
        } else if (k == 3) {
            pg8::Gemm g{(const bf16_t*)(ws + WS_XB), (const bf16_t*)(ws + WS_WIN), T, ZW, DM, DM, DM};
            pg8::StaticOrder S; S.init(T, ZW, G, (int)blockIdx.x);
            pg8::EpiWin E{(bf16_t*)(ws + WS_Z), rssb + (size_t)(3 * l + 1) * T, (bf16_t*)(ws + WS_XS)};
            pg8::gemm_phase(ldsl, g, S, E);
#ifndef NO_GLR
            phase_glr(a, rssb + (size_t)(3 * l + 1) * T, G);
#endif
        } else if (k == 4) {
#ifndef NO_GLA
            for (int u = blockIdx.x; u < 1024; u += G) gla_kv_unit(a, l, lds, u);
#ifdef PROBE_GLA1
            for (int u = blockIdx.x; u < 1024; u += G) gla_kv_unit(a, l, lds, u);
#endif
#endif
#ifndef NO_SSM
            for (int u = G - 1 - (int)blockIdx.x; u < 128; u += G) ssm_end_unit(a, u);
#endif
#ifndef NO_POOL
            phase_pool(a, G);
#endif
        } else if (k == 5) {
#ifndef NO_GLA
            gla_scan(a, G);
#endif
#ifndef NO_SSM
            { const int id = (G - 1 - (int)blockIdx.x) * 512 + otid(); if (id < 8192) ssm_scan(a, id); }
#endif
        } else if (k == 6) {
#ifndef NO_GLA
            for (int u = blockIdx.x; u < 1024; u += G) gla_out_unit(a, l, lds, u);
#ifdef PROBE_GLA3
            for (int u = blockIdx.x; u < 1024; u += G) gla_out_unit(a, l, lds, u);
#endif
#endif
#ifndef NO_SSM
            ssm_out_unit(a, (int)blockIdx.x); ssm_out_unit(a, 256 + ((int)blockIdx.x ^ 15));
#ifdef PROBE_SSM3
            for (int u = blockIdx.x; u < 512; u += G) ssm_out_unit(a, u);
#endif
#endif
        } else if (k == 7) {
            pg8::Gemm g{(const bf16_t*)(ws + WS_YS), (const bf16_t*)(ws + WS_WGLU), T, 512, 512, 512, 512};
            pg8::StaticOrder S; S.init(T, 512, G, (int)blockIdx.x);
            pg8::EpiGlu E{(const bf16_t*)(ws + WS_YS), (bf16_t*)(ws + WS_Y)};
            pg8::gemm_phase(ldsl, g, S, E);
        } else if (k == 8) {
            const bf16_t* Y = (const bf16_t*)(ws + WS_Y); const bf16_t* Wb = (const bf16_t*)(ws + WS_WBR); const bf16_t* Zg = (const bf16_t*)(ws + WS_Z) + ZC_G;
            pg8::BranchOrder S; S.init(T, DM, G, (int)blockIdx.x);
            pg8::Gemm g{Y, Wb, T, DM, DM, DM, DM}; pg8::EpiBranch E{Zg, (bf16_t*)(ws + WS_MB)};
            pg8::gemm_phase(ldsl, g, S, E);
        } else if (k == 9) {
            pg8::Gemm g{(const bf16_t*)(ws + WS_MB), (const bf16_t*)(ws + WS_WO), T, DM, DM, DM, DM};
            pg8::StaticOrder S; S.init(T, DM, G, (int)blockIdx.x);
            pg8::EpiResid E{a.out, a.out, (bf16_t*)(ws + WS_XB), rssb + (size_t)(3 * l + 2) * T, 1.0f};
            pg8::gemm_phase(ldsl, g, S, E);
        }
#ifdef PROBE_K
        }
#endif
    }
}

extern "C" void kernel_launch(void* const* d_in, const int* in_sizes, int n_in, void* d_out, int out_size, void* d_ws, size_t ws_size, hipStream_t stream) {
    static int grid = 0;
    if (grid == 0) {
        if (n_in != 28 || in_sizes[0] != T * DM || out_size != T * DM || ws_size < WS_END) {
            fprintf(stderr, "kernel_launch: unexpected problem (n_in %d, in0 %d, out %d, ws %zu, need %zu)\n", n_in, n_in > 0 ? in_sizes[0] : -1, out_size, ws_size, (size_t)WS_END);
            grid = -1; return;
        }
        int dev = 0, cus = 0, per_cu = 0;
        hipGetDevice(&dev);
        hipDeviceGetAttribute(&cus, hipDeviceAttributeMultiprocessorCount, dev);
        hipFuncSetAttribute((const void*)mega_fwd, hipFuncAttributeMaxDynamicSharedMemorySize, LDS_BYTES);
        hipOccupancyMaxActiveBlocksPerMultiprocessor(&per_cu, (const void*)mega_fwd, 512, LDS_BYTES);
        if (per_cu < 1) per_cu = 1;
        if (per_cu > 1) per_cu = 1;
        grid = 256;
        if (cus * per_cu < 256) { fprintf(stderr, "kernel_launch: needs 256 co-resident workgroups (have %d x %d)\n", cus, per_cu); grid = -1; return; }
        (void)hipGetLastError();
    }
    if (grid < 0) return;
    Args a{};
    for (int i = 0; i < 28; ++i) a.in[i] = (const float*)d_in[i];
    a.out = (float*)d_out; a.ws = (unsigned char*)d_ws;
    (void)hipMemsetAsync((char*)d_ws + WS_BAR, 0, 16384, stream);
#if MK_MULTI_LAUNCH
    for (int ph = 0; ph < N_PHASES; ++ph) {
        a.ph_lo = ph; a.ph_hi = ph + 1;
        hipLaunchKernelGGL(mega_fwd, dim3(grid), dim3(512), LDS_BYTES, stream, a);
    }
#else
    a.ph_lo = 0; a.ph_hi = N_PHASES;
    void* args[] = {&a};
    hipError_t e = hipLaunchCooperativeKernel((const void*)mega_fwd, dim3(grid), dim3(512), args, LDS_BYTES, stream);
    if (e != hipSuccess) fprintf(stderr, "cooperative launch failed: %s (grid %d)\n", hipGetErrorString(e), grid);
#endif
}
```

```cpp
#include <hip/hip_runtime.h>
#include <hip/hip_cooperative_groups.h>
#include <cstdio>
#include <cstdint>
namespace cg = cooperative_groups;

#ifndef MK_MULTI_LAUNCH
#define MK_MULTI_LAUNCH 0
#endif

#define LAS __attribute__((address_space(3)))
typedef unsigned short bf16_t;
typedef short bf16x8 __attribute__((ext_vector_type(8)));
typedef float f32x4 __attribute__((ext_vector_type(4)));
typedef unsigned u32x4 __attribute__((ext_vector_type(4)));
typedef unsigned u32x2 __attribute__((ext_vector_type(2)));

constexpr int T = 16384, DM = 2048, FF = 5632, SEQ = 4096;
constexpr int ZW = 10240;
constexpr int ZC_POOL = 0, ZC_Q = 512, ZC_K = 1024, ZC_V = 1536, ZC_R = 2560, ZC_S = 3584, ZC_G = 4096;
constexpr int YC_GLA = 512, YC_SSM = 1536;
constexpr int INW = 10256;
constexpr float EPS = 1e-6f;

constexpr size_t MiB = 1u << 20;
constexpr size_t WS_RSS = 0;
constexpr size_t WS_BAR = 917504;
constexpr size_t WS_WGT = 1 * MiB;
constexpr size_t WS_L64 = 1 * MiB + 131072;
constexpr size_t WS_GLR = 2 * MiB;
constexpr size_t WS_DEC = 3 * MiB;
constexpr size_t WS_KT = 4 * MiB;
constexpr size_t WS_E = 5 * MiB;
constexpr size_t WS_HC = 9 * MiB;
constexpr size_t WS_MET = 11 * MiB;
constexpr size_t WS_MCT = 19 * MiB;
constexpr size_t WS_YS = 27 * MiB;
constexpr size_t WS_W1U = 43 * MiB, WS_W1D = 87 * MiB, WS_WIN = 109 * MiB, WS_WBR = 149 * MiB, WS_WO = 157 * MiB, WS_WGLU = 165 * MiB;
constexpr size_t WS_W2U = 166 * MiB, WS_W2D = 210 * MiB;
constexpr size_t WS_XB = 232 * MiB, WS_Y = 296 * MiB, WS_MB = 360 * MiB, WS_KV = 424 * MiB, WS_Z = 488 * MiB, WS_BCG = 808 * MiB, WS_XS = 840 * MiB, WS_END = 856 * MiB;

constexpr int LDS_BYTES = 147456;

typedef __bf16 bf16v2_t __attribute__((ext_vector_type(2)));
typedef float f32v2_t __attribute__((ext_vector_type(2)));
__device__ __forceinline__ unsigned pk2(float lo, float hi) { const f32v2_t v = {lo, hi}; const bf16v2_t b = __builtin_convertvector(v, bf16v2_t); return __builtin_bit_cast(unsigned, b); }
__device__ __forceinline__ unsigned f2bf(float f) { return pk2(f, 0.f) & 0xffffu; }
__device__ __forceinline__ float bf2f(unsigned short b) { return __uint_as_float(((unsigned)b) << 16); }
__device__ __forceinline__ float bflo(unsigned w) { return __uint_as_float(w << 16); }
__device__ __forceinline__ float bfhi(unsigned w) { return __uint_as_float(w & 0xffff0000u); }
__device__ __forceinline__ float wave_sum(float v) {
#pragma unroll
    for (int o = 1; o < 64; o <<= 1) v += __shfl_xor(v, o);
    return v;
}
__device__ __forceinline__ float sigmoid_f(float x) { return __builtin_amdgcn_rcpf(1.f + __expf(-x)); }
__device__ __forceinline__ float gelu_tanh_f(float x) {
    const float u = 0.7978845608028654f * (x + 0.044715f * x * x * x);
    const float t = 1.f - 2.f * __builtin_amdgcn_rcpf(1.f + __expf(2.f * u));
    return 0.5f * x * (1.f + t);
}
#define LDS_WAIT() asm volatile("s_waitcnt lgkmcnt(0)" ::: "memory")
__device__ __forceinline__ int otid() { int t = threadIdx.x; asm volatile("" : "+v"(t)); return t; }
__device__ __forceinline__ f32x4 mfma16(bf16x8 a, bf16x8 b, f32x4 c) { return __builtin_amdgcn_mfma_f32_16x16x32_bf16(a, b, c, 0, 0, 0); }

#ifndef PG8_AUX
#define PG8_AUX 0
#endif
#ifndef PG8_WGM
#define PG8_WGM 4
#endif
#ifndef NO_NT_OUT
#define ST_OUT(p, v) __builtin_nontemporal_store((v), (p))
#else
#define ST_OUT(p, v) (*(p) = (v))
#endif
#ifdef NT_OUT2
#define ST_OUT2(p, v) __builtin_nontemporal_store((v), (p))
#else
#define ST_OUT2(p, v) (*(p) = (v))
#endif
namespace pg8 {
constexpr int BM = 256, BK = 64, HALF = 128, HTB = HALF * BK * 2, STAGE_BYTES = 8 * HTB, NXCD = 8, WGM = PG8_WGM;
__host__ __device__ __forceinline__ int lds_byte(int r, int c) { const int st = (r >> 4) * 2 + (c >> 5), rr = r & 15, cc = c & 31, ob = rr * 64 + cc * 2; return st * 1024 + (ob ^ (((ob >> 9) & 1) << 5)); }
__host__ __device__ __forceinline__ void stage_rc(int b, int& R, int& C) { const int st = b / 1024, sb = b % 1024, swz = sb ^ (((sb >> 9) & 1) << 5); R = (st >> 1) * 16 + swz / 64; C = (st & 1) * 32 + (swz % 64) / 2; }
__host__ __device__ __forceinline__ int perm32(int rho) { const int n = rho >> 4, i = rho & 15; return 8 * (i >> 2) + 4 * n + (i & 3); }

struct Unit { int pm, pn, seg; };
struct Gemm { const bf16_t* A; const bf16_t* Bt; int M, N, K, lda, ldb; };

struct StaticOrder {
    static constexpr bool SEGMENTED = false;
    int nM, nN, nwg, G, c;
    __device__ __forceinline__ int koff(const Unit&) const { return 0; }
    __device__ __forceinline__ int nt(const Unit&) const { return 0; }
    __device__ void init(int M, int N, int G_, int c_) { nM = M / BM; nN = N / BM; nwg = nM * nN; G = G_; c = c_; }
    __device__ bool next(int i, Unit& u) const {
        const long L = (long)i * G + c; if (L >= nwg) return false;
        int wgid = (int)L; { const int q = nwg / NXCD, r = nwg % NXCD, xcd = wgid % NXCD, off = wgid / NXCD; wgid = (xcd < r ? xcd * (q + 1) : r * (q + 1) + (xcd - r) * q) + off; }
        const int nig = WGM * nN, gid = wgid / nig, fm = gid * WGM, gsz = (nM - fm) < WGM ? (nM - fm) : WGM;
        u.pm = fm + ((wgid % nig) % gsz); u.pn = (wgid % nig) / gsz; u.seg = 0; return true;
    }
};
struct BranchOrder : StaticOrder {
    static constexpr bool SEGMENTED = true;
    __device__ bool next(int i, Unit& u) const { const bool ok = StaticOrder::next(i / 3, u); u.seg = i % 3; return ok; }
    __device__ __forceinline__ int koff(const Unit& u) const { return u.seg == 0 ? 0 : (u.seg == 1 ? 512 : 1536); }
    __device__ __forceinline__ int nt(const Unit& u) const { return u.seg == 1 ? 16 : 8; }
};

template <class Epi, class Sched>
__device__ __forceinline__ void gemm_phase(LAS unsigned char* lds, const Gemm g, const Sched& S, const Epi& E) {
    const int tid = otid(), wid = __builtin_amdgcn_readfirstlane(tid >> 6), lane = tid & 63, wr = wid >> 2, wc = wid & 3, fr = lane & 15, fq = lane >> 4;
    unsigned voffA[2], voffB[2];
#pragma unroll
    for (int i = 0; i < 2; ++i) { int R, C; stage_rc(tid * 16 + i * 8192, R, C); const int Rb = (R & ~31) + perm32(R & 31);
        voffA[i] = (unsigned)(R * g.lda + C) * 2u; voffB[i] = (unsigned)(Rb * g.ldb + C) * 2u; }
    const size_t kstep = (size_t)(BK * 2);
    const size_t hstepA = (size_t)HALF * g.lda * 2, hstepB = (size_t)HALF * g.ldb * 2;
    const size_t tstepA = 2 * hstepA, tstepB = 2 * hstepB;
    const unsigned ldsw = (unsigned)wid * 1024u;
    const int aoff = lds_byte(wr * 64 + fr, fq * 8), boff = lds_byte(wc * 32 + fr, fq * 8);
#define PG8_SA(b, h) (((b) * 2 + (h)) * HTB)
#define PG8_SB(b, h) ((4 + (b) * 2 + (h)) * HTB)
#define PG8_STAGE(bufoff, gbase, voff) do { _Pragma("unroll") for (int _i = 0; _i < 2; ++_i) \
        __builtin_amdgcn_global_load_lds((const unsigned*)((const char*)(gbase) + (voff)[_i]), (LAS unsigned*)(lds + (bufoff) + ldsw + _i * 8192), 16, 0, PG8_AUX); } while (0)
#define PG8_LDA(dst, b, h) do { _Pragma("unroll") for (int m = 0; m < 4; ++m) _Pragma("unroll") for (int k = 0; k < 2; ++k) dst[m][k] = *(const LAS bf16x8*)(lds + PG8_SA(b, h) + aoff + m * 2048 + k * 1024); } while (0)
#define PG8_LDB(dst, b, h) do { _Pragma("unroll") for (int n = 0; n < 2; ++n) _Pragma("unroll") for (int k = 0; k < 2; ++k) dst[n][k] = *(const LAS bf16x8*)(lds + PG8_SB(b, h) + boff + n * 2048 + k * 1024); } while (0)
#define PG8_MMA(ai, bj, At, Bt) do { __builtin_amdgcn_s_setprio(1); _Pragma("unroll") for (int m = 0; m < 4; ++m) _Pragma("unroll") for (int n = 0; n < 2; ++n) _Pragma("unroll") for (int k = 0; k < 2; ++k) \
        acc[ai][bj][m][n] = __builtin_amdgcn_mfma_f32_16x16x32_bf16(Bt[n][k], At[m][k], acc[ai][bj][m][n], 0, 0, 0); __builtin_amdgcn_s_setprio(0); } while (0)
#define PG8_WAIT_V(n) asm volatile("s_waitcnt vmcnt(" #n ")" ::: "memory")
#define PG8_WAIT_L(n) asm volatile("s_waitcnt lgkmcnt(" #n ")" ::: "memory")
#define PG8_BAR __builtin_amdgcn_s_barrier()
#define PG8_SCHED __builtin_amdgcn_sched_barrier(0)
    Unit cur, nxt; int ui = 0;
    if (!S.next(0, cur)) return;
    f32x4 acc[2][2][4][2];
#pragma unroll
    for (int a = 0; a < 2; ++a)
#pragma unroll
        for (int b = 0; b < 2; ++b)
#pragma unroll
            for (int m = 0; m < 4; ++m)
#pragma unroll
                for (int n = 0; n < 2; ++n) acc[a][b][m][n] = (f32x4){0.f, 0.f, 0.f, 0.f};
    bf16x8 At[4][2], B0[2][2], B1[2][2];
    int nt = Sched::SEGMENTED ? S.nt(cur) : g.K / BK;
    const char* cA = (const char*)g.A + (size_t)cur.pm * tstepA + (size_t)S.koff(cur) * 2; const char* cB = (const char*)g.Bt + (size_t)cur.pn * tstepB + (size_t)S.koff(cur) * 2;
    PG8_STAGE(PG8_SB(0, 0), cB, voffB); PG8_STAGE(PG8_SB(0, 1), cB + hstepB, voffB); PG8_STAGE(PG8_SA(0, 0), cA, voffA); PG8_STAGE(PG8_SA(0, 1), cA + hstepA, voffA);
    if (wr == 1) PG8_BAR;
    PG8_WAIT_V(2); PG8_BAR;
    PG8_STAGE(PG8_SB(1, 0), cB + kstep, voffB); PG8_STAGE(PG8_SA(1, 0), cA + kstep, voffA); PG8_STAGE(PG8_SB(1, 1), cB + hstepB + kstep, voffB);
    PG8_WAIT_V(6); PG8_BAR;
    for (;;) {
        const bool has_next = S.next(ui + 1, nxt);
        const char* nA = has_next ? (const char*)g.A + (size_t)nxt.pm * tstepA + (size_t)S.koff(nxt) * 2 : cA; const char* nB = has_next ? (const char*)g.Bt + (size_t)nxt.pn * tstepB + (size_t)S.koff(nxt) * 2 : cB;
        for (int t = 0; t < nt; t += 2) {
            const bool last = (t == nt - 2);
            const char* a1 = cA + (size_t)(t + 1) * kstep;
            const char* a2 = last ? nA : cA + (size_t)(t + 2) * kstep; const char* b2 = last ? nB : cB + (size_t)(t + 2) * kstep;
            const char* a3 = a2 + kstep; const char* b3 = b2 + kstep;
            PG8_LDB(B0, 0, 0); PG8_LDB(B1, 0, 1); PG8_SCHED; PG8_LDA(At, 0, 0); PG8_STAGE(PG8_SA(1, 1), a1 + hstepA, voffA);
            PG8_WAIT_V(8); PG8_WAIT_L(0); PG8_BAR; PG8_MMA(0, 0, At, B0); PG8_MMA(0, 1, At, B1); PG8_BAR; PG8_SCHED;
            PG8_LDA(At, 0, 1); PG8_STAGE(PG8_SB(0, 0), b2, voffB); PG8_STAGE(PG8_SB(0, 1), b2 + hstepB, voffB); PG8_STAGE(PG8_SA(0, 0), a2, voffA);
            PG8_WAIT_V(8); PG8_WAIT_L(0); PG8_BAR; PG8_MMA(1, 0, At, B0); PG8_MMA(1, 1, At, B1); PG8_BAR; PG8_SCHED;
            PG8_LDB(B0, 1, 0); PG8_LDB(B1, 1, 1); PG8_SCHED; PG8_LDA(At, 1, 0); PG8_STAGE(PG8_SA(0, 1), a2 + hstepA, voffA);
            PG8_WAIT_V(8); PG8_WAIT_L(0); PG8_BAR; PG8_MMA(0, 0, At, B0); PG8_MMA(0, 1, At, B1); PG8_BAR; PG8_SCHED;
            PG8_LDA(At, 1, 1); PG8_STAGE(PG8_SB(1, 0), b3, voffB); PG8_STAGE(PG8_SB(1, 1), b3 + hstepB, voffB); PG8_STAGE(PG8_SA(1, 0), a3, voffA);
            PG8_WAIT_V(8); PG8_WAIT_L(0); PG8_BAR; PG8_MMA(1, 0, At, B0); PG8_MMA(1, 1, At, B1); PG8_BAR; PG8_SCHED;
        }
#ifndef NO_ALIGN
        if (wr == 0) PG8_BAR;
#endif
        E(acc, cur, wr, wc, fr, fq);
        if (!has_next) break;
#pragma unroll
        for (int a = 0; a < 2; ++a)
#pragma unroll
            for (int b = 0; b < 2; ++b)
#pragma unroll
                for (int m = 0; m < 4; ++m)
#pragma unroll
                    for (int n = 0; n < 2; ++n) acc[a][b][m][n] = (f32x4){0.f, 0.f, 0.f, 0.f};
        cur = nxt; cA = nA; cB = nB; ++ui;
        if (Sched::SEGMENTED) nt = S.nt(cur);
#ifndef NO_ALIGN
        if (wr == 1) PG8_BAR;
#endif
    }
    PG8_WAIT_V(0);
#ifdef NO_ALIGN
    if (wr == 0) PG8_BAR;
#endif
    PG8_BAR;
#undef PG8_SA
#undef PG8_SB
#undef PG8_STAGE
#undef PG8_LDA
#undef PG8_LDB
#undef PG8_MMA
#undef PG8_WAIT_V
#undef PG8_WAIT_L
#undef PG8_BAR
#undef PG8_SCHED
}

typedef const f32x4 (&AccRef)[2][2][4][2];

struct EpiFfnUp {
    bf16_t* H; const unsigned long long* rss;
    __device__ __forceinline__ void operator()(AccRef acc, const Unit& u, int wr, int wc, int fr, int fq) const {
        const int row0 = u.pm * BM + wr * 64 + fr, col0 = u.pn * 128 + wc * 32 + 8 * fq;
#pragma unroll
        for (int ai = 0; ai < 2; ++ai)
#pragma unroll
            for (int m = 0; m < 4; ++m) {
                const int row = row0 + ai * HALF + m * 16;
                const float rinv = rsqrtf((float)rss[row] * (1.f / (16777216.f * DM)) + EPS);
                float h[8];
#pragma unroll
                for (int n = 0; n < 2; ++n)
#pragma unroll
                    for (int j = 0; j < 4; ++j) { const float gg = acc[ai][0][m][n][j] * rinv, uu = acc[ai][1][m][n][j] * rinv; h[n * 4 + j] = gg * uu * sigmoid_f(gg); }
                u32x4 o; o.x = pk2(h[0], h[1]); o.y = pk2(h[2], h[3]); o.z = pk2(h[4], h[5]); o.w = pk2(h[6], h[7]);
                ST_OUT((u32x4*)(H + (size_t)row * FF + col0), o);
            }
    }
};
struct EpiWin {
    bf16_t* Z; const unsigned long long* rss; bf16_t* XS;
    __device__ __forceinline__ void operator()(AccRef acc, const Unit& u, int wr, int wc, int fr, int fq) const {
        const int row0 = u.pm * BM + wr * 64 + fr, col0 = u.pn * BM + wc * 32 + 8 * fq;
        const bool sg = u.pn >= 16;
        const bool ssm = (u.pn == 14) | (u.pn == 15);
        const int cs = col0 - ZC_S;
        bf16_t* const dst = ssm ? XS + (size_t)(cs >> 4) * T * 16 + (cs & 15) : Z + col0; const size_t pitch = ssm ? 16 : ZW; const size_t bjstep = ssm ? (size_t)8 * T * 16 : (size_t)HALF;
#pragma unroll
        for (int ai = 0; ai < 2; ++ai)
#pragma unroll
            for (int m = 0; m < 4; ++m) {
                const int row = row0 + ai * HALF + m * 16;
                const float rinv = rsqrtf((float)rss[row] * (1.f / (16777216.f * DM)) + EPS);
#pragma unroll
                for (int bj = 0; bj < 2; ++bj) {
                    float h[8];
#pragma unroll
                    for (int n = 0; n < 2; ++n)
#pragma unroll
                        for (int j = 0; j < 4; ++j) { const float v = acc[ai][bj][m][n][j] * rinv; h[n * 4 + j] = sg ? sigmoid_f(v) : v; }
                    u32x4 o; o.x = pk2(h[0], h[1]); o.y = pk2(h[2], h[3]); o.z = pk2(h[4], h[5]); o.w = pk2(h[6], h[7]);
                    ST_OUT((u32x4*)(dst + (size_t)row * pitch + bj * bjstep), o);
                }
            }
    }
};
struct EpiResid {
    const float* xin; float* xout; bf16_t* XB; unsigned long long* rssn; float scale;
    __device__ __forceinline__ void operator()(AccRef acc, const Unit& u, int wr, int wc, int fr, int fq) const {
        const int row0 = u.pm * BM + wr * 64 + fr, col0 = u.pn * BM + wc * 32 + 8 * fq;
#pragma unroll
        for (int ai = 0; ai < 2; ++ai)
#pragma unroll
            for (int m = 0; m < 4; ++m) {
                const int row = row0 + ai * HALF + m * 16;
                float ss = 0.f;
#pragma unroll
                for (int bj = 0; bj < 2; ++bj) {
                    const size_t off = (size_t)row * DM + col0 + bj * HALF;
                    f32x4 x0 = *(const f32x4*)(xin + off), x1 = *(const f32x4*)(xin + off + 4);
                    x0 = x0 + acc[ai][bj][m][0] * scale; x1 = x1 + acc[ai][bj][m][1] * scale;
                    ST_OUT2((f32x4*)(xout + off), x0); ST_OUT2((f32x4*)(xout + off + 4), x1);
                    u32x4 o; o.x = pk2(x0[0], x0[1]); o.y = pk2(x0[2], x0[3]); o.z = pk2(x1[0], x1[1]); o.w = pk2(x1[2], x1[3]);
                    ST_OUT2((u32x4*)(XB + off), o);
                    ss += x0[0] * x0[0] + x0[1] * x0[1] + x0[2] * x0[2] + x0[3] * x0[3] + x1[0] * x1[0] + x1[1] * x1[1] + x1[2] * x1[2] + x1[3] * x1[3];
                }
                ss += __shfl_xor(ss, 16); ss += __shfl_xor(ss, 32);
                if (fq == 0) atomicAdd(rssn + row, (unsigned long long)(ss * 16777216.f));
            }
    }
};
struct EpiBranch {
    const bf16_t* G0; bf16_t* MB;
    __device__ __forceinline__ void operator()(AccRef acc, const Unit& u, int wr, int wc, int fr, int fq) const {
        const int row0 = u.pm * BM + wr * 64 + fr, col0 = u.pn * BM + wc * 32 + 8 * fq;
        const bf16_t* G = G0 + u.seg * 2048; const bool accum = u.seg > 0;
#pragma unroll
        for (int ai = 0; ai < 2; ++ai)
#pragma unroll
            for (int m = 0; m < 4; ++m) {
                const int row = row0 + ai * HALF + m * 16;
#pragma unroll
                for (int bj = 0; bj < 2; ++bj) {
                    const int col = col0 + bj * HALF;
                    const u32x4 gv = *(const u32x4*)(G + (size_t)row * ZW + col);
                    u32x4 pv = (u32x4){0u, 0u, 0u, 0u};
                    if (accum) pv = *(const u32x4*)(MB + (size_t)row * DM + col);
                    const f32x4 a0 = acc[ai][bj][m][0], a1 = acc[ai][bj][m][1];
                    u32x4 o;
                    o.x = pk2(bflo(pv.x) + bflo(gv.x) * a0[0], bfhi(pv.x) + bfhi(gv.x) * a0[1]);
                    o.y = pk2(bflo(pv.y) + bflo(gv.y) * a0[2], bfhi(pv.y) + bfhi(gv.y) * a0[3]);
                    o.z = pk2(bflo(pv.z) + bflo(gv.z) * a1[0], bfhi(pv.z) + bfhi(gv.z) * a1[1]);
                    o.w = pk2(bflo(pv.w) + bflo(gv.w) * a1[2], bfhi(pv.w) + bfhi(gv.w) * a1[3]);
                    *(u32x4*)(MB + (size_t)row * DM + col) = o;
                }
            }
    }
};
struct EpiGlu {
    const bf16_t* YS; bf16_t* Y;
    __device__ __forceinline__ void operator()(AccRef acc, const Unit& u, int wr, int wc, int fr, int fq) const {
        const int row0 = u.pm * BM + wr * 64 + fr, col0 = u.pn * BM + wc * 32 + 8 * fq;
#pragma unroll
        for (int ai = 0; ai < 2; ++ai)
#pragma unroll
            for (int m = 0; m < 4; ++m) {
                const int row = row0 + ai * HALF + m * 16;
#pragma unroll
                for (int bj = 0; bj < 2; ++bj) {
                    const int col = col0 + bj * HALF;
                    const u32x4 yv = *(const u32x4*)(YS + (size_t)row * 512 + col);
                    const f32x4 a0 = acc[ai][bj][m][0], a1 = acc[ai][bj][m][1];
                    u32x4 o;
                    o.x = pk2(bflo(yv.x) * sigmoid_f(a0[0]), bfhi(yv.x) * sigmoid_f(a0[1]));
                    o.y = pk2(bflo(yv.y) * sigmoid_f(a0[2]), bfhi(yv.y) * sigmoid_f(a0[3]));
                    o.z = pk2(bflo(yv.z) * sigmoid_f(a1[0]), bfhi(yv.z) * sigmoid_f(a1[1]));
                    o.w = pk2(bflo(yv.w) * sigmoid_f(a1[2]), bfhi(yv.w) * sigmoid_f(a1[3]));
                    *(u32x4*)(Y + (size_t)row * DM + YC_SSM + col) = o;
                }
            }
    }
};
}

struct Args { const float* in[28]; float* out; unsigned char* ws; int ph_lo, ph_hi; };
enum { I_X = 0, I_F1N, I_F1G, I_F1U, I_F1D, I_MIXN, I_WIN, I_POOLW, I_POOLS, I_GW2, I_GB, I_GNORM, I_ARE, I_AIM, I_LDT, I_BRE, I_BIM, I_CRE, I_CIM,
       I_SD, I_WGLU, I_WBR, I_WOUT, I_F2N, I_F2G, I_F2U, I_F2D, I_FINN };

__device__ __forceinline__ void tr_item(const float* W, int ldw, int col0, const float* ksc, bf16_t* WT, int ldt, int drow, int k0, int n0, unsigned* scr, int lane) {
    const int a = lane & 15, b = lane >> 4;
    const float* src = W + (size_t)(k0 + 2 * b) * ldw + col0 + n0 + a * 4;
    f32x4 v[16];
#pragma unroll
    for (int m = 0; m < 8; ++m) { v[2 * m] = *(const f32x4*)(src + (size_t)(8 * m) * ldw); v[2 * m + 1] = *(const f32x4*)(src + (size_t)(8 * m + 1) * ldw); }
#pragma unroll
    for (int m = 0; m < 8; ++m) {
        const float s0 = ksc ? ksc[k0 + 8 * m + 2 * b] : 1.f, s1 = ksc ? ksc[k0 + 8 * m + 2 * b + 1] : 1.f;
#pragma unroll
        for (int e = 0; e < 4; ++e) scr[(4 * a + e) * 32 + (((m ^ (a & 7)) << 2) | b)] = pk2(v[2 * m][e] * s0, v[2 * m + 1][e] * s1);
    }
    LDS_WAIT();
#pragma unroll
    for (int j = 0; j < 8; ++j) { const int n = (lane >> 3) + 8 * j, c = lane & 7;
        const u32x4 o = *(const u32x4*)(scr + n * 32 + ((c ^ ((n >> 2) & 7)) << 2));
        *(u32x4*)(WT + (size_t)(drow + n) * ldt + k0 + c * 8) = o; }
    LDS_WAIT();
}
__device__ __forceinline__ bool tr_try(int& r, const float* W, int ldw, int K, int N, int col0, const float* ksc, bf16_t* WT, int ldt, int drow0, int mode, unsigned* scr, int lane) {
    const int nblk = N / 64, items = (K / 64) * nblk;
    if (r >= items) { r -= items; return false; }
    const int kb = r / nblk, n0 = (r % nblk) * 64;
    const int drow = drow0 + (mode ? ((n0 >> 7) * 256 + (n0 & 127)) : n0);
    tr_item(W, ldw, col0, ksc, WT, ldt, drow, kb * 64, n0, scr, lane);
    return true;
}

__device__ __forceinline__ void cpow_d(double th, double la, int j, double& pr, double& pi) {
    const double y = th * (double)j;
    const double kq = __builtin_rint(y * 0.63661977236758134308);
    double r = __builtin_fma(-kq, 1.57079632679489655800, y); r = __builtin_fma(-kq, 6.12323399573676603587e-17, r);
    const double r2 = r * r;
    double s = 1.0 - r2 * (1.0 / 272.0); s = 1.0 - r2 * (1.0 / 210.0) * s; s = 1.0 - r2 * (1.0 / 156.0) * s; s = 1.0 - r2 * (1.0 / 110.0) * s; s = 1.0 - r2 * (1.0 / 72.0) * s; s = 1.0 - r2 * (1.0 / 42.0) * s; s = 1.0 - r2 * (1.0 / 20.0) * s; s = 1.0 - r2 * (1.0 / 6.0) * s; s *= r;
    double c = 1.0 - r2 * (1.0 / 240.0); c = 1.0 - r2 * (1.0 / 182.0) * c; c = 1.0 - r2 * (1.0 / 132.0) * c; c = 1.0 - r2 * (1.0 / 90.0) * c; c = 1.0 - r2 * (1.0 / 56.0) * c; c = 1.0 - r2 * (1.0 / 30.0) * c; c = 1.0 - r2 * (1.0 / 12.0) * c; c = 1.0 - r2 * (1.0 / 2.0) * c;
    const int q = ((int)kq) & 3;
    double sn = s, cs = c;
    if (q == 1) { sn = c; cs = -s; } else if (q == 2) { sn = -s; cs = -c; } else if (q == 3) { sn = -c; cs = s; }
    const double x = la * (double)j * (1.0 * (1.0 / 64.0));
    double e = 1.0 + x * (1.0 / 10.0); e = 1.0 + x * (1.0 / 9.0) * e; e = 1.0 + x * (1.0 / 8.0) * e; e = 1.0 + x * (1.0 / 7.0) * e; e = 1.0 + x * (1.0 / 6.0) * e; e = 1.0 + x * (1.0 / 5.0) * e; e = 1.0 + x * (1.0 / 4.0) * e; e = 1.0 + x * (1.0 / 3.0) * e; e = 1.0 + x * (1.0 / 2.0) * e; e = 1.0 + x * e;
#pragma unroll
    for (int i = 0; i < 6; ++i) e = e * e;
    pr = e * cs; pi = e * sn;
}

__device__ __forceinline__ void phase_prep(const Args& a, int l, unsigned char* lds, int G) {
    const int tid = otid(), lane = tid & 63, wave = tid >> 6;
    unsigned char* ws = a.ws;
    const int gw = blockIdx.x * 8 + wave, NGW = G * 8;
    unsigned* scr = (unsigned*)(lds + wave * 16384);
    const float* f1n = a.in[I_F1N] + (size_t)l * DM; const float* f2n = a.in[I_F2N] + (size_t)l * DM; const float* mxn = a.in[I_MIXN] + (size_t)l * DM;
    const float* f1g = a.in[I_F1G] + (size_t)l * DM * FF; const float* f1u = a.in[I_F1U] + (size_t)l * DM * FF; const float* f1d = a.in[I_F1D] + (size_t)l * FF * DM;
    const float* f2g = a.in[I_F2G] + (size_t)l * DM * FF; const float* f2u = a.in[I_F2U] + (size_t)l * DM * FF; const float* f2d = a.in[I_F2D] + (size_t)l * FF * DM;
    const float* win = a.in[I_WIN] + (size_t)l * DM * INW; const float* wbr = a.in[I_WBR] + (size_t)l * DM * DM; const float* wout = a.in[I_WOUT] + (size_t)l * DM * DM;
    const float* wglu = a.in[I_WGLU] + (size_t)l * 512 * 512;
    constexpr int IT_FU = (DM / 64) * (FF / 64), IT_FD = (FF / 64) * (DM / 64), IT_WA = (DM / 64) * (3584 / 64), IT_WB = (DM / 64) * (6656 / 64),
                  IT_BR = (1536 / 64) * (DM / 64), IT_WO = (DM / 64) * (DM / 64), IT_GL = (512 / 64) * (512 / 64);
    constexpr int IT_TOTAL = 4 * IT_FU + 2 * IT_FD + IT_WA + IT_WB + IT_BR + IT_WO + IT_GL;
    for (int it = gw; it < IT_TOTAL; it += NGW) {
        int r = it;
        if (tr_try(r, f1g, FF, DM, FF, 0, f1n, (bf16_t*)(ws + WS_W1U), DM, 0, 1, scr, lane)) continue;
        if (tr_try(r, f1u, FF, DM, FF, 0, f1n, (bf16_t*)(ws + WS_W1U), DM, 128, 1, scr, lane)) continue;
        if (tr_try(r, f2g, FF, DM, FF, 0, f2n, (bf16_t*)(ws + WS_W2U), DM, 0, 1, scr, lane)) continue;
        if (tr_try(r, f2u, FF, DM, FF, 0, f2n, (bf16_t*)(ws + WS_W2U), DM, 128, 1, scr, lane)) continue;
        if (tr_try(r, f1d, DM, FF, DM, 0, nullptr, (bf16_t*)(ws + WS_W1D), FF, 0, 0, scr, lane)) continue;
        if (tr_try(r, f2d, DM, FF, DM, 0, nullptr, (bf16_t*)(ws + WS_W2D), FF, 0, 0, scr, lane)) continue;
        if (tr_try(r, win, INW, DM, 3584, 0, mxn, (bf16_t*)(ws + WS_WIN), DM, 0, 0, scr, lane)) continue;
        if (tr_try(r, win, INW, DM, 6656, 3600, mxn, (bf16_t*)(ws + WS_WIN), DM, 3584, 0, scr, lane)) continue;
        if (tr_try(r, wbr + (size_t)512 * DM, DM, 1536, DM, 0, nullptr, (bf16_t*)(ws + WS_WBR) + 512, DM, 0, 0, scr, lane)) continue;
        if (tr_try(r, wout, DM, DM, DM, 0, nullptr, (bf16_t*)(ws + WS_WO), DM, 0, 0, scr, lane)) continue;
        tr_try(r, wglu, 512, 512, 512, 0, nullptr, (bf16_t*)(ws + WS_WGLU), 512, 0, 0, scr, lane);
    }
    {
        const float* pw = a.in[I_POOLW] + (size_t)l * 4 * 128 * 128; const float* ps = a.in[I_POOLS] + (size_t)l * 512;
        bf16_t* WbT = (bf16_t*)(ws + WS_WBR);
        const int n0 = blockIdx.x * 8, k = tid, g = k >> 7;
        const float* pr = pw + (size_t)k * 128;
        float s[8];
#pragma unroll
        for (int i = 0; i < 8; ++i) s[i] = 0.f;
#pragma unroll 4
        for (int d = 0; d < 128; ++d) {
            const float pv = pr[d] * ps[g * 128 + d];
            const f32x4 w0 = *(const f32x4*)(wbr + (size_t)(g * 128 + d) * DM + n0), w1 = *(const f32x4*)(wbr + (size_t)(g * 128 + d) * DM + n0 + 4);
            s[0] += pv * w0[0]; s[1] += pv * w0[1]; s[2] += pv * w0[2]; s[3] += pv * w0[3]; s[4] += pv * w1[0]; s[5] += pv * w1[1]; s[6] += pv * w1[2]; s[7] += pv * w1[3];
        }
#pragma unroll
        for (int i = 0; i < 8; ++i) WbT[(size_t)(n0 + i) * DM + k] = (bf16_t)f2bf(s[i]);
    }
    {
        bf16_t* WGT = (bf16_t*)(ws + WS_WGT);
        for (int i = blockIdx.x * 512 + tid; i < 16 * DM; i += G * 512) { const int j = i >> 11, k = i & 2047; WGT[i] = (bf16_t)f2bf(mxn[k] * win[(size_t)k * INW + 3584 + j]); }
    }
    {
        const float* are = a.in[I_ARE] + (size_t)l * 32 * 64; const float* aim = a.in[I_AIM] + (size_t)l * 32 * 64; const float* ldt = a.in[I_LDT] + (size_t)l * 32;
        const float* bre = a.in[I_BRE] + (size_t)l * 32 * 64 * 16; const float* bim = a.in[I_BIM] + (size_t)l * 32 * 64 * 16;
        const float* cre = a.in[I_CRE] + (size_t)l * 32 * 16 * 64; const float* cim = a.in[I_CIM] + (size_t)l * 32 * 16 * 64;
        const float* sd = a.in[I_SD] + (size_t)l * 512;
        bf16_t* KT = (bf16_t*)(ws + WS_KT); bf16_t* MET = (bf16_t*)(ws + WS_MET); bf16_t* MCT = (bf16_t*)(ws + WS_MCT); float* L64 = (float*)(ws + WS_L64);
        float* s_cr = (float*)lds;
        float* s_ci = s_cr + 1024;
        float* s_bbr = s_ci + 1024;
        float* s_bbi = s_bbr + 1024;
        float* s_pw = s_bbi + 1024;
        float* s_f = s_pw + 1024;
        __syncthreads();
        for (int it = blockIdx.x; it < 32 * 9; it += G) {
            const int g = it / 9, jb = it % 9;
            {
                const int p = tid & 63, jj = tid >> 6, j = jb * 8 + jj;
                const double dt = (double)expf(ldt[g]);
                const double ar = (double)are[g * 64 + p], ai = (double)aim[g * 64 + p];
                if (j <= 64) { double pr, pi; cpow_d(dt * ai, dt * ar, j, pr, pi); s_pw[(jj * 64 + p) * 2] = (float)pr; s_pw[(jj * 64 + p) * 2 + 1] = (float)pi;
                    if (j == 64) { L64[(g * 64 + p) * 2] = (float)pr; L64[(g * 64 + p) * 2 + 1] = (float)pi; } }
                if (tid < 64) {
                    double l1r, l1i; cpow_d(dt * ai, dt * ar, 1, l1r, l1i);
                    const double den = ar * ar + ai * ai;
                    s_f[2 * p] = (float)(((l1r - 1.0) * ar + l1i * ai) / den); s_f[2 * p + 1] = (float)((l1i * ar - (l1r - 1.0) * ai) / den);
                }
#pragma unroll
                for (int i = 0; i < 2; ++i) { const int idx = tid + i * 512; s_cr[idx] = cre[(size_t)g * 1024 + idx]; s_ci[idx] = cim[(size_t)g * 1024 + idx]; }
            }
            __syncthreads();
#pragma unroll
            for (int i = 0; i < 2; ++i) { const int idx = tid + i * 512, p = idx >> 4; const float fr = s_f[2 * p], fi = s_f[2 * p + 1];
                const float br = bre[(size_t)g * 1024 + idx], bi = bim[(size_t)g * 1024 + idx];
                s_bbr[idx] = fr * br - fi * bi; s_bbi[idx] = fr * bi + fi * br; }
            __syncthreads();
#pragma unroll 1
            for (int i = 0; i < 4; ++i) {
                const int o = tid + i * 512, jj = o >> 8, h = (o >> 4) & 15, hp = o & 15, j = jb * 8 + jj;
                if (j < 64) {
                    float sacc = 0.f;
#pragma unroll 8
                    for (int p = 0; p < 64; ++p) { const float cr = s_cr[h * 64 + p], ci = s_ci[h * 64 + p], pr = s_pw[(jj * 64 + p) * 2], pi = s_pw[(jj * 64 + p) * 2 + 1];
                        sacc += (cr * pr - ci * pi) * s_bbr[p * 16 + hp] - (cr * pi + ci * pr) * s_bbi[p * 16 + hp]; }
                    if (j == 0 && h == hp) sacc += sd[g * 16 + h];
                    KT[((size_t)(g * 64 + j) * 16 + h) * 16 + hp] = (bf16_t)f2bf(sacc);
                }
            }
#pragma unroll 4
            for (int i = 0; i < 16; ++i) {
                const int o = tid + i * 512, jj = o >> 10, j = jb * 8 + jj;
                if (j < 64) { const int p = (o >> 4) & 63, hp = o & 15; const float pr = s_pw[(jj * 64 + p) * 2], pi = s_pw[(jj * 64 + p) * 2 + 1], br = s_bbr[p * 16 + hp], bi = s_bbi[p * 16 + hp];
                    const int jp = 63 - j;
                    MET[((size_t)(g * 128 + p) * 64 + jp) * 16 + hp] = (bf16_t)f2bf(pr * br - pi * bi);
                    MET[((size_t)(g * 128 + 64 + p) * 64 + jp) * 16 + hp] = (bf16_t)f2bf(pr * bi + pi * br); }
                if (j >= 1 && j <= 64) { const int h = (o >> 6) & 15, p = o & 63; const float cr = s_cr[h * 64 + p], ci = s_ci[h * 64 + p], pr = s_pw[(jj * 64 + p) * 2], pi = s_pw[(jj * 64 + p) * 2 + 1];
                    const size_t base = ((size_t)g * 1024 + (j - 1) * 16 + h) * 128;
                    MCT[base + p] = (bf16_t)f2bf(cr * pr - ci * pi); MCT[base + 64 + p] = (bf16_t)f2bf(-(cr * pi + ci * pr)); }
            }
            __syncthreads();
        }
    }
    if (l == 0) {
        const float* x = a.in[I_X]; bf16_t* XB = (bf16_t*)(ws + WS_XB); unsigned long long* rss = (unsigned long long*)(ws + WS_RSS);
        for (int row = gw; row < T; row += NGW) {
            const f32x4* xr = (const f32x4*)(x + (size_t)row * DM) + lane; u32x2* o = (u32x2*)(XB + (size_t)row * DM) + lane;
            float ss = 0.f;
#pragma unroll
            for (int i = 0; i < 8; ++i) { const f32x4 v = xr[64 * i]; ss += v[0] * v[0] + v[1] * v[1] + v[2] * v[2] + v[3] * v[3]; u32x2 w; w.x = pk2(v[0], v[1]); w.y = pk2(v[2], v[3]); o[64 * i] = w; }
            ss = wave_sum(ss);
            if (lane == 0) rss[row] = (unsigned long long)(ss * 16777216.f);
        }
        for (int i = blockIdx.x * 512 + tid; i < 6 * T; i += G * 512) rss[T + i] = 0ull;
    }
}

__device__ __forceinline__ void phase_glr(const Args& a, const unsigned long long* rss, int G) {
    const int tid = otid(), lane = tid & 63, wave = tid >> 6, r16 = lane & 15, quad = lane >> 4;
    const int gw = blockIdx.x * 8 + wave, NGW = G * 8;
    const bf16_t* XB = (const bf16_t*)(a.ws + WS_XB); const bf16_t* WGT = (const bf16_t*)(a.ws + WS_WGT); float* GLR = (float*)(a.ws + WS_GLR);
    for (int task = gw; task < T / 16; task += NGW) {
        const int r0 = task * 16;
        f32x4 acc4[4];
#pragma unroll
        for (int q = 0; q < 4; ++q) acc4[q] = (f32x4){0.f, 0.f, 0.f, 0.f};
        const bf16_t* ap = XB + (size_t)(r0 + r16) * DM + quad * 8; const bf16_t* bp = WGT + (size_t)r16 * DM + quad * 8;
#pragma unroll 4
        for (int kb = 0; kb < 64; kb += 4)
#pragma unroll
            for (int q = 0; q < 4; ++q) acc4[q] = mfma16(*(const bf16x8*)(ap + (kb + q) * 32), *(const bf16x8*)(bp + (kb + q) * 32), acc4[q]);
        const f32x4 acc = (acc4[0] + acc4[1]) + (acc4[2] + acc4[3]);
#pragma unroll
        for (int i = 0; i < 4; ++i) { const int row = r0 + quad * 4 + i; GLR[(size_t)row * 16 + r16] = acc[i] * rsqrtf((float)rss[row] * (1.f / (16777216.f * DM)) + EPS); }
    }
}

template <int W>
__device__ __forceinline__ void pool_group(const bf16_t* Z, bf16_t* Y, int c00, int G) {
    for (int idx = blockIdx.x * 512 + otid(); idx < T * 16; idx += G * 512) {
        const int t = idx >> 4, c0 = c00 + (idx & 15) * 8, s = t & (SEQ - 1);
        const int cnt = (s + 1) < W ? (s + 1) : W;
        u32x4 v[W];
#pragma unroll
        for (int j = 0; j < W; ++j) { const int tj = (j < cnt) ? (t - j) : t; v[j] = *(const u32x4*)(Z + (size_t)tj * ZW + ZC_POOL + c0); }
        float sum[8];
#pragma unroll
        for (int i = 0; i < 8; ++i) sum[i] = 0.f;
#pragma unroll
        for (int j = 0; j < W; ++j) { const float m = (j < cnt) ? 1.f : 0.f;
            sum[0] += m * bflo(v[j].x); sum[1] += m * bfhi(v[j].x); sum[2] += m * bflo(v[j].y); sum[3] += m * bfhi(v[j].y);
            sum[4] += m * bflo(v[j].z); sum[5] += m * bfhi(v[j].z); sum[6] += m * bflo(v[j].w); sum[7] += m * bfhi(v[j].w); }
        const float inv = 1.f / (float)cnt;
        u32x4 o; o.x = pk2(sum[0] * inv - bflo(v[0].x), sum[1] * inv - bfhi(v[0].x)); o.y = pk2(sum[2] * inv - bflo(v[0].y), sum[3] * inv - bfhi(v[0].y));
        o.z = pk2(sum[4] * inv - bflo(v[0].z), sum[5] * inv - bfhi(v[0].z)); o.w = pk2(sum[6] * inv - bflo(v[0].w), sum[7] * inv - bfhi(v[0].w));
        *(u32x4*)(Y + (size_t)t * DM + c0) = o;
    }
}
__device__ __forceinline__ void phase_pool(const Args& a, int G) {
    const bf16_t* Z = (const bf16_t*)(a.ws + WS_Z); bf16_t* Y = (bf16_t*)(a.ws + WS_Y);
    pool_group<2>(Z, Y, 0, G); pool_group<4>(Z, Y, 128, G); pool_group<8>(Z, Y, 256, G); pool_group<16>(Z, Y, 384, G);
}

constexpr int OFF_BC = 0, OFF_QP = 32768, OFF_KP = 50176, OFF_OB = 0, OFF_QD = 67584, OFF_VT = 84992, OFF_PB = 121856, OFF_GL = 131072, OFF_TOT = 135168;
constexpr int PQ = 136, PV = 72, POB = 260;

__device__ __forceinline__ void gla_bc(const Args& a, int l, unsigned char* lds, int t0, int h) {
    const int tid = otid(), d = tid & 127, jq = tid >> 7;
    float* BC = (float*)(lds + OFF_BC); float* GL = (float*)(lds + OFF_GL); float* TOT = (float*)(lds + OFF_TOT);
    const float* GLR = (const float*)(a.ws + WS_GLR);
    const float* w2 = a.in[I_GW2] + (size_t)l * 16 * 512; const float* gb = a.in[I_GB] + (size_t)l * 512;
    for (int i = tid; i < 1024; i += 512) GL[i] = GLR[(size_t)t0 * 16 + i];
    float w[16];
#pragma unroll
    for (int r = 0; r < 16; ++r) w[r] = w2[r * 512 + h * 128 + d];
    const float bias = gb[h * 128 + d];
    __syncthreads();
    float run = 0.f;
#pragma unroll 4
    for (int jj = 0; jj < 16; ++jj) {
        const int j = jq * 16 + jj;
        float z = bias;
#pragma unroll
        for (int r = 0; r < 16; ++r) z += GL[j * 16 + r] * w[r];
        const float la = (fminf(z, 0.f) - __logf(1.f + __expf(-fabsf(z)))) * (1.f / 16.f);
        run += la; BC[j * 128 + d] = run;
    }
    TOT[jq * 128 + d] = run;
    __syncthreads();
    float off = 0.f;
    for (int q = 0; q < jq; ++q) off += TOT[q * 128 + d];
    if (jq > 0) {
#pragma unroll 4
        for (int jj = 0; jj < 16; ++jj) BC[(jq * 16 + jj) * 128 + d] += off;
    }
    __syncthreads();
}

__device__ __forceinline__ int tsw(int x, int j) { return x * PV + ((((j >> 3) ^ ((x >> 3) & 7)) << 3) | (j & 7)); }
__device__ __forceinline__ int tsc(int x, int c) { return x * PV + ((c ^ ((x >> 3) & 7)) << 3); }
__device__ __forceinline__ float bfe(const u32x4& v, int e) { const unsigned w = (e < 2) ? v.x : (e < 4) ? v.y : (e < 6) ? v.z : v.w; return (e & 1) ? bfhi(w) : bflo(w); }
__device__ __forceinline__ unsigned short bfr(const u32x4& v, int e) { const unsigned w = (e < 2) ? v.x : (e < 4) ? v.y : (e < 6) ? v.z : v.w; return (unsigned short)((e & 1) ? (w >> 16) : (w & 0xffffu)); }

__device__ __forceinline__ void gla_kv_unit(const Args& a, int l, unsigned char* lds, int unit) {
    const int tid = otid(), lane = tid & 63, wave = tid >> 6, r16 = lane & 15, quad = lane >> 4;
    const int bh = unit >> 6, n = unit & 63, b = bh >> 2, h = bh & 3, t0 = b * SEQ + n * 64;
    const bf16_t* Z = (const bf16_t*)(a.ws + WS_Z); bf16_t* KV = (bf16_t*)(a.ws + WS_KV); float* DEC = (float*)(a.ws + WS_DEC);
    u32x4 kreg[2], vreg[4];
#pragma unroll
    for (int i = 0; i < 2; ++i) { const int p = tid + 512 * i; kreg[i] = *(const u32x4*)(Z + (size_t)(t0 + (p >> 4)) * ZW + ZC_K + h * 128 + (p & 15) * 8); }
#pragma unroll
    for (int i = 0; i < 4; ++i) { const int p = tid + 512 * i; vreg[i] = *(const u32x4*)(Z + (size_t)(t0 + (p >> 5)) * ZW + ZC_V + h * 256 + (p & 31) * 8); }
    gla_bc(a, l, lds, t0, h);
    const float* BC = (const float*)(lds + OFF_BC); bf16_t* KTl = (bf16_t*)(lds + OFF_QP); bf16_t* VT = (bf16_t*)(lds + OFF_VT);
    {
        float* BCG = (float*)(a.ws + WS_BCG);
#pragma unroll
        for (int i = 0; i < 4; ++i) { const int p = tid + 512 * i, j = p >> 5, d0 = (p & 31) * 4; *(f32x4*)(BCG + (size_t)(t0 + j) * 512 + h * 128 + d0) = *(const f32x4*)(BC + j * 128 + d0); }
    }
#pragma unroll
    for (int i = 0; i < 2; ++i) {
        const int p = tid + 512 * i, j = p >> 4, d0 = (p & 15) * 8;
        const f32x4 bl0 = *(const f32x4*)(BC + 63 * 128 + d0), bl1 = *(const f32x4*)(BC + 63 * 128 + d0 + 4);
        const f32x4 bc0 = *(const f32x4*)(BC + j * 128 + d0), bc1 = *(const f32x4*)(BC + j * 128 + d0 + 4);
#pragma unroll
        for (int e = 0; e < 8; ++e) { const float bl = e < 4 ? bl0[e & 3] : bl1[e & 3], bc = e < 4 ? bc0[e & 3] : bc1[e & 3];
            KTl[tsw(d0 + e, j)] = (bf16_t)f2bf(bfe(kreg[i], e) * __expf(bl - bc)); }
    }
    if (tid < 128) DEC[(size_t)unit * 128 + tid] = __expf(BC[63 * 128 + tid]);
#pragma unroll
    for (int i = 0; i < 4; ++i) {
        const int p = tid + 512 * i, j = p >> 5, v0 = (p & 31) * 8;
#pragma unroll
        for (int e = 0; e < 8; ++e) VT[tsw(v0 + e, j)] = bfr(vreg[i], e);
    }
    __syncthreads();
    f32x4 acc[8][2];
#pragma unroll
    for (int i = 0; i < 8; ++i) { acc[i][0] = (f32x4){0.f, 0.f, 0.f, 0.f}; acc[i][1] = (f32x4){0.f, 0.f, 0.f, 0.f}; }
#pragma unroll
    for (int kb = 0; kb < 2; ++kb) {
        bf16x8 bf[2];
#pragma unroll
        for (int v2 = 0; v2 < 2; ++v2) bf[v2] = *(const bf16x8*)(VT + tsc((wave * 2 + v2) * 16 + r16, kb * 4 + quad));
#pragma unroll
        for (int db = 0; db < 8; ++db) { const bf16x8 af = *(const bf16x8*)(KTl + tsc(db * 16 + r16, kb * 4 + quad));
            acc[db][0] = mfma16(af, bf[0], acc[db][0]); acc[db][1] = mfma16(af, bf[1], acc[db][1]); }
    }
#pragma unroll
    for (int db = 0; db < 8; ++db)
#pragma unroll
        for (int v2 = 0; v2 < 2; ++v2) { const int v = (wave * 2 + v2) * 16 + r16; u32x2 o; o.x = pk2(acc[db][v2][0], acc[db][v2][1]); o.y = pk2(acc[db][v2][2], acc[db][v2][3]);
            *(u32x2*)(KV + ((size_t)unit * 256 + v) * 128 + db * 16 + quad * 4) = o; }
    __syncthreads();
}

__device__ __forceinline__ void gla_scan(const Args& a, int G, size_t dst_off = WS_KV) {
    bf16_t* KV = (bf16_t*)(a.ws + WS_KV); const float* DEC = (const float*)(a.ws + WS_DEC); const ptrdiff_t dd = (ptrdiff_t)dst_off - (ptrdiff_t)WS_KV;
    for (int id = blockIdx.x * 512 + otid(); id < 16 * 256 * 32; id += G * 512) {
        const int bh = id >> 13, v = (id >> 5) & 255, d0 = (id & 31) * 4;
        float s0 = 0.f, s1 = 0.f, s2 = 0.f, s3 = 0.f;
#pragma unroll 8
        for (int n = 0; n < 64; ++n) {
            const int unit = bh * 64 + n;
            u32x2* p = (u32x2*)(KV + ((size_t)unit * 256 + v) * 128 + d0);
            const u32x2 kv = *p; const f32x4 dc = *(const f32x4*)(DEC + (size_t)unit * 128 + d0);
            u32x2 o; o.x = pk2(s0, s1); o.y = pk2(s2, s3); *(u32x2*)((char*)p + dd) = o;
            s0 = dc[0] * s0 + bflo(kv.x); s1 = dc[1] * s1 + bfhi(kv.x); s2 = dc[2] * s2 + bflo(kv.y); s3 = dc[3] * s3 + bfhi(kv.y);
        }
    }
}

__device__ __forceinline__ void gla_out_unit(const Args& a, int l, unsigned char* lds, int unit) {
    const int tid = otid(), lane = tid & 63, wave = tid >> 6, r16 = lane & 15, quad = lane >> 4;
    const int bh = unit >> 6, n = unit & 63, b = bh >> 2, h = bh & 3, t0 = b * SEQ + n * 64;
    const bf16_t* Z = (const bf16_t*)(a.ws + WS_Z); const bf16_t* KV = (const bf16_t*)(a.ws + WS_KV); bf16_t* Y = (bf16_t*)(a.ws + WS_Y);
    u32x4 qreg[2], kreg[2], vreg[4];
#pragma unroll
    for (int i = 0; i < 2; ++i) { const int p = tid + 512 * i; const bf16_t* rp = Z + (size_t)(t0 + (p >> 4)) * ZW + h * 128 + (p & 15) * 8;
        qreg[i] = *(const u32x4*)(rp + ZC_Q); kreg[i] = *(const u32x4*)(rp + ZC_K); }
#pragma unroll
    for (int i = 0; i < 4; ++i) { const int p = tid + 512 * i; vreg[i] = *(const u32x4*)(Z + (size_t)(t0 + (p >> 5)) * ZW + ZC_V + h * 256 + (p & 31) * 8); }
    const float* BCG = (const float*)(a.ws + WS_BCG);
    f32x4 bcr[2][2], bmr[2][2];
#pragma unroll
    for (int i = 0; i < 2; ++i) { const int p = tid + 512 * i, j = p >> 4, d0 = (p & 15) * 8;
        bcr[i][0] = *(const f32x4*)(BCG + (size_t)(t0 + j) * 512 + h * 128 + d0); bcr[i][1] = *(const f32x4*)(BCG + (size_t)(t0 + j) * 512 + h * 128 + d0 + 4);
        bmr[i][0] = *(const f32x4*)(BCG + (size_t)(t0 + 31) * 512 + h * 128 + d0); bmr[i][1] = *(const f32x4*)(BCG + (size_t)(t0 + 31) * 512 + h * 128 + d0 + 4); }
    bf16_t* QP = (bf16_t*)(lds + OFF_QP); bf16_t* KP = (bf16_t*)(lds + OFF_KP); bf16_t* QD = (bf16_t*)(lds + OFF_QD); bf16_t* VT = (bf16_t*)(lds + OFF_VT); bf16_t* PB = (bf16_t*)(lds + OFF_PB);
    float* OB = (float*)(lds + OFF_OB);
#pragma unroll
    for (int i = 0; i < 2; ++i) {
        const int p = tid + 512 * i, j = p >> 4, d0 = (p & 15) * 8;
        const f32x4 bm0 = bmr[i][0], bm1 = bmr[i][1];
        const f32x4 bc0 = bcr[i][0], bc1 = bcr[i][1];
        float qp[8], kp[8], qd[8];
#pragma unroll
        for (int e = 0; e < 8; ++e) { const float bm = e < 4 ? bm0[e & 3] : bm1[e & 3], bc = e < 4 ? bc0[e & 3] : bc1[e & 3];
            const float qv = bfe(qreg[i], e) * 0.08838834764831845f, kv = bfe(kreg[i], e);
            qp[e] = qv * __expf(bc - bm); kp[e] = kv * __expf(bm - bc); qd[e] = qv * __expf(bc); }
        u32x4 o; o.x = pk2(qp[0], qp[1]); o.y = pk2(qp[2], qp[3]); o.z = pk2(qp[4], qp[5]); o.w = pk2(qp[6], qp[7]); *(u32x4*)(QP + j * PQ + d0) = o;
        o.x = pk2(kp[0], kp[1]); o.y = pk2(kp[2], kp[3]); o.z = pk2(kp[4], kp[5]); o.w = pk2(kp[6], kp[7]); *(u32x4*)(KP + j * PQ + d0) = o;
        o.x = pk2(qd[0], qd[1]); o.y = pk2(qd[2], qd[3]); o.z = pk2(qd[4], qd[5]); o.w = pk2(qd[6], qd[7]); *(u32x4*)(QD + j * PQ + d0) = o;
    }
#pragma unroll
    for (int i = 0; i < 4; ++i) {
        const int p = tid + 512 * i, j = p >> 5, v0 = (p & 31) * 8;
#pragma unroll
        for (int e = 0; e < 8; ++e) VT[tsw(v0 + e, j)] = bfr(vreg[i], e);
    }
    bf16x8 bfk[4][2];
#pragma unroll
    for (int kb = 0; kb < 4; ++kb)
#pragma unroll
        for (int v2 = 0; v2 < 2; ++v2) bfk[kb][v2] = *(const bf16x8*)(KV + ((size_t)unit * 256 + (wave * 2 + v2) * 16 + r16) * 128 + kb * 32 + quad * 8);
    u32x2 rv8[8];
#pragma unroll
    for (int rr = 0; rr < 8; ++rr) rv8[rr] = *(const u32x2*)(Z + (size_t)(t0 + wave * 8 + rr) * ZW + ZC_R + h * 256 + lane * 4);
    __syncthreads();
    {
        const int ib = wave >> 1;
#pragma unroll
        for (int jbi = 0; jbi < 2; ++jbi) {
            const int jb = (wave & 1) * 2 + jbi;
            f32x4 sc = (f32x4){0.f, 0.f, 0.f, 0.f};
            if (jb <= ib) {
#pragma unroll
                for (int kb = 0; kb < 4; ++kb) sc = mfma16(*(const bf16x8*)(QP + (ib * 16 + r16) * PQ + kb * 32 + quad * 8), *(const bf16x8*)(KP + (jb * 16 + r16) * PQ + kb * 32 + quad * 8), sc);
            }
#pragma unroll
            for (int i = 0; i < 4; ++i) { const int row = ib * 16 + quad * 4 + i, col = jb * 16 + r16; PB[row * PV + col] = (bf16_t)f2bf(col <= row ? sc[i] : 0.f); }
        }
    }
    __syncthreads();
    f32x4 acc[4][2];
#pragma unroll
    for (int i = 0; i < 4; ++i) { acc[i][0] = (f32x4){0.f, 0.f, 0.f, 0.f}; acc[i][1] = (f32x4){0.f, 0.f, 0.f, 0.f}; }
#pragma unroll
    for (int kb = 0; kb < 2; ++kb) {
        bf16x8 bf[2];
#pragma unroll
        for (int v2 = 0; v2 < 2; ++v2) bf[v2] = *(const bf16x8*)(VT + tsc((wave * 2 + v2) * 16 + r16, kb * 4 + quad));
#pragma unroll
        for (int ib = 0; ib < 4; ++ib) { const bf16x8 af = *(const bf16x8*)(PB + (ib * 16 + r16) * PV + kb * 32 + quad * 8);
            acc[ib][0] = mfma16(af, bf[0], acc[ib][0]); acc[ib][1] = mfma16(af, bf[1], acc[ib][1]); }
    }
#pragma unroll
    for (int kb = 0; kb < 4; ++kb) {
#pragma unroll
        for (int ib = 0; ib < 4; ++ib) { const bf16x8 af = *(const bf16x8*)(QD + (ib * 16 + r16) * PQ + kb * 32 + quad * 8);
            acc[ib][0] = mfma16(af, bfk[kb][0], acc[ib][0]); acc[ib][1] = mfma16(af, bfk[kb][1], acc[ib][1]); }
    }
#pragma unroll
    for (int ib = 0; ib < 4; ++ib)
#pragma unroll
        for (int v2 = 0; v2 < 2; ++v2)
#pragma unroll
            for (int i = 0; i < 4; ++i) OB[(ib * 16 + quad * 4 + i) * POB + (wave * 2 + v2) * 16 + r16] = acc[ib][v2][i];
    __syncthreads();
    {
        const float* gn = a.in[I_GNORM] + (size_t)l * 1024 + h * 256 + lane * 4;
        const f32x4 gain = *(const f32x4*)gn;
#pragma unroll
        for (int rr = 0; rr < 8; ++rr) {
            const int i = wave * 8 + rr;
            const f32x4 v = *(const f32x4*)(OB + i * POB + lane * 4);
            const float ss = wave_sum(v[0] * v[0] + v[1] * v[1] + v[2] * v[2] + v[3] * v[3]);
            const float rinv = rsqrtf(ss * (1.f / 256.f) + EPS);
            const u32x2 rv = rv8[rr];
            const float r0 = bflo(rv.x), r1 = bfhi(rv.x), r2 = bflo(rv.y), r3 = bfhi(rv.y);
            u32x2 o; o.x = pk2(v[0] * rinv * gain[0] * r0 * sigmoid_f(r0), v[1] * rinv * gain[1] * r1 * sigmoid_f(r1));
            o.y = pk2(v[2] * rinv * gain[2] * r2 * sigmoid_f(r2), v[3] * rinv * gain[3] * r3 * sigmoid_f(r3));
            *(u32x2*)(Y + (size_t)(t0 + i) * DM + YC_GLA + h * 256 + lane * 4) = o;
        }
    }
    __syncthreads();
}

__device__ __forceinline__ void ssm_end_unit(const Args& a, int unit) {
    const int tid = otid(), lane = tid & 63, wave = tid >> 6, r16 = lane & 15, quad = lane >> 4;
    const int g = unit >> 2, rb = unit & 3;
    const bf16_t* XS = (const bf16_t*)(a.ws + WS_XS); const bf16_t* MET = (const bf16_t*)(a.ws + WS_MET); float* E = (float*)(a.ws + WS_E);
    const int crow = rb * 64 + (wave & 3) * 16, qg = (wave >> 2) * 64;
    const int ch = (quad & 1) * 8, jo = quad >> 1;
    f32x4 acc[4];
#pragma unroll
    for (int i = 0; i < 4; ++i) acc[i] = (f32x4){0.f, 0.f, 0.f, 0.f};
    const bf16_t* ap = XS + ((size_t)g * T + (crow + r16) * 64 + jo) * 16 + ch;
    const bf16_t* bp = MET + ((size_t)(g * 128 + qg + r16) * 64 + jo) * 16 + ch;
#pragma unroll 4
    for (int kb = 0; kb < 32; ++kb) {
        const bf16x8 af = *(const bf16x8*)(ap + (size_t)kb * 2 * 16);
#pragma unroll
        for (int nb = 0; nb < 4; ++nb) acc[nb] = mfma16(af, *(const bf16x8*)(bp + (size_t)nb * 16 * 1024 + kb * 32), acc[nb]);
    }
#pragma unroll
    for (int nb = 0; nb < 4; ++nb)
#pragma unroll
        for (int i = 0; i < 4; ++i) E[((size_t)(crow + quad * 4 + i) * 32 + g) * 128 + qg + nb * 16 + r16] = acc[nb][i];
}
__device__ __forceinline__ void ssm_scan(const Args& a, int id) {
    const int b = id >> 11, g = (id >> 6) & 31, p = id & 63;
    const float* E = (const float*)(a.ws + WS_E); bf16_t* HC = (bf16_t*)(a.ws + WS_HC); const float* L64 = (const float*)(a.ws + WS_L64);
    const float lr = L64[(g * 64 + p) * 2], li = L64[(g * 64 + p) * 2 + 1];
    float hr = 0.f, hi = 0.f;
#pragma unroll 8
    for (int n = 0; n < 64; ++n) {
        const size_t base = ((size_t)(b * 64 + n) * 32 + g) * 128;
        HC[base + p] = (bf16_t)f2bf(hr); HC[base + 64 + p] = (bf16_t)f2bf(hi);
        const float er = E[base + p], ei = E[base + 64 + p];
        const float nr = lr * hr - li * hi + er, ni = lr * hi + li * hr + ei;
        hr = nr; hi = ni;
    }
}
__device__ __forceinline__ void ssm_out_unit(const Args& a, int unit) {
    const int tid = otid(), lane = tid & 63, wave = tid >> 6, r16 = lane & 15, quad = lane >> 4;
    const int g = unit >> 4, cb = unit & 15;
    const bf16_t* XS = (const bf16_t*)(a.ws + WS_XS); const bf16_t* KT = (const bf16_t*)(a.ws + WS_KT); const bf16_t* MCT = (const bf16_t*)(a.ws + WS_MCT);
    const bf16_t* HC = (const bf16_t*)(a.ws + WS_HC); bf16_t* YS = (bf16_t*)(a.ws + WS_YS);
    const int ch = (quad & 1) * 8, jo = quad >> 1;
    f32x4 acc[2][4];
#pragma unroll
    for (int i = 0; i < 2; ++i)
#pragma unroll
        for (int k = 0; k < 4; ++k) acc[i][k] = (f32x4){0.f, 0.f, 0.f, 0.f};
    const int kbn = cb * 2 + 2;
    const bf16x8 zero8 = (bf16x8){0, 0, 0, 0, 0, 0, 0, 0};
    for (int kb0 = 0; kb0 < kbn; kb0 += 4) {
        bf16x8 af[4][2], bf[4][4];
#pragma unroll
        for (int u = 0; u < 4; ++u) {
            const int kb = kb0 + u, jp = kb * 2 + jo; const bool on = kb < kbn;
#pragma unroll
            for (int rk = 0; rk < 2; ++rk) af[u][rk] = on ? *(const bf16x8*)(XS + ((size_t)g * T + (wave * 32 + rk * 16 + r16) * 64 + jp) * 16 + ch) : zero8;
#pragma unroll
            for (int nb = 0; nb < 4; ++nb) { const int dl = cb * 4 + nb - jp; bf[u][nb] = (on && dl >= 0) ? *(const bf16x8*)(KT + ((size_t)(g * 64 + dl) * 16 + r16) * 16 + ch) : zero8; }
        }
#pragma unroll
        for (int u = 0; u < 4; ++u)
#pragma unroll
            for (int nb = 0; nb < 4; ++nb) { acc[0][nb] = mfma16(af[u][0], bf[u][nb], acc[0][nb]); acc[1][nb] = mfma16(af[u][1], bf[u][nb], acc[1][nb]); }
    }
#pragma unroll
    for (int kb = 0; kb < 4; ++kb) {
        bf16x8 af[2];
#pragma unroll
        for (int rk = 0; rk < 2; ++rk) af[rk] = *(const bf16x8*)(HC + ((size_t)(wave * 32 + rk * 16 + r16) * 32 + g) * 128 + kb * 32 + quad * 8);
#pragma unroll
        for (int nb = 0; nb < 4; ++nb) { const bf16x8 bf = *(const bf16x8*)(MCT + ((size_t)g * 1024 + (cb * 4 + nb) * 16 + r16) * 128 + kb * 32 + quad * 8);
            acc[0][nb] = mfma16(af[0], bf, acc[0][nb]); acc[1][nb] = mfma16(af[1], bf, acc[1][nb]); }
    }
#pragma unroll
    for (int rk = 0; rk < 2; ++rk)
#pragma unroll
        for (int nb = 0; nb < 4; ++nb)
#pragma unroll
            for (int i = 0; i < 4; ++i) { const int chunk = wave * 32 + rk * 16 + quad * 4 + i, t = chunk * 64 + cb * 4 + nb;
                YS[(size_t)t * 512 + g * 16 + r16] = (bf16_t)f2bf(gelu_tanh_f(acc[rk][nb][i])); }
}

__device__ __forceinline__ void phase_final(const Args& a, int G) {
    const int tid = otid(), lane = tid & 63, wave = tid >> 6;
    const int gw = blockIdx.x * 8 + wave, NGW = G * 8;
    const unsigned long long* rss = (const unsigned long long*)(a.ws + WS_RSS) + (size_t)6 * T; const float* gf = a.in[I_FINN];
    for (int row = gw; row < T; row += NGW) {
        const float rinv = rsqrtf((float)rss[row] * (1.f / (16777216.f * DM)) + EPS);
        f32x4* xr = (f32x4*)(a.out + (size_t)row * DM) + lane; const f32x4* gr = (const f32x4*)gf + lane;
#pragma unroll
        for (int i = 0; i < 8; ++i) { f32x4 v = xr[64 * i]; const f32x4 gg = gr[64 * i]; v = v * rinv * gg; xr[64 * i] = v; }
    }
}


#define XB_TMO      128
#define XB_XCNT(j)  (256  + 64 * (j))
#define XB_XSUB(j)  (1280 + 64 * (j))
#define XB_XGEN(j)  (2304 + 64 * (j))
#define XB_TOP      3328
#define XB_TOPGEN   3392
#define XCD_BAR_WORDS 3456
#define XB_SPIN_CAP (1u << 18)
__device__ __forceinline__ unsigned xb_ld(unsigned* p)              { return __hip_atomic_load(p, __ATOMIC_RELAXED, __HIP_MEMORY_SCOPE_AGENT); }
__device__ __forceinline__ unsigned xb_add(unsigned* p, unsigned v) { return __hip_atomic_fetch_add(p, v, __ATOMIC_RELAXED, __HIP_MEMORY_SCOPE_AGENT); }
__device__ __forceinline__ unsigned xb_xcc_id() { return (unsigned)__builtin_amdgcn_s_getreg((3 << 11) | 20) & 0xFu; }
#define XB_SPIN(cond, bar) do { unsigned _sp = 0; while (cond) { __builtin_amdgcn_s_sleep(1); \
    if ((++_sp & 255u) == 0u) { if (xb_ld(&(bar)[XB_TMO])) break; if (_sp > XB_SPIN_CAP) { atomicAdd(&(bar)[XB_TMO], 1u); break; } } } } while (0)
struct XcdBarrier { unsigned* bar; unsigned x; volatile LAS unsigned* st; };
__device__ __forceinline__ XcdBarrier xcd_barrier_post(unsigned* bar, volatile LAS unsigned* st) {
    XcdBarrier b; b.bar = bar; b.x = xb_xcc_id(); b.st = st;
    if (threadIdx.x == 0) (void)xb_add(&bar[XB_XCNT(b.x)], 1u);
    return b;
}
__device__ __forceinline__ void xcd_barrier_complete(unsigned* bar, unsigned x, unsigned& nloc, unsigned& nx) {
    const unsigned G = gridDim.x * gridDim.y * gridDim.z;
    unsigned sum, cnt, mine, sp = 0u;
    for (;;) {
        sum = 0u; cnt = 0u; mine = 0u;
#pragma unroll
        for (unsigned j = 0; j < 16; ++j) { const unsigned c = xb_ld(&bar[XB_XCNT(j)]); sum += c; cnt += (c > 0u) ? 1u : 0u; mine = (j == x) ? c : mine; }
        if (sum == G) break;
        __builtin_amdgcn_s_sleep(1);
        if ((++sp & 255u) == 0u) { if (xb_ld(&bar[XB_TMO])) break; if (sp > XB_SPIN_CAP) { atomicAdd(&bar[XB_TMO], 1u); break; } }
    }
    nloc = mine > 0u ? mine : 1u; nx = cnt > 0u ? cnt : 1u;
}
__device__ __forceinline__ void xcd_barrier(const XcdBarrier& b) {
    asm volatile("s_waitcnt vmcnt(0)" ::: "memory");
    __syncthreads();
    if (threadIdx.x == 0) {
        unsigned* bar = b.bar;
        __builtin_amdgcn_s_waitcnt(0);
        unsigned nloc = b.st[0], nx = b.st[1];
        if (nloc == 0u) { xcd_barrier_complete(bar, b.x, nloc, nx); b.st[0] = nloc; b.st[1] = nx; }
        const unsigned old = xb_add(&bar[XB_XSUB(b.x)], 1u);
        const unsigned gen = old / nloc;
        if (old + 1u == (gen + 1u) * nloc) {
            __builtin_amdgcn_fence(__ATOMIC_RELEASE, "agent");
            asm volatile("s_waitcnt vmcnt(0)" ::: "memory");
            const unsigned og = xb_add(&bar[XB_TOP], 1u);
            const unsigned tg = og / nx;
            if (og + 1u == (tg + 1u) * nx) xb_add(&bar[XB_TOPGEN], 1u);
            else XB_SPIN(xb_ld(&bar[XB_TOPGEN]) == tg, bar);
            __builtin_amdgcn_fence(__ATOMIC_ACQUIRE, "agent");
            xb_add(&bar[XB_XGEN(b.x)], 1u);
            asm volatile("s_waitcnt vmcnt(0)" ::: "memory");
        } else {
            XB_SPIN(xb_ld(&bar[XB_XGEN(b.x)]) == gen, bar);
            __builtin_amdgcn_fence(__ATOMIC_ACQUIRE, "agent");
            asm volatile("s_waitcnt vmcnt(0)" ::: "memory");
        }
    }
    __syncthreads();
}

constexpr int PH_PER_LAYER = 12, N_PHASES = 2 * PH_PER_LAYER + 1;

__global__ void __launch_bounds__(512, 2) mega_fwd(Args a) {
    extern __shared__ __attribute__((aligned(16))) unsigned char lds[];
    cg::grid_group grid = cg::this_grid();
    constexpr int G = 256;
    unsigned char* ws = a.ws;
    LAS unsigned char* ldsl = (LAS unsigned char*)lds;
    unsigned long long* rssb = (unsigned long long*)(ws + WS_RSS);
    volatile LAS unsigned* bst = (volatile LAS unsigned*)(ldsl + (LDS_BYTES - 64));
    if (threadIdx.x < 2) bst[threadIdx.x] = 0u;
    __syncthreads();
    XcdBarrier bar = xcd_barrier_post((unsigned*)(ws + WS_BAR), bst);
#if !MK_MULTI_LAUNCH
    if (a.ph_hi - a.ph_lo > 1) grid.sync();
#endif
    for (int ph = a.ph_lo; ph < a.ph_hi; ++ph) {
        if (ph != a.ph_lo) {
            xcd_barrier(bar);
#ifdef PROBE_SYNC
            for (int q = 0; q < 4; ++q) xcd_barrier(bar);
#endif
        }
        if (ph == N_PHASES - 1) { phase_final(a, G); continue; }
        const int l = ph / PH_PER_LAYER, k = ph % PH_PER_LAYER;
#ifdef PROBE_K
        for (int rep = 0; rep < ((k == PROBE_K) ? 2 : 1); ++rep) {
        if (rep) xcd_barrier(bar);
#endif
        if (k == 0) {
#ifndef NO_PREP
            phase_prep(a, l, lds, G);
#endif
        } else if (k == 1 || k == 10) {
            const int second = (k == 10);
            pg8::Gemm g{(const bf16_t*)(ws + WS_XB), (const bf16_t*)(ws + (second ? WS_W2U : WS_W1U)), T, 2 * FF, DM, DM, DM};
            pg8::StaticOrder S; S.init(T, 2 * FF, G, (int)blockIdx.x);
            pg8::EpiFfnUp E{(bf16_t*)(ws + WS_Z), rssb + (size_t)(3 * l + (second ? 2 : 0)) * T};
            pg8::gemm_phase(ldsl, g, S, E);
        } else if (k == 2 || k == 11) {
            const int second = (k == 11);
            pg8::Gemm g{(const bf16_t*)(ws + WS_Z), (const bf16_t*)(ws + (second ? WS_W2D : WS_W1D)), T, DM, FF, FF, FF};
            pg8::StaticOrder S; S.init(T, DM, G, (int)blockIdx.x);
            const float* xin = (l == 0 && !second) ? a.in[I_X] : a.out;
            pg8::EpiResid E{xin, a.out, (bf16_t*)(ws + WS_XB), rssb + (size_t)(3 * l + (second ? 3 : 1)) * T, 0.5f};
            pg8::gemm_phase(ldsl, g, S, E);
        } else if (k == 3) {
            pg8::Gemm g{(const bf16_t*)(ws + WS_XB), (const bf16_t*)(ws + WS_WIN), T, ZW, DM, DM, DM};
            pg8::StaticOrder S; S.init(T, ZW, G, (int)blockIdx.x);
            pg8::EpiWin E{(bf16_t*)(ws + WS_Z), rssb + (size_t)(3 * l + 1) * T, (bf16_t*)(ws + WS_XS)};
            pg8::gemm_phase(ldsl, g, S, E);
#ifndef NO_GLR
            phase_glr(a, rssb + (size_t)(3 * l + 1) * T, G);
#endif
        } else if (k == 4) {
#ifndef NO_GLA
            for (int u = blockIdx.x; u < 1024; u += G) gla_kv_unit(a, l, lds, u);
#ifdef PROBE_GLA1
            for (int u = blockIdx.x; u < 1024; u += G) gla_kv_unit(a, l, lds, u);
#endif
#endif
#ifndef NO_SSM
            for (int u = G - 1 - (int)blockIdx.x; u < 128; u += G) ssm_end_unit(a, u);
#endif
#ifndef NO_POOL
            phase_pool(a, G);
#endif
        } else if (k == 5) {
#ifndef NO_GLA
#ifdef PROBE_SCAN
            gla_scan(a, G, WS_MB);
#endif
            gla_scan(a, G);
#endif
#ifndef NO_SSM
            { const int id = (G - 1 - (int)blockIdx.x) * 512 + otid(); if (id < 8192) ssm_scan(a, id); }
#endif
        } else if (k == 6) {
#ifndef NO_GLA
            for (int u = blockIdx.x; u < 1024; u += G) gla_out_unit(a, l, lds, u);
#ifdef PROBE_GLA3
            for (int u = blockIdx.x; u < 1024; u += G) gla_out_unit(a, l, lds, u);
#endif
#endif
#ifndef NO_SSM
            ssm_out_unit(a, (int)blockIdx.x); ssm_out_unit(a, 256 + ((int)blockIdx.x ^ 15));
#ifdef PROBE_SSM3
            for (int u = blockIdx.x; u < 512; u += G) ssm_out_unit(a, u);
#endif
#endif
        } else if (k == 7) {
            pg8::Gemm g{(const bf16_t*)(ws + WS_YS), (const bf16_t*)(ws + WS_WGLU), T, 512, 512, 512, 512};
            pg8::StaticOrder S; S.init(T, 512, G, (int)blockIdx.x);
            pg8::EpiGlu E{(const bf16_t*)(ws + WS_YS), (bf16_t*)(ws + WS_Y)};
            pg8::gemm_phase(ldsl, g, S, E);
        } else if (k == 8) {
            const bf16_t* Y = (const bf16_t*)(ws + WS_Y); const bf16_t* Wb = (const bf16_t*)(ws + WS_WBR); const bf16_t* Zg = (const bf16_t*)(ws + WS_Z) + ZC_G;
            pg8::BranchOrder S; S.init(T, DM, G, (int)blockIdx.x);
            pg8::Gemm g{Y, Wb, T, DM, DM, DM, DM}; pg8::EpiBranch E{Zg, (bf16_t*)(ws + WS_MB)};
            pg8::gemm_phase(ldsl, g, S, E);
        } else if (k == 9) {
            pg8::Gemm g{(const bf16_t*)(ws + WS_MB), (const bf16_t*)(ws + WS_WO), T, DM, DM, DM, DM};
            pg8::StaticOrder S; S.init(T, DM, G, (int)blockIdx.x);
            pg8::EpiResid E{a.out, a.out, (bf16_t*)(ws + WS_XB), rssb + (size_t)(3 * l + 2) * T, 1.0f};
            pg8::gemm_phase(ldsl, g, S, E);
        }
#ifdef PROBE_K
        }
#endif
    }
}

extern "C" void kernel_launch(void* const* d_in, const int* in_sizes, int n_in, void* d_out, int out_size, void* d_ws, size_t ws_size, hipStream_t stream) {
    static int grid = 0;
    if (grid == 0) {
        if (n_in != 28 || in_sizes[0] != T * DM || out_size != T * DM || ws_size < WS_END) {
            fprintf(stderr, "kernel_launch: unexpected problem (n_in %d, in0 %d, out %d, ws %zu, need %zu)\n", n_in, n_in > 0 ? in_sizes[0] : -1, out_size, ws_size, (size_t)WS_END);
            grid = -1; return;
        }
        int dev = 0, cus = 0, per_cu = 0;
        hipGetDevice(&dev);
        hipDeviceGetAttribute(&cus, hipDeviceAttributeMultiprocessorCount, dev);
        hipFuncSetAttribute((const void*)mega_fwd, hipFuncAttributeMaxDynamicSharedMemorySize, LDS_BYTES);
        hipOccupancyMaxActiveBlocksPerMultiprocessor(&per_cu, (const void*)mega_fwd, 512, LDS_BYTES);
        if (per_cu < 1) per_cu = 1;
        if (per_cu > 1) per_cu = 1;
        grid = 256;
        if (cus * per_cu < 256) { fprintf(stderr, "kernel_launch: needs 256 co-resident workgroups (have %d x %d)\n", cus, per_cu); grid = -1; return; }
        (void)hipGetLastError();
    }
    if (grid < 0) return;
    Args a{};
    for (int i = 0; i < 28; ++i) a.in[i] = (const float*)d_in[i];
    a.out = (float*)d_out; a.ws = (unsigned char*)d_ws;
    (void)hipMemsetAsync((char*)d_ws + WS_BAR, 0, 16384, stream);
#if MK_MULTI_LAUNCH
    for (int ph = 0; ph < N_PHASES; ++ph) {
        a.ph_lo = ph; a.ph_hi = ph + 1;
        hipLaunchKernelGGL(mega_fwd, dim3(grid), dim3(512), LDS_BYTES, stream, a);
    }
#else
    a.ph_lo = 0; a.ph_hi = N_PHASES;
    void* args[] = {&a};
    hipError_t e = hipLaunchCooperativeKernel((const void*)mega_fwd, dim3(grid), dim3(512), args, LDS_BYTES, stream);
    if (e != hipSuccess) fprintf(stderr, "cooperative launch failed: %s (grid %d)\n", hipGetErrorString(e), grid);
#endif
}
```

```cpp
#include <hip/hip_runtime.h>
#include <hip/hip_cooperative_groups.h>
#include <cstdio>
#include <cstdint>
namespace cg = cooperative_groups;

#ifndef MK_MULTI_LAUNCH
#define MK_MULTI_LAUNCH 0
#endif

#define LAS __attribute__((address_space(3)))
typedef unsigned short bf16_t;
typedef short bf16x8 __attribute__((ext_vector_type(8)));
typedef float f32x4 __attribute__((ext_vector_type(4)));
typedef unsigned u32x4 __attribute__((ext_vector_type(4)));
typedef unsigned u32x2 __attribute__((ext_vector_type(2)));

constexpr int T = 16384, DM = 2048, FF = 5632, SEQ = 4096;
constexpr int ZW = 10240;
constexpr int ZC_POOL = 0, ZC_Q = 512, ZC_K = 1024, ZC_V = 1536, ZC_R = 2560, ZC_S = 3584, ZC_G = 4096;
constexpr int YC_GLA = 512, YC_SSM = 1536;
constexpr int INW = 10256;
constexpr float EPS = 1e-6f;

constexpr size_t MiB = 1u << 20;
constexpr size_t WS_RSS = 0;
constexpr size_t WS_BAR = 917504;
constexpr size_t WS_WGT = 1 * MiB;
constexpr size_t WS_L64 = 1 * MiB + 131072;
constexpr size_t WS_GLR = 2 * MiB;
constexpr size_t WS_DEC = 3 * MiB;
constexpr size_t WS_KT = 4 * MiB;
constexpr size_t WS_E = 5 * MiB;
constexpr size_t WS_HC = 9 * MiB;
constexpr size_t WS_MET = 11 * MiB;
constexpr size_t WS_MCT = 19 * MiB;
constexpr size_t WS_YS = 27 * MiB;
constexpr size_t WS_W1U = 43 * MiB, WS_W1D = 87 * MiB, WS_WIN = 109 * MiB, WS_WBR = 149 * MiB, WS_WO = 157 * MiB, WS_WGLU = 165 * MiB;
constexpr size_t WS_W2U = 166 * MiB, WS_W2D = 210 * MiB;
constexpr size_t WS_XB = 232 * MiB, WS_Y = 296 * MiB, WS_MB = 360 * MiB, WS_KV = 424 * MiB, WS_Z = 488 * MiB, WS_BCG = 808 * MiB, WS_XS = 840 * MiB, WS_END = 856 * MiB;

constexpr int LDS_BYTES = 147456;

typedef __bf16 bf16v2_t __attribute__((ext_vector_type(2)));
typedef float f32v2_t __attribute__((ext_vector_type(2)));
__device__ __forceinline__ unsigned pk2(float lo, float hi) { const f32v2_t v = {lo, hi}; const bf16v2_t b = __builtin_convertvector(v, bf16v2_t); return __builtin_bit_cast(unsigned, b); }
__device__ __forceinline__ unsigned f2bf(float f) { return pk2(f, 0.f) & 0xffffu; }
__device__ __forceinline__ float bf2f(unsigned short b) { return __uint_as_float(((unsigned)b) << 16); }
__device__ __forceinline__ float bflo(unsigned w) { return __uint_as_float(w << 16); }
__device__ __forceinline__ float bfhi(unsigned w) { return __uint_as_float(w & 0xffff0000u); }
__device__ __forceinline__ float wave_sum(float v) {
#pragma unroll
    for (int o = 1; o < 64; o <<= 1) v += __shfl_xor(v, o);
    return v;
}
__device__ __forceinline__ float sigmoid_f(float x) { return __builtin_amdgcn_rcpf(1.f + __expf(-x)); }
__device__ __forceinline__ float gelu_tanh_f(float x) {
    const float u = 0.7978845608028654f * (x + 0.044715f * x * x * x);
    const float t = 1.f - 2.f * __builtin_amdgcn_rcpf(1.f + __expf(2.f * u));
    return 0.5f * x * (1.f + t);
}
#define LDS_WAIT() asm volatile("s_waitcnt lgkmcnt(0)" ::: "memory")
__device__ __forceinline__ int otid() { int t = threadIdx.x; asm volatile("" : "+v"(t)); return t; }
__device__ __forceinline__ f32x4 mfma16(bf16x8 a, bf16x8 b, f32x4 c) { return __builtin_amdgcn_mfma_f32_16x16x32_bf16(a, b, c, 0, 0, 0); }

#ifndef PG8_AUX
#define PG8_AUX 0
#endif
#ifndef PG8_WGM
#define PG8_WGM 4
#endif
#ifndef NO_NT_OUT
#define ST_OUT(p, v) __builtin_nontemporal_store((v), (p))
#else
#define ST_OUT(p, v) (*(p) = (v))
#endif
#ifdef NT_OUT2
#define ST_OUT2(p, v) __builtin_nontemporal_store((v), (p))
#else
#define ST_OUT2(p, v) (*(p) = (v))
#endif
namespace pg8 {
constexpr int BM = 256, BK = 64, HALF = 128, HTB = HALF * BK * 2, STAGE_BYTES = 8 * HTB, NXCD = 8, WGM = PG8_WGM;
__host__ __device__ __forceinline__ int lds_byte(int r, int c) { const int st = (r >> 4) * 2 + (c >> 5), rr = r & 15, cc = c & 31, ob = rr * 64 + cc * 2; return st * 1024 + (ob ^ (((ob >> 9) & 1) << 5)); }
__host__ __device__ __forceinline__ void stage_rc(int b, int& R, int& C) { const int st = b / 1024, sb = b % 1024, swz = sb ^ (((sb >> 9) & 1) << 5); R = (st >> 1) * 16 + swz / 64; C = (st & 1) * 32 + (swz % 64) / 2; }
__host__ __device__ __forceinline__ int perm32(int rho) { const int n = rho >> 4, i = rho & 15; return 8 * (i >> 2) + 4 * n + (i & 3); }

struct Unit { int pm, pn, seg; };
struct Gemm { const bf16_t* A; const bf16_t* Bt; int M, N, K, lda, ldb; int fix = 0; };

struct StaticOrder {
    static constexpr bool SEGMENTED = false;
    int nM, nN, nwg, G, c;
    __device__ __forceinline__ int koff(const Unit&) const { return 0; }
    __device__ __forceinline__ int nt(const Unit&) const { return 0; }
    __device__ void init(int M, int N, int G_, int c_) { nM = M / BM; nN = N / BM; nwg = nM * nN; G = G_; c = c_; }
    __device__ bool next(int i, Unit& u) const {
        const long L = (long)i * G + c; if (L >= nwg) return false;
        int wgid = (int)L; { const int q = nwg / NXCD, r = nwg % NXCD, xcd = wgid % NXCD, off = wgid / NXCD; wgid = (xcd < r ? xcd * (q + 1) : r * (q + 1) + (xcd - r) * q) + off; }
        const int nig = WGM * nN, gid = wgid / nig, fm = gid * WGM, gsz = (nM - fm) < WGM ? (nM - fm) : WGM;
        u.pm = fm + ((wgid % nig) % gsz); u.pn = (wgid % nig) / gsz; u.seg = 0; return true;
    }
};
struct BranchOrder : StaticOrder {
    static constexpr bool SEGMENTED = true;
    __device__ bool next(int i, Unit& u) const { const bool ok = StaticOrder::next(i / 3, u); u.seg = i % 3; return ok; }
    __device__ __forceinline__ int koff(const Unit& u) const { return u.seg == 0 ? 0 : (u.seg == 1 ? 512 : 1536); }
    __device__ __forceinline__ int nt(const Unit& u) const { return u.seg == 1 ? 16 : 8; }
};

template <class Epi, class Sched>
__device__ __forceinline__ void gemm_phase(LAS unsigned char* lds, const Gemm g, const Sched& S, const Epi& E) {
    const int tid = otid(), wid = __builtin_amdgcn_readfirstlane(tid >> 6), lane = tid & 63, wr = wid >> 2, wc = wid & 3, fr = lane & 15, fq = lane >> 4;
    unsigned voffA[2], voffB[2];
#pragma unroll
    for (int i = 0; i < 2; ++i) { int R, C; stage_rc(tid * 16 + i * 8192, R, C); const int Rb = (R & ~31) + perm32(R & 31);
        voffA[i] = (unsigned)(R * g.lda + C) * 2u; voffB[i] = (unsigned)(Rb * g.ldb + C) * 2u; }
    const size_t kstep = (size_t)(BK * 2);
    const size_t hstepA = (size_t)HALF * g.lda * 2, hstepB = (size_t)HALF * g.ldb * 2;
    const size_t tstepA = 2 * hstepA, tstepB = 2 * hstepB;
    const unsigned ldsw = (unsigned)wid * 1024u;
    const int aoff = lds_byte(wr * 64 + fr, fq * 8), boff = lds_byte(wc * 32 + fr, fq * 8);
#define PG8_SA(b, h) (((b) * 2 + (h)) * HTB)
#define PG8_SB(b, h) ((4 + (b) * 2 + (h)) * HTB)
#define PG8_STAGE(bufoff, gbase, voff) do { _Pragma("unroll") for (int _i = 0; _i < 2; ++_i) \
        __builtin_amdgcn_global_load_lds((const unsigned*)((const char*)(gbase) + (voff)[_i]), (LAS unsigned*)(lds + (bufoff) + ldsw + _i * 8192), 16, 0, PG8_AUX); } while (0)
#define PG8_LDA(dst, b, h) do { _Pragma("unroll") for (int m = 0; m < 4; ++m) _Pragma("unroll") for (int k = 0; k < 2; ++k) dst[m][k] = *(const LAS bf16x8*)(lds + PG8_SA(b, h) + aoff + m * 2048 + k * 1024); } while (0)
#define PG8_LDB(dst, b, h) do { _Pragma("unroll") for (int n = 0; n < 2; ++n) _Pragma("unroll") for (int k = 0; k < 2; ++k) dst[n][k] = *(const LAS bf16x8*)(lds + PG8_SB(b, h) + boff + n * 2048 + k * 1024); } while (0)
#define PG8_MMA(ai, bj, At, Bt) do { __builtin_amdgcn_s_setprio(1); _Pragma("unroll") for (int m = 0; m < 4; ++m) _Pragma("unroll") for (int n = 0; n < 2; ++n) _Pragma("unroll") for (int k = 0; k < 2; ++k) \
        acc[ai][bj][m][n] = __builtin_amdgcn_mfma_f32_16x16x32_bf16(Bt[n][k], At[m][k], acc[ai][bj][m][n], 0, 0, 0); __builtin_amdgcn_s_setprio(0); } while (0)
#define PG8_WAIT_V(n) asm volatile("s_waitcnt vmcnt(" #n ")" ::: "memory")
#define PG8_WAIT_L(n) asm volatile("s_waitcnt lgkmcnt(" #n ")" ::: "memory")
#define PG8_BAR __builtin_amdgcn_s_barrier()
#define PG8_SCHED __builtin_amdgcn_sched_barrier(0)
    Unit cur, nxt; int ui = 0;
    if (!S.next(0, cur)) return;
    f32x4 acc[2][2][4][2];
#pragma unroll
    for (int a = 0; a < 2; ++a)
#pragma unroll
        for (int b = 0; b < 2; ++b)
#pragma unroll
            for (int m = 0; m < 4; ++m)
#pragma unroll
                for (int n = 0; n < 2; ++n) acc[a][b][m][n] = (f32x4){0.f, 0.f, 0.f, 0.f};
    bf16x8 At[4][2], B0[2][2], B1[2][2];
    int nt = Sched::SEGMENTED ? S.nt(cur) : g.K / BK;
    const char* cA = (const char*)g.A + (size_t)(g.fix ? 0 : cur.pm) * tstepA + (size_t)S.koff(cur) * 2; const char* cB = (const char*)g.Bt + (size_t)(g.fix ? 0 : cur.pn) * tstepB + (size_t)S.koff(cur) * 2;
    PG8_STAGE(PG8_SB(0, 0), cB, voffB); PG8_STAGE(PG8_SB(0, 1), cB + hstepB, voffB); PG8_STAGE(PG8_SA(0, 0), cA, voffA); PG8_STAGE(PG8_SA(0, 1), cA + hstepA, voffA);
    if (wr == 1) PG8_BAR;
    PG8_WAIT_V(2); PG8_BAR;
    PG8_STAGE(PG8_SB(1, 0), cB + kstep, voffB); PG8_STAGE(PG8_SA(1, 0), cA + kstep, voffA); PG8_STAGE(PG8_SB(1, 1), cB + hstepB + kstep, voffB);
    PG8_WAIT_V(6); PG8_BAR;
    for (;;) {
        const bool has_next = S.next(ui + 1, nxt);
        const char* nA = has_next ? (const char*)g.A + (size_t)(g.fix ? 0 : nxt.pm) * tstepA + (size_t)S.koff(nxt) * 2 : cA; const char* nB = has_next ? (const char*)g.Bt + (size_t)(g.fix ? 0 : nxt.pn) * tstepB + (size_t)S.koff(nxt) * 2 : cB;
        for (int t = 0; t < nt; t += 2) {
            const bool last = (t == nt - 2);
            const char* a1 = cA + (size_t)(t + 1) * kstep;
            const char* a2 = last ? nA : cA + (size_t)(t + 2) * kstep; const char* b2 = last ? nB : cB + (size_t)(t + 2) * kstep;
            const char* a3 = a2 + kstep; const char* b3 = b2 + kstep;
            PG8_LDB(B0, 0, 0); PG8_LDB(B1, 0, 1); PG8_SCHED; PG8_LDA(At, 0, 0); PG8_STAGE(PG8_SA(1, 1), a1 + hstepA, voffA);
            PG8_WAIT_V(8); PG8_WAIT_L(0); PG8_BAR; PG8_MMA(0, 0, At, B0); PG8_MMA(0, 1, At, B1); PG8_BAR; PG8_SCHED;
            PG8_LDA(At, 0, 1); PG8_STAGE(PG8_SB(0, 0), b2, voffB); PG8_STAGE(PG8_SB(0, 1), b2 + hstepB, voffB); PG8_STAGE(PG8_SA(0, 0), a2, voffA);
            PG8_WAIT_V(8); PG8_WAIT_L(0); PG8_BAR; PG8_MMA(1, 0, At, B0); PG8_MMA(1, 1, At, B1); PG8_BAR; PG8_SCHED;
            PG8_LDB(B0, 1, 0); PG8_LDB(B1, 1, 1); PG8_SCHED; PG8_LDA(At, 1, 0); PG8_STAGE(PG8_SA(0, 1), a2 + hstepA, voffA);
            PG8_WAIT_V(8); PG8_WAIT_L(0); PG8_BAR; PG8_MMA(0, 0, At, B0); PG8_MMA(0, 1, At, B1); PG8_BAR; PG8_SCHED;
            PG8_LDA(At, 1, 1); PG8_STAGE(PG8_SB(1, 0), b3, voffB); PG8_STAGE(PG8_SB(1, 1), b3 + hstepB, voffB); PG8_STAGE(PG8_SA(1, 0), a3, voffA);
            PG8_WAIT_V(8); PG8_WAIT_L(0); PG8_BAR; PG8_MMA(1, 0, At, B0); PG8_MMA(1, 1, At, B1); PG8_BAR; PG8_SCHED;
        }
#ifndef NO_ALIGN
        if (wr == 0) PG8_BAR;
#endif
        E(acc, cur, wr, wc, fr, fq);
        if (!has_next) break;
#pragma unroll
        for (int a = 0; a < 2; ++a)
#pragma unroll
            for (int b = 0; b < 2; ++b)
#pragma unroll
                for (int m = 0; m < 4; ++m)
#pragma unroll
                    for (int n = 0; n < 2; ++n) acc[a][b][m][n] = (f32x4){0.f, 0.f, 0.f, 0.f};
        cur = nxt; cA = nA; cB = nB; ++ui;
        if (Sched::SEGMENTED) nt = S.nt(cur);
#ifndef NO_ALIGN
        if (wr == 1) PG8_BAR;
#endif
    }
    PG8_WAIT_V(0);
#ifdef NO_ALIGN
    if (wr == 0) PG8_BAR;
#endif
    PG8_BAR;
#undef PG8_SA
#undef PG8_SB
#undef PG8_STAGE
#undef PG8_LDA
#undef PG8_LDB
#undef PG8_MMA
#undef PG8_WAIT_V
#undef PG8_WAIT_L
#undef PG8_BAR
#undef PG8_SCHED
}

typedef const f32x4 (&AccRef)[2][2][4][2];

struct EpiFfnUp {
    bf16_t* H; const unsigned long long* rss;
    __device__ __forceinline__ void operator()(AccRef acc, const Unit& u, int wr, int wc, int fr, int fq) const {
        const int row0 = u.pm * BM + wr * 64 + fr, col0 = u.pn * 128 + wc * 32 + 8 * fq;
#pragma unroll
        for (int ai = 0; ai < 2; ++ai)
#pragma unroll
            for (int m = 0; m < 4; ++m) {
                const int row = row0 + ai * HALF + m * 16;
                const float rinv = rsqrtf((float)rss[row] * (1.f / (16777216.f * DM)) + EPS);
                float h[8];
#pragma unroll
                for (int n = 0; n < 2; ++n)
#pragma unroll
                    for (int j = 0; j < 4; ++j) { const float gg = acc[ai][0][m][n][j] * rinv, uu = acc[ai][1][m][n][j] * rinv; h[n * 4 + j] = gg * uu * sigmoid_f(gg); }
                u32x4 o; o.x = pk2(h[0], h[1]); o.y = pk2(h[2], h[3]); o.z = pk2(h[4], h[5]); o.w = pk2(h[6], h[7]);
                ST_OUT((u32x4*)(H + (size_t)row * FF + col0), o);
            }
    }
};
struct EpiWin {
    bf16_t* Z; const unsigned long long* rss; bf16_t* XS;
    __device__ __forceinline__ void operator()(AccRef acc, const Unit& u, int wr, int wc, int fr, int fq) const {
        const int row0 = u.pm * BM + wr * 64 + fr, col0 = u.pn * BM + wc * 32 + 8 * fq;
        const bool sg = u.pn >= 16;
        const bool ssm = (u.pn == 14) | (u.pn == 15);
        const int cs = col0 - ZC_S;
        bf16_t* const dst = ssm ? XS + (size_t)(cs >> 4) * T * 16 + (cs & 15) : Z + col0; const size_t pitch = ssm ? 16 : ZW; const size_t bjstep = ssm ? (size_t)8 * T * 16 : (size_t)HALF;
#pragma unroll
        for (int ai = 0; ai < 2; ++ai)
#pragma unroll
            for (int m = 0; m < 4; ++m) {
                const int row = row0 + ai * HALF + m * 16;
                const float rinv = rsqrtf((float)rss[row] * (1.f / (16777216.f * DM)) + EPS);
#pragma unroll
                for (int bj = 0; bj < 2; ++bj) {
                    float h[8];
#pragma unroll
                    for (int n = 0; n < 2; ++n)
#pragma unroll
                        for (int j = 0; j < 4; ++j) { const float v = acc[ai][bj][m][n][j] * rinv; h[n * 4 + j] = sg ? sigmoid_f(v) : v; }
                    u32x4 o; o.x = pk2(h[0], h[1]); o.y = pk2(h[2], h[3]); o.z = pk2(h[4], h[5]); o.w = pk2(h[6], h[7]);
                    ST_OUT((u32x4*)(dst + (size_t)row * pitch + bj * bjstep), o);
                }
            }
    }
};
struct EpiResid {
    const float* xin; float* xout; bf16_t* XB; unsigned long long* rssn; float scale; int wxb;
    __device__ __forceinline__ void operator()(AccRef acc, const Unit& u, int wr, int wc, int fr, int fq) const {
        const int row0 = u.pm * BM + wr * 64 + fr, col0 = u.pn * BM + wc * 32 + 8 * fq;
#pragma unroll
        for (int ai = 0; ai < 2; ++ai)
#pragma unroll
            for (int m = 0; m < 4; ++m) {
                const int row = row0 + ai * HALF + m * 16;
                float ss = 0.f;
#pragma unroll
                for (int bj = 0; bj < 2; ++bj) {
                    const size_t off = (size_t)row * DM + col0 + bj * HALF;
                    f32x4 x0 = *(const f32x4*)(xin + off), x1 = *(const f32x4*)(xin + off + 4);
                    x0 = x0 + acc[ai][bj][m][0] * scale; x1 = x1 + acc[ai][bj][m][1] * scale;
                    ST_OUT2((f32x4*)(xout + off), x0); ST_OUT2((f32x4*)(xout + off + 4), x1);
                    u32x4 o; o.x = pk2(x0[0], x0[1]); o.y = pk2(x0[2], x0[3]); o.z = pk2(x1[0], x1[1]); o.w = pk2(x1[2], x1[3]);
                    if (wxb) ST_OUT2((u32x4*)(XB + off), o);
                    ss += x0[0] * x0[0] + x0[1] * x0[1] + x0[2] * x0[2] + x0[3] * x0[3] + x1[0] * x1[0] + x1[1] * x1[1] + x1[2] * x1[2] + x1[3] * x1[3];
                }
                ss += __shfl_xor(ss, 16); ss += __shfl_xor(ss, 32);
                if (fq == 0) atomicAdd(rssn + row, (unsigned long long)(ss * 16777216.f));
            }
    }
};
struct EpiBranch {
    const bf16_t* G0; bf16_t* MB;
    __device__ __forceinline__ void operator()(AccRef acc, const Unit& u, int wr, int wc, int fr, int fq) const {
        const int row0 = u.pm * BM + wr * 64 + fr, col0 = u.pn * BM + wc * 32 + 8 * fq;
        const bf16_t* G = G0 + u.seg * 2048; const bool accum = u.seg > 0;
#pragma unroll
        for (int ai = 0; ai < 2; ++ai)
#pragma unroll
            for (int m = 0; m < 4; ++m) {
                const int row = row0 + ai * HALF + m * 16;
#pragma unroll
                for (int bj = 0; bj < 2; ++bj) {
                    const int col = col0 + bj * HALF;
                    const u32x4 gv = *(const u32x4*)(G + (size_t)row * ZW + col);
                    u32x4 pv = (u32x4){0u, 0u, 0u, 0u};
                    if (accum) pv = *(const u32x4*)(MB + (size_t)row * DM + col);
                    const f32x4 a0 = acc[ai][bj][m][0], a1 = acc[ai][bj][m][1];
                    u32x4 o;
                    o.x = pk2(bflo(pv.x) + bflo(gv.x) * a0[0], bfhi(pv.x) + bfhi(gv.x) * a0[1]);
                    o.y = pk2(bflo(pv.y) + bflo(gv.y) * a0[2], bfhi(pv.y) + bfhi(gv.y) * a0[3]);
                    o.z = pk2(bflo(pv.z) + bflo(gv.z) * a1[0], bfhi(pv.z) + bfhi(gv.z) * a1[1]);
                    o.w = pk2(bflo(pv.w) + bflo(gv.w) * a1[2], bfhi(pv.w) + bfhi(gv.w) * a1[3]);
                    *(u32x4*)(MB + (size_t)row * DM + col) = o;
                }
            }
    }
};
struct EpiGlu {
    const bf16_t* YS; bf16_t* Y;
    __device__ __forceinline__ void operator()(AccRef acc, const Unit& u, int wr, int wc, int fr, int fq) const {
        const int row0 = u.pm * BM + wr * 64 + fr, col0 = u.pn * BM + wc * 32 + 8 * fq;
#pragma unroll
        for (int ai = 0; ai < 2; ++ai)
#pragma unroll
            for (int m = 0; m < 4; ++m) {
                const int row = row0 + ai * HALF + m * 16;
#pragma unroll
                for (int bj = 0; bj < 2; ++bj) {
                    const int col = col0 + bj * HALF;
                    const u32x4 yv = *(const u32x4*)(YS + (size_t)row * 512 + col);
                    const f32x4 a0 = acc[ai][bj][m][0], a1 = acc[ai][bj][m][1];
                    u32x4 o;
                    o.x = pk2(bflo(yv.x) * sigmoid_f(a0[0]), bfhi(yv.x) * sigmoid_f(a0[1]));
                    o.y = pk2(bflo(yv.y) * sigmoid_f(a0[2]), bfhi(yv.y) * sigmoid_f(a0[3]));
                    o.z = pk2(bflo(yv.z) * sigmoid_f(a1[0]), bfhi(yv.z) * sigmoid_f(a1[1]));
                    o.w = pk2(bflo(yv.w) * sigmoid_f(a1[2]), bfhi(yv.w) * sigmoid_f(a1[3]));
                    *(u32x4*)(Y + (size_t)row * DM + YC_SSM + col) = o;
                }
            }
    }
};
}

struct Args { const float* in[28]; float* out; unsigned char* ws; int ph_lo, ph_hi; };
enum { I_X = 0, I_F1N, I_F1G, I_F1U, I_F1D, I_MIXN, I_WIN, I_POOLW, I_POOLS, I_GW2, I_GB, I_GNORM, I_ARE, I_AIM, I_LDT, I_BRE, I_BIM, I_CRE, I_CIM,
       I_SD, I_WGLU, I_WBR, I_WOUT, I_F2N, I_F2G, I_F2U, I_F2D, I_FINN };

__device__ __forceinline__ void tr_item(const float* W, int ldw, int col0, const float* ksc, bf16_t* WT, int ldt, int drow, int k0, int n0, unsigned* scr, int lane) {
    const int a = lane & 15, b = lane >> 4;
    const float* src = W + (size_t)(k0 + 2 * b) * ldw + col0 + n0 + a * 4;
    f32x4 v[16];
#pragma unroll
    for (int m = 0; m < 8; ++m) { v[2 * m] = *(const f32x4*)(src + (size_t)(8 * m) * ldw); v[2 * m + 1] = *(const f32x4*)(src + (size_t)(8 * m + 1) * ldw); }
#pragma unroll
    for (int m = 0; m < 8; ++m) {
        const float s0 = ksc ? ksc[k0 + 8 * m + 2 * b] : 1.f, s1 = ksc ? ksc[k0 + 8 * m + 2 * b + 1] : 1.f;
#pragma unroll
        for (int e = 0; e < 4; ++e) scr[(4 * a + e) * 32 + (((m ^ (a & 7)) << 2) | b)] = pk2(v[2 * m][e] * s0, v[2 * m + 1][e] * s1);
    }
    LDS_WAIT();
#pragma unroll
    for (int j = 0; j < 8; ++j) { const int n = (lane >> 3) + 8 * j, c = lane & 7;
        const u32x4 o = *(const u32x4*)(scr + n * 32 + ((c ^ ((n >> 2) & 7)) << 2));
        *(u32x4*)(WT + (size_t)(drow + n) * ldt + k0 + c * 8) = o; }
    LDS_WAIT();
}
__device__ __forceinline__ bool tr_try(int& r, const float* W, int ldw, int K, int N, int col0, const float* ksc, bf16_t* WT, int ldt, int drow0, int mode, unsigned* scr, int lane) {
    const int nblk = N / 64, items = (K / 64) * nblk;
    if (r >= items) { r -= items; return false; }
    const int kb = r / nblk, n0 = (r % nblk) * 64;
    const int drow = drow0 + (mode ? ((n0 >> 7) * 256 + (n0 & 127)) : n0);
    tr_item(W, ldw, col0, ksc, WT, ldt, drow, kb * 64, n0, scr, lane);
    return true;
}

__device__ __forceinline__ void cpow_d(double th, double la, int j, double& pr, double& pi) {
    const double y = th * (double)j;
    const double kq = __builtin_rint(y * 0.63661977236758134308);
    double r = __builtin_fma(-kq, 1.57079632679489655800, y); r = __builtin_fma(-kq, 6.12323399573676603587e-17, r);
    const double r2 = r * r;
    double s = 1.0 - r2 * (1.0 / 272.0); s = 1.0 - r2 * (1.0 / 210.0) * s; s = 1.0 - r2 * (1.0 / 156.0) * s; s = 1.0 - r2 * (1.0 / 110.0) * s; s = 1.0 - r2 * (1.0 / 72.0) * s; s = 1.0 - r2 * (1.0 / 42.0) * s; s = 1.0 - r2 * (1.0 / 20.0) * s; s = 1.0 - r2 * (1.0 / 6.0) * s; s *= r;
    double c = 1.0 - r2 * (1.0 / 240.0); c = 1.0 - r2 * (1.0 / 182.0) * c; c = 1.0 - r2 * (1.0 / 132.0) * c; c = 1.0 - r2 * (1.0 / 90.0) * c; c = 1.0 - r2 * (1.0 / 56.0) * c; c = 1.0 - r2 * (1.0 / 30.0) * c; c = 1.0 - r2 * (1.0 / 12.0) * c; c = 1.0 - r2 * (1.0 / 2.0) * c;
    const int q = ((int)kq) & 3;
    double sn = s, cs = c;
    if (q == 1) { sn = c; cs = -s; } else if (q == 2) { sn = -s; cs = -c; } else if (q == 3) { sn = -c; cs = s; }
    const double x = la * (double)j * (1.0 * (1.0 / 64.0));
    double e = 1.0 + x * (1.0 / 10.0); e = 1.0 + x * (1.0 / 9.0) * e; e = 1.0 + x * (1.0 / 8.0) * e; e = 1.0 + x * (1.0 / 7.0) * e; e = 1.0 + x * (1.0 / 6.0) * e; e = 1.0 + x * (1.0 / 5.0) * e; e = 1.0 + x * (1.0 / 4.0) * e; e = 1.0 + x * (1.0 / 3.0) * e; e = 1.0 + x * (1.0 / 2.0) * e; e = 1.0 + x * e;
#pragma unroll
    for (int i = 0; i < 6; ++i) e = e * e;
    pr = e * cs; pi = e * sn;
}

__device__ __forceinline__ void phase_prep(const Args& a, int l, unsigned char* lds, int G) {
    const int tid = otid(), lane = tid & 63, wave = tid >> 6;
    unsigned char* ws = a.ws;
    const int gw = blockIdx.x * 8 + wave, NGW = G * 8;
    unsigned* scr = (unsigned*)(lds + wave * 16384);
    const float* f1n = a.in[I_F1N] + (size_t)l * DM; const float* f2n = a.in[I_F2N] + (size_t)l * DM; const float* mxn = a.in[I_MIXN] + (size_t)l * DM;
    const float* f1g = a.in[I_F1G] + (size_t)l * DM * FF; const float* f1u = a.in[I_F1U] + (size_t)l * DM * FF; const float* f1d = a.in[I_F1D] + (size_t)l * FF * DM;
    const float* f2g = a.in[I_F2G] + (size_t)l * DM * FF; const float* f2u = a.in[I_F2U] + (size_t)l * DM * FF; const float* f2d = a.in[I_F2D] + (size_t)l * FF * DM;
    const float* win = a.in[I_WIN] + (size_t)l * DM * INW; const float* wbr = a.in[I_WBR] + (size_t)l * DM * DM; const float* wout = a.in[I_WOUT] + (size_t)l * DM * DM;
    const float* wglu = a.in[I_WGLU] + (size_t)l * 512 * 512;
    constexpr int IT_FU = (DM / 64) * (FF / 64), IT_FD = (FF / 64) * (DM / 64), IT_WA = (DM / 64) * (3584 / 64), IT_WB = (DM / 64) * (6656 / 64),
                  IT_BR = (1536 / 64) * (DM / 64), IT_WO = (DM / 64) * (DM / 64), IT_GL = (512 / 64) * (512 / 64);
    constexpr int IT_TOTAL = 4 * IT_FU + 2 * IT_FD + IT_WA + IT_WB + IT_BR + IT_WO + IT_GL;
    for (int it = gw; it < IT_TOTAL; it += NGW) {
        int r = it;
        if (tr_try(r, f1g, FF, DM, FF, 0, f1n, (bf16_t*)(ws + WS_W1U), DM, 0, 1, scr, lane)) continue;
        if (tr_try(r, f1u, FF, DM, FF, 0, f1n, (bf16_t*)(ws + WS_W1U), DM, 128, 1, scr, lane)) continue;
        if (tr_try(r, f2g, FF, DM, FF, 0, f2n, (bf16_t*)(ws + WS_W2U), DM, 0, 1, scr, lane)) continue;
        if (tr_try(r, f2u, FF, DM, FF, 0, f2n, (bf16_t*)(ws + WS_W2U), DM, 128, 1, scr, lane)) continue;
        if (tr_try(r, f1d, DM, FF, DM, 0, nullptr, (bf16_t*)(ws + WS_W1D), FF, 0, 0, scr, lane)) continue;
        if (tr_try(r, f2d, DM, FF, DM, 0, nullptr, (bf16_t*)(ws + WS_W2D), FF, 0, 0, scr, lane)) continue;
        if (tr_try(r, win, INW, DM, 3584, 0, mxn, (bf16_t*)(ws + WS_WIN), DM, 0, 0, scr, lane)) continue;
        if (tr_try(r, win, INW, DM, 6656, 3600, mxn, (bf16_t*)(ws + WS_WIN), DM, 3584, 0, scr, lane)) continue;
        if (tr_try(r, wbr + (size_t)512 * DM, DM, 1536, DM, 0, nullptr, (bf16_t*)(ws + WS_WBR) + 512, DM, 0, 0, scr, lane)) continue;
        if (tr_try(r, wout, DM, DM, DM, 0, nullptr, (bf16_t*)(ws + WS_WO), DM, 0, 0, scr, lane)) continue;
        tr_try(r, wglu, 512, 512, 512, 0, nullptr, (bf16_t*)(ws + WS_WGLU), 512, 0, 0, scr, lane);
    }
    {
        const float* pw = a.in[I_POOLW] + (size_t)l * 4 * 128 * 128; const float* ps = a.in[I_POOLS] + (size_t)l * 512;
        bf16_t* WbT = (bf16_t*)(ws + WS_WBR);
        const int n0 = blockIdx.x * 8, k = tid, g = k >> 7;
        const float* pr = pw + (size_t)k * 128;
        float s[8];
#pragma unroll
        for (int i = 0; i < 8; ++i) s[i] = 0.f;
#pragma unroll 4
        for (int d = 0; d < 128; ++d) {
            const float pv = pr[d] * ps[g * 128 + d];
            const f32x4 w0 = *(const f32x4*)(wbr + (size_t)(g * 128 + d) * DM + n0), w1 = *(const f32x4*)(wbr + (size_t)(g * 128 + d) * DM + n0 + 4);
            s[0] += pv * w0[0]; s[1] += pv * w0[1]; s[2] += pv * w0[2]; s[3] += pv * w0[3]; s[4] += pv * w1[0]; s[5] += pv * w1[1]; s[6] += pv * w1[2]; s[7] += pv * w1[3];
        }
#pragma unroll
        for (int i = 0; i < 8; ++i) WbT[(size_t)(n0 + i) * DM + k] = (bf16_t)f2bf(s[i]);
    }
    {
        bf16_t* WGT = (bf16_t*)(ws + WS_WGT);
        for (int i = blockIdx.x * 512 + tid; i < 16 * DM; i += G * 512) { const int j = i >> 11, k = i & 2047; WGT[i] = (bf16_t)f2bf(mxn[k] * win[(size_t)k * INW + 3584 + j]); }
    }
    {
        const float* are = a.in[I_ARE] + (size_t)l * 32 * 64; const float* aim = a.in[I_AIM] + (size_t)l * 32 * 64; const float* ldt = a.in[I_LDT] + (size_t)l * 32;
        const float* bre = a.in[I_BRE] + (size_t)l * 32 * 64 * 16; const float* bim = a.in[I_BIM] + (size_t)l * 32 * 64 * 16;
        const float* cre = a.in[I_CRE] + (size_t)l * 32 * 16 * 64; const float* cim = a.in[I_CIM] + (size_t)l * 32 * 16 * 64;
        const float* sd = a.in[I_SD] + (size_t)l * 512;
        bf16_t* KT = (bf16_t*)(ws + WS_KT); bf16_t* MET = (bf16_t*)(ws + WS_MET); bf16_t* MCT = (bf16_t*)(ws + WS_MCT); float* L64 = (float*)(ws + WS_L64);
        float* s_cr = (float*)lds;
        float* s_ci = s_cr + 1024;
        float* s_bbr = s_ci + 1024;
        float* s_bbi = s_bbr + 1024;
        float* s_pw = s_bbi + 1024;
        float* s_f = s_pw + 1024;
        __syncthreads();
        for (int it = blockIdx.x; it < 32 * 9; it += G) {
            const int g = it / 9, jb = it % 9;
            {
                const int p = tid & 63, jj = tid >> 6, j = jb * 8 + jj;
                const double dt = (double)expf(ldt[g]);
                const double ar = (double)are[g * 64 + p], ai = (double)aim[g * 64 + p];
                if (j <= 64) { double pr, pi; cpow_d(dt * ai, dt * ar, j, pr, pi); s_pw[(jj * 64 + p) * 2] = (float)pr; s_pw[(jj * 64 + p) * 2 + 1] = (float)pi;
                    if (j == 64) { L64[(g * 64 + p) * 2] = (float)pr; L64[(g * 64 + p) * 2 + 1] = (float)pi; } }
                if (tid < 64) {
                    double l1r, l1i; cpow_d(dt * ai, dt * ar, 1, l1r, l1i);
                    const double den = ar * ar + ai * ai;
                    s_f[2 * p] = (float)(((l1r - 1.0) * ar + l1i * ai) / den); s_f[2 * p + 1] = (float)((l1i * ar - (l1r - 1.0) * ai) / den);
                }
#pragma unroll
                for (int i = 0; i < 2; ++i) { const int idx = tid + i * 512; s_cr[idx] = cre[(size_t)g * 1024 + idx]; s_ci[idx] = cim[(size_t)g * 1024 + idx]; }
            }
            __syncthreads();
#pragma unroll
            for (int i = 0; i < 2; ++i) { const int idx = tid + i * 512, p = idx >> 4; const float fr = s_f[2 * p], fi = s_f[2 * p + 1];
                const float br = bre[(size_t)g * 1024 + idx], bi = bim[(size_t)g * 1024 + idx];
                s_bbr[idx] = fr * br - fi * bi; s_bbi[idx] = fr * bi + fi * br; }
            __syncthreads();
#pragma unroll 1
            for (int i = 0; i < 4; ++i) {
                const int o = tid + i * 512, jj = o >> 8, h = (o >> 4) & 15, hp = o & 15, j = jb * 8 + jj;
                if (j < 64) {
                    float sacc = 0.f;
#pragma unroll 8
                    for (int p = 0; p < 64; ++p) { const float cr = s_cr[h * 64 + p], ci = s_ci[h * 64 + p], pr = s_pw[(jj * 64 + p) * 2], pi = s_pw[(jj * 64 + p) * 2 + 1];
                        sacc += (cr * pr - ci * pi) * s_bbr[p * 16 + hp] - (cr * pi + ci * pr) * s_bbi[p * 16 + hp]; }
                    if (j == 0 && h == hp) sacc += sd[g * 16 + h];
                    KT[((size_t)(g * 64 + j) * 16 + h) * 16 + hp] = (bf16_t)f2bf(sacc);
                }
            }
#pragma unroll 4
            for (int i = 0; i < 16; ++i) {
                const int o = tid + i * 512, jj = o >> 10, j = jb * 8 + jj;
                if (j < 64) { const int p = (o >> 4) & 63, hp = o & 15; const float pr = s_pw[(jj * 64 + p) * 2], pi = s_pw[(jj * 64 + p) * 2 + 1], br = s_bbr[p * 16 + hp], bi = s_bbi[p * 16 + hp];
                    const int jp = 63 - j;
                    MET[((size_t)(g * 128 + p) * 64 + jp) * 16 + hp] = (bf16_t)f2bf(pr * br - pi * bi);
                    MET[((size_t)(g * 128 + 64 + p) * 64 + jp) * 16 + hp] = (bf16_t)f2bf(pr * bi + pi * br); }
                if (j >= 1 && j <= 64) { const int h = (o >> 6) & 15, p = o & 63; const float cr = s_cr[h * 64 + p], ci = s_ci[h * 64 + p], pr = s_pw[(jj * 64 + p) * 2], pi = s_pw[(jj * 64 + p) * 2 + 1];
                    const size_t base = ((size_t)g * 1024 + (j - 1) * 16 + h) * 128;
                    MCT[base + p] = (bf16_t)f2bf(cr * pr - ci * pi); MCT[base + 64 + p] = (bf16_t)f2bf(-(cr * pi + ci * pr)); }
            }
            __syncthreads();
        }
    }
    if (l == 0) {
        const float* x = a.in[I_X]; bf16_t* XB = (bf16_t*)(ws + WS_XB); unsigned long long* rss = (unsigned long long*)(ws + WS_RSS);
        for (int row = gw; row < T; row += NGW) {
            const f32x4* xr = (const f32x4*)(x + (size_t)row * DM) + lane; u32x2* o = (u32x2*)(XB + (size_t)row * DM) + lane;
            float ss = 0.f;
#pragma unroll
            for (int i = 0; i < 8; ++i) { const f32x4 v = xr[64 * i]; ss += v[0] * v[0] + v[1] * v[1] + v[2] * v[2] + v[3] * v[3]; u32x2 w; w.x = pk2(v[0], v[1]); w.y = pk2(v[2], v[3]); o[64 * i] = w; }
            ss = wave_sum(ss);
            if (lane == 0) rss[row] = (unsigned long long)(ss * 16777216.f);
        }
        for (int i = blockIdx.x * 512 + tid; i < 6 * T; i += G * 512) rss[T + i] = 0ull;
    }
}

__device__ __forceinline__ void phase_glr(const Args& a, const unsigned long long* rss, int G) {
    const int tid = otid(), lane = tid & 63, wave = tid >> 6, r16 = lane & 15, quad = lane >> 4;
    const int gw = blockIdx.x * 8 + wave, NGW = G * 8;
    const bf16_t* XB = (const bf16_t*)(a.ws + WS_XB); const bf16_t* WGT = (const bf16_t*)(a.ws + WS_WGT); float* GLR = (float*)(a.ws + WS_GLR);
    for (int task = gw; task < T / 16; task += NGW) {
        const int r0 = task * 16;
        f32x4 acc4[4];
#pragma unroll
        for (int q = 0; q < 4; ++q) acc4[q] = (f32x4){0.f, 0.f, 0.f, 0.f};
        const bf16_t* ap = XB + (size_t)(r0 + r16) * DM + quad * 8; const bf16_t* bp = WGT + (size_t)r16 * DM + quad * 8;
#pragma unroll 4
        for (int kb = 0; kb < 64; kb += 4)
#pragma unroll
            for (int q = 0; q < 4; ++q) acc4[q] = mfma16(*(const bf16x8*)(ap + (kb + q) * 32), *(const bf16x8*)(bp + (kb + q) * 32), acc4[q]);
        const f32x4 acc = (acc4[0] + acc4[1]) + (acc4[2] + acc4[3]);
#pragma unroll
        for (int i = 0; i < 4; ++i) { const int row = r0 + quad * 4 + i; GLR[(size_t)row * 16 + r16] = acc[i] * rsqrtf((float)rss[row] * (1.f / (16777216.f * DM)) + EPS); }
    }
}

template <int W>
__device__ __forceinline__ void pool_group(const bf16_t* Z, bf16_t* Y, int c00, int G) {
    for (int idx = blockIdx.x * 512 + otid(); idx < T * 16; idx += G * 512) {
        const int t = idx >> 4, c0 = c00 + (idx & 15) * 8, s = t & (SEQ - 1);
        const int cnt = (s + 1) < W ? (s + 1) : W;
        u32x4 v[W];
#pragma unroll
        for (int j = 0; j < W; ++j) { const int tj = (j < cnt) ? (t - j) : t; v[j] = *(const u32x4*)(Z + (size_t)tj * ZW + ZC_POOL + c0); }
        float sum[8];
#pragma unroll
        for (int i = 0; i < 8; ++i) sum[i] = 0.f;
#pragma unroll
        for (int j = 0; j < W; ++j) { const float m = (j < cnt) ? 1.f : 0.f;
            sum[0] += m * bflo(v[j].x); sum[1] += m * bfhi(v[j].x); sum[2] += m * bflo(v[j].y); sum[3] += m * bfhi(v[j].y);
            sum[4] += m * bflo(v[j].z); sum[5] += m * bfhi(v[j].z); sum[6] += m * bflo(v[j].w); sum[7] += m * bfhi(v[j].w); }
        const float inv = 1.f / (float)cnt;
        u32x4 o; o.x = pk2(sum[0] * inv - bflo(v[0].x), sum[1] * inv - bfhi(v[0].x)); o.y = pk2(sum[2] * inv - bflo(v[0].y), sum[3] * inv - bfhi(v[0].y));
        o.z = pk2(sum[4] * inv - bflo(v[0].z), sum[5] * inv - bfhi(v[0].z)); o.w = pk2(sum[6] * inv - bflo(v[0].w), sum[7] * inv - bfhi(v[0].w));
        *(u32x4*)(Y + (size_t)t * DM + c0) = o;
    }
}
__device__ __forceinline__ void phase_pool(const Args& a, int G) {
    const bf16_t* Z = (const bf16_t*)(a.ws + WS_Z); bf16_t* Y = (bf16_t*)(a.ws + WS_Y);
    pool_group<2>(Z, Y, 0, G); pool_group<4>(Z, Y, 128, G); pool_group<8>(Z, Y, 256, G); pool_group<16>(Z, Y, 384, G);
}

constexpr int OFF_BC = 0, OFF_QP = 32768, OFF_KP = 50176, OFF_OB = 0, OFF_QD = 67584, OFF_VT = 84992, OFF_PB = 121856, OFF_GL = 131072, OFF_TOT = 135168;
constexpr int PQ = 136, PV = 72, POB = 260;

__device__ __forceinline__ void gla_bc(unsigned char* lds, int tid, const float (&gl)[2], const float (&w)[16], float bias) {
    const int d = tid & 127, jq = tid >> 7;
    float* BC = (float*)(lds + OFF_BC); float* GL = (float*)(lds + OFF_GL); float* TOT = (float*)(lds + OFF_TOT);
    GL[tid] = gl[0]; GL[tid + 512] = gl[1];
    __syncthreads();
    float run = 0.f;
#pragma unroll 4
    for (int jj = 0; jj < 16; ++jj) {
        const int j = jq * 16 + jj;
        float z = bias;
#pragma unroll
        for (int r = 0; r < 16; ++r) z += GL[j * 16 + r] * w[r];
        const float la = (fminf(z, 0.f) - __logf(1.f + __expf(-fabsf(z)))) * (1.f / 16.f);
        run += la; BC[j * 128 + d] = run;
    }
    TOT[jq * 128 + d] = run;
    __syncthreads();
    float off = 0.f;
    for (int q = 0; q < jq; ++q) off += TOT[q * 128 + d];
    if (jq > 0) {
#pragma unroll 4
        for (int jj = 0; jj < 16; ++jj) BC[(jq * 16 + jj) * 128 + d] += off;
    }
    __syncthreads();
}

__device__ __forceinline__ int tsw(int x, int j) { return x * PV + ((((j >> 3) ^ ((x >> 3) & 7)) << 3) | (j & 7)); }
__device__ __forceinline__ int tsc(int x, int c) { return x * PV + ((c ^ ((x >> 3) & 7)) << 3); }
__device__ __forceinline__ float bfe(const u32x4& v, int e) { const unsigned w = (e < 2) ? v.x : (e < 4) ? v.y : (e < 6) ? v.z : v.w; return (e & 1) ? bfhi(w) : bflo(w); }
__device__ __forceinline__ unsigned short bfr(const u32x4& v, int e) { const unsigned w = (e < 2) ? v.x : (e < 4) ? v.y : (e < 6) ? v.z : v.w; return (unsigned short)((e & 1) ? (w >> 16) : (w & 0xffffu)); }

struct KvIn { u32x4 k[2], v[4]; float gl[2]; };
__device__ __forceinline__ void gla_kv_load(const Args& a, int unit, int tid, KvIn& r) {
    const int bh = unit >> 6, n = unit & 63, b = bh >> 2, h = bh & 3, t0 = b * SEQ + n * 64;
    const bf16_t* Z = (const bf16_t*)(a.ws + WS_Z); const float* GLR = (const float*)(a.ws + WS_GLR);
    r.gl[0] = GLR[(size_t)t0 * 16 + tid]; r.gl[1] = GLR[(size_t)t0 * 16 + tid + 512];
#pragma unroll
    for (int i = 0; i < 2; ++i) { const int p = tid + 512 * i; r.k[i] = *(const u32x4*)(Z + (size_t)(t0 + (p >> 4)) * ZW + ZC_K + h * 128 + (p & 15) * 8); }
#pragma unroll
    for (int i = 0; i < 4; ++i) { const int p = tid + 512 * i; r.v[i] = *(const u32x4*)(Z + (size_t)(t0 + (p >> 5)) * ZW + ZC_V + h * 256 + (p & 31) * 8); }
}
__device__ __forceinline__ void gla_kv_unit(const Args& a, unsigned char* lds, int unit, int next, int tid, KvIn& in, const float (&w)[16], float bias) {
    const int lane = tid & 63, wave = tid >> 6, r16 = lane & 15, quad = lane >> 4;
    const int bh = unit >> 6, n = unit & 63, b = bh >> 2, h = bh & 3, t0 = b * SEQ + n * 64;
    bf16_t* KV = (bf16_t*)(a.ws + WS_KV); float* DEC = (float*)(a.ws + WS_DEC);
    gla_bc(lds, tid, in.gl, w, bias);
    u32x4 kreg[2], vreg[4];
#pragma unroll
    for (int i = 0; i < 2; ++i) kreg[i] = in.k[i];
#pragma unroll
    for (int i = 0; i < 4; ++i) vreg[i] = in.v[i];
    const float* BC = (const float*)(lds + OFF_BC); bf16_t* KTl = (bf16_t*)(lds + OFF_QP); bf16_t* VT = (bf16_t*)(lds + OFF_VT);
    {
        float* BCG = (float*)(a.ws + WS_BCG);
#pragma unroll
        for (int i = 0; i < 4; ++i) { const int p = tid + 512 * i, j = p >> 5, d0 = (p & 31) * 4; *(f32x4*)(BCG + (size_t)(t0 + j) * 512 + h * 128 + d0) = *(const f32x4*)(BC + j * 128 + d0); }
    }
#pragma unroll
    for (int i = 0; i < 2; ++i) {
        const int p = tid + 512 * i, j = p >> 4, d0 = (p & 15) * 8;
        const f32x4 bl0 = *(const f32x4*)(BC + 63 * 128 + d0), bl1 = *(const f32x4*)(BC + 63 * 128 + d0 + 4);
        const f32x4 bc0 = *(const f32x4*)(BC + j * 128 + d0), bc1 = *(const f32x4*)(BC + j * 128 + d0 + 4);
#pragma unroll
        for (int e = 0; e < 8; ++e) { const float bl = e < 4 ? bl0[e & 3] : bl1[e & 3], bc = e < 4 ? bc0[e & 3] : bc1[e & 3];
            KTl[tsw(d0 + e, j)] = (bf16_t)f2bf(bfe(kreg[i], e) * __expf(bl - bc)); }
    }
    if (tid < 128) DEC[(size_t)unit * 128 + tid] = __expf(BC[63 * 128 + tid]);
#pragma unroll
    for (int i = 0; i < 4; ++i) {
        const int p = tid + 512 * i, j = p >> 5, v0 = (p & 31) * 8;
#pragma unroll
        for (int e = 0; e < 8; ++e) VT[tsw(v0 + e, j)] = bfr(vreg[i], e);
    }
    if (next >= 0) gla_kv_load(a, next, tid, in);
    __syncthreads();
    f32x4 acc[8][2];
#pragma unroll
    for (int i = 0; i < 8; ++i) { acc[i][0] = (f32x4){0.f, 0.f, 0.f, 0.f}; acc[i][1] = (f32x4){0.f, 0.f, 0.f, 0.f}; }
#pragma unroll
    for (int kb = 0; kb < 2; ++kb) {
        bf16x8 bf[2];
#pragma unroll
        for (int v2 = 0; v2 < 2; ++v2) bf[v2] = *(const bf16x8*)(VT + tsc((wave * 2 + v2) * 16 + r16, kb * 4 + quad));
#pragma unroll
        for (int db = 0; db < 8; ++db) { const bf16x8 af = *(const bf16x8*)(KTl + tsc(db * 16 + r16, kb * 4 + quad));
            acc[db][0] = mfma16(af, bf[0], acc[db][0]); acc[db][1] = mfma16(af, bf[1], acc[db][1]); }
    }
#pragma unroll
    for (int db = 0; db < 8; ++db)
#pragma unroll
        for (int v2 = 0; v2 < 2; ++v2) { const int v = (wave * 2 + v2) * 16 + r16; u32x2 o; o.x = pk2(acc[db][v2][0], acc[db][v2][1]); o.y = pk2(acc[db][v2][2], acc[db][v2][3]);
            *(u32x2*)(KV + ((size_t)unit * 256 + v) * 128 + db * 16 + quad * 4) = o; }
    __syncthreads();
}

__device__ __forceinline__ void gla_scan(const Args& a, int G, size_t dst_off = WS_KV) {
    bf16_t* KV = (bf16_t*)(a.ws + WS_KV); const float* DEC = (const float*)(a.ws + WS_DEC); const ptrdiff_t dd = (ptrdiff_t)dst_off - (ptrdiff_t)WS_KV;
    for (int id = blockIdx.x * 512 + otid(); id < 16 * 256 * 32; id += G * 512) {
        const int bh = id >> 13, v = (id >> 5) & 255, d0 = (id & 31) * 4;
        float s0 = 0.f, s1 = 0.f, s2 = 0.f, s3 = 0.f;
#pragma unroll 8
        for (int n = 0; n < 64; ++n) {
            const int unit = bh * 64 + n;
            u32x2* p = (u32x2*)(KV + ((size_t)unit * 256 + v) * 128 + d0);
            const u32x2 kv = *p; const f32x4 dc = *(const f32x4*)(DEC + (size_t)unit * 128 + d0);
            u32x2 o; o.x = pk2(s0, s1); o.y = pk2(s2, s3); *(u32x2*)((char*)p + dd) = o;
            s0 = dc[0] * s0 + bflo(kv.x); s1 = dc[1] * s1 + bfhi(kv.x); s2 = dc[2] * s2 + bflo(kv.y); s3 = dc[3] * s3 + bfhi(kv.y);
        }
    }
}

struct OutIn { u32x4 q[2], k[2], v[4]; f32x4 bc[2][2], bm[2][2]; };
__device__ __forceinline__ void gla_out_load(const Args& a, int unit, int tid, OutIn& r) {
    const int bh = unit >> 6, n = unit & 63, b = bh >> 2, h = bh & 3, t0 = b * SEQ + n * 64;
    const bf16_t* Z = (const bf16_t*)(a.ws + WS_Z); const float* BCG = (const float*)(a.ws + WS_BCG);
#pragma unroll
    for (int i = 0; i < 2; ++i) { const int p = tid + 512 * i, j = p >> 4, d0 = (p & 15) * 8; const bf16_t* rp = Z + (size_t)(t0 + j) * ZW + h * 128 + d0;
        r.q[i] = *(const u32x4*)(rp + ZC_Q); r.k[i] = *(const u32x4*)(rp + ZC_K);
        r.bc[i][0] = *(const f32x4*)(BCG + (size_t)(t0 + j) * 512 + h * 128 + d0); r.bc[i][1] = *(const f32x4*)(BCG + (size_t)(t0 + j) * 512 + h * 128 + d0 + 4);
        r.bm[i][0] = *(const f32x4*)(BCG + (size_t)(t0 + 31) * 512 + h * 128 + d0); r.bm[i][1] = *(const f32x4*)(BCG + (size_t)(t0 + 31) * 512 + h * 128 + d0 + 4); }
#pragma unroll
    for (int i = 0; i < 4; ++i) { const int p = tid + 512 * i; r.v[i] = *(const u32x4*)(Z + (size_t)(t0 + (p >> 5)) * ZW + ZC_V + h * 256 + (p & 31) * 8); }
}
__device__ __forceinline__ void gla_out_unit(const Args& a, int l, unsigned char* lds, int unit, int next, int tid, OutIn& in) {
    const int lane = tid & 63, wave = tid >> 6, r16 = lane & 15, quad = lane >> 4;
    const int bh = unit >> 6, n = unit & 63, b = bh >> 2, h = bh & 3, t0 = b * SEQ + n * 64;
    const bf16_t* Z = (const bf16_t*)(a.ws + WS_Z); const bf16_t* KV = (const bf16_t*)(a.ws + WS_KV); bf16_t* Y = (bf16_t*)(a.ws + WS_Y);
    u32x4 qreg[2], kreg[2], vreg[4]; f32x4 bcr[2][2], bmr[2][2];
#pragma unroll
    for (int i = 0; i < 2; ++i) { qreg[i] = in.q[i]; kreg[i] = in.k[i]; bcr[i][0] = in.bc[i][0]; bcr[i][1] = in.bc[i][1]; bmr[i][0] = in.bm[i][0]; bmr[i][1] = in.bm[i][1]; }
#pragma unroll
    for (int i = 0; i < 4; ++i) vreg[i] = in.v[i];
    bf16_t* QP = (bf16_t*)(lds + OFF_QP); bf16_t* KP = (bf16_t*)(lds + OFF_KP); bf16_t* QD = (bf16_t*)(lds + OFF_QD); bf16_t* VT = (bf16_t*)(lds + OFF_VT); bf16_t* PB = (bf16_t*)(lds + OFF_PB);
    float* OB = (float*)(lds + OFF_OB);
#pragma unroll
    for (int i = 0; i < 2; ++i) {
        const int p = tid + 512 * i, j = p >> 4, d0 = (p & 15) * 8;
        const f32x4 bm0 = bmr[i][0], bm1 = bmr[i][1];
        const f32x4 bc0 = bcr[i][0], bc1 = bcr[i][1];
        float qp[8], kp[8], qd[8];
#pragma unroll
        for (int e = 0; e < 8; ++e) { const float bm = e < 4 ? bm0[e & 3] : bm1[e & 3], bc = e < 4 ? bc0[e & 3] : bc1[e & 3];
            const float qv = bfe(qreg[i], e) * 0.08838834764831845f, kv = bfe(kreg[i], e);
            qp[e] = qv * __expf(bc - bm); kp[e] = kv * __expf(bm - bc); qd[e] = qv * __expf(bc); }
        u32x4 o; o.x = pk2(qp[0], qp[1]); o.y = pk2(qp[2], qp[3]); o.z = pk2(qp[4], qp[5]); o.w = pk2(qp[6], qp[7]); *(u32x4*)(QP + j * PQ + d0) = o;
        o.x = pk2(kp[0], kp[1]); o.y = pk2(kp[2], kp[3]); o.z = pk2(kp[4], kp[5]); o.w = pk2(kp[6], kp[7]); *(u32x4*)(KP + j * PQ + d0) = o;
        o.x = pk2(qd[0], qd[1]); o.y = pk2(qd[2], qd[3]); o.z = pk2(qd[4], qd[5]); o.w = pk2(qd[6], qd[7]); *(u32x4*)(QD + j * PQ + d0) = o;
    }
#pragma unroll
    for (int i = 0; i < 4; ++i) {
        const int p = tid + 512 * i, j = p >> 5, v0 = (p & 31) * 8;
#pragma unroll
        for (int e = 0; e < 8; ++e) VT[tsw(v0 + e, j)] = bfr(vreg[i], e);
    }
    bf16x8 bfk[4][2];
#pragma unroll
    for (int kb = 0; kb < 4; ++kb)
#pragma unroll
        for (int v2 = 0; v2 < 2; ++v2) bfk[kb][v2] = *(const bf16x8*)(KV + ((size_t)unit * 256 + (wave * 2 + v2) * 16 + r16) * 128 + kb * 32 + quad * 8);
    u32x2 rv8[8];
#pragma unroll
    for (int rr = 0; rr < 8; ++rr) rv8[rr] = *(const u32x2*)(Z + (size_t)(t0 + wave * 8 + rr) * ZW + ZC_R + h * 256 + lane * 4);
    if (next >= 0) gla_out_load(a, next, tid, in);
    __syncthreads();
    {
        const int ib = wave >> 1;
#pragma unroll
        for (int jbi = 0; jbi < 2; ++jbi) {
            const int jb = (wave & 1) * 2 + jbi;
            f32x4 sc = (f32x4){0.f, 0.f, 0.f, 0.f};
            if (jb <= ib) {
#pragma unroll
                for (int kb = 0; kb < 4; ++kb) sc = mfma16(*(const bf16x8*)(QP + (ib * 16 + r16) * PQ + kb * 32 + quad * 8), *(const bf16x8*)(KP + (jb * 16 + r16) * PQ + kb * 32 + quad * 8), sc);
            }
#pragma unroll
            for (int i = 0; i < 4; ++i) { const int row = ib * 16 + quad * 4 + i, col = jb * 16 + r16; PB[row * PV + col] = (bf16_t)f2bf(col <= row ? sc[i] : 0.f); }
        }
    }
    __syncthreads();
    f32x4 acc[4][2];
#pragma unroll
    for (int i = 0; i < 4; ++i) { acc[i][0] = (f32x4){0.f, 0.f, 0.f, 0.f}; acc[i][1] = (f32x4){0.f, 0.f, 0.f, 0.f}; }
#pragma unroll
    for (int kb = 0; kb < 2; ++kb) {
        bf16x8 bf[2];
#pragma unroll
        for (int v2 = 0; v2 < 2; ++v2) bf[v2] = *(const bf16x8*)(VT + tsc((wave * 2 + v2) * 16 + r16, kb * 4 + quad));
#pragma unroll
        for (int ib = 0; ib < 4; ++ib) { const bf16x8 af = *(const bf16x8*)(PB + (ib * 16 + r16) * PV + kb * 32 + quad * 8);
            acc[ib][0] = mfma16(af, bf[0], acc[ib][0]); acc[ib][1] = mfma16(af, bf[1], acc[ib][1]); }
    }
#pragma unroll
    for (int kb = 0; kb < 4; ++kb) {
#pragma unroll
        for (int ib = 0; ib < 4; ++ib) { const bf16x8 af = *(const bf16x8*)(QD + (ib * 16 + r16) * PQ + kb * 32 + quad * 8);
            acc[ib][0] = mfma16(af, bfk[kb][0], acc[ib][0]); acc[ib][1] = mfma16(af, bfk[kb][1], acc[ib][1]); }
    }
#pragma unroll
    for (int ib = 0; ib < 4; ++ib)
#pragma unroll
        for (int v2 = 0; v2 < 2; ++v2)
#pragma unroll
            for (int i = 0; i < 4; ++i) OB[(ib * 16 + quad * 4 + i) * POB + (wave * 2 + v2) * 16 + r16] = acc[ib][v2][i];
    __syncthreads();
    {
        const float* gn = a.in[I_GNORM] + (size_t)l * 1024 + h * 256 + lane * 4;
        const f32x4 gain = *(const f32x4*)gn;
#pragma unroll
        for (int rr = 0; rr < 8; ++rr) {
            const int i = wave * 8 + rr;
            const f32x4 v = *(const f32x4*)(OB + i * POB + lane * 4);
            const float ss = wave_sum(v[0] * v[0] + v[1] * v[1] + v[2] * v[2] + v[3] * v[3]);
            const float rinv = rsqrtf(ss * (1.f / 256.f) + EPS);
            const u32x2 rv = rv8[rr];
            const float r0 = bflo(rv.x), r1 = bfhi(rv.x), r2 = bflo(rv.y), r3 = bfhi(rv.y);
            u32x2 o; o.x = pk2(v[0] * rinv * gain[0] * r0 * sigmoid_f(r0), v[1] * rinv * gain[1] * r1 * sigmoid_f(r1));
            o.y = pk2(v[2] * rinv * gain[2] * r2 * sigmoid_f(r2), v[3] * rinv * gain[3] * r3 * sigmoid_f(r3));
            *(u32x2*)(Y + (size_t)(t0 + i) * DM + YC_GLA + h * 256 + lane * 4) = o;
        }
    }
    __syncthreads();
}

__device__ __forceinline__ void ssm_end_unit(const Args& a, int unit) {
    const int tid = otid(), lane = tid & 63, wave = tid >> 6, r16 = lane & 15, quad = lane >> 4;
    const int g = unit >> 3, rb = unit & 7;
    const bf16_t* XS = (const bf16_t*)(a.ws + WS_XS); const bf16_t* MET = (const bf16_t*)(a.ws + WS_MET); float* E = (float*)(a.ws + WS_E);
    const int crow = rb * 32 + (wave & 1) * 16, qg = (wave >> 1) * 32;
    const int ch = (quad & 1) * 8, jo = quad >> 1;
    f32x4 acc[2];
#pragma unroll
    for (int i = 0; i < 2; ++i) acc[i] = (f32x4){0.f, 0.f, 0.f, 0.f};
    const bf16_t* ap = XS + ((size_t)g * T + (crow + r16) * 64 + jo) * 16 + ch;
    const bf16_t* bp = MET + ((size_t)(g * 128 + qg + r16) * 64 + jo) * 16 + ch;
#pragma unroll 8
    for (int kb = 0; kb < 32; ++kb) {
        const bf16x8 af = *(const bf16x8*)(ap + (size_t)kb * 2 * 16);
#pragma unroll
        for (int nb = 0; nb < 2; ++nb) acc[nb] = mfma16(af, *(const bf16x8*)(bp + (size_t)nb * 16 * 1024 + kb * 32), acc[nb]);
    }
#pragma unroll
    for (int nb = 0; nb < 2; ++nb)
#pragma unroll
        for (int i = 0; i < 4; ++i) E[((size_t)(crow + quad * 4 + i) * 32 + g) * 128 + qg + nb * 16 + r16] = acc[nb][i];
}
__device__ __forceinline__ void ssm_scan(const Args& a, int id) {
    const int b = id >> 11, g = (id >> 6) & 31, p = id & 63;
    const float* E = (const float*)(a.ws + WS_E); bf16_t* HC = (bf16_t*)(a.ws + WS_HC); const float* L64 = (const float*)(a.ws + WS_L64);
    const float lr = L64[(g * 64 + p) * 2], li = L64[(g * 64 + p) * 2 + 1];
    float hr = 0.f, hi = 0.f;
#pragma unroll 8
    for (int n = 0; n < 64; ++n) {
        const size_t base = ((size_t)(b * 64 + n) * 32 + g) * 128;
        HC[base + p] = (bf16_t)f2bf(hr); HC[base + 64 + p] = (bf16_t)f2bf(hi);
        const float er = E[base + p], ei = E[base + 64 + p];
        const float nr = lr * hr - li * hi + er, ni = lr * hi + li * hr + ei;
        hr = nr; hi = ni;
    }
}
__device__ __forceinline__ void ssm_out_unit(const Args& a, int unit) {
    const int tid = otid(), lane = tid & 63, wave = tid >> 6, r16 = lane & 15, quad = lane >> 4;
    const int g = unit >> 4, cb = unit & 15;
    const bf16_t* XS = (const bf16_t*)(a.ws + WS_XS); const bf16_t* KT = (const bf16_t*)(a.ws + WS_KT); const bf16_t* MCT = (const bf16_t*)(a.ws + WS_MCT);
    const bf16_t* HC = (const bf16_t*)(a.ws + WS_HC); bf16_t* YS = (bf16_t*)(a.ws + WS_YS);
    const int ch = (quad & 1) * 8, jo = quad >> 1;
    f32x4 acc[2][4];
#pragma unroll
    for (int i = 0; i < 2; ++i)
#pragma unroll
        for (int k = 0; k < 4; ++k) acc[i][k] = (f32x4){0.f, 0.f, 0.f, 0.f};
    const int kbn = cb * 2 + 2;
    const bf16x8 zero8 = (bf16x8){0, 0, 0, 0, 0, 0, 0, 0};
    for (int kb0 = 0; kb0 < kbn; kb0 += 4) {
        bf16x8 af[4][2], bf[4][4];
#pragma unroll
        for (int u = 0; u < 4; ++u) {
            const int kb = kb0 + u, jp = kb * 2 + jo; const bool on = kb < kbn;
#pragma unroll
            for (int rk = 0; rk < 2; ++rk) af[u][rk] = on ? *(const bf16x8*)(XS + ((size_t)g * T + (wave * 32 + rk * 16 + r16) * 64 + jp) * 16 + ch) : zero8;
#pragma unroll
            for (int nb = 0; nb < 4; ++nb) { const int dl = cb * 4 + nb - jp; bf[u][nb] = (on && dl >= 0) ? *(const bf16x8*)(KT + ((size_t)(g * 64 + dl) * 16 + r16) * 16 + ch) : zero8; }
        }
#pragma unroll
        for (int u = 0; u < 4; ++u)
#pragma unroll
            for (int nb = 0; nb < 4; ++nb) { acc[0][nb] = mfma16(af[u][0], bf[u][nb], acc[0][nb]); acc[1][nb] = mfma16(af[u][1], bf[u][nb], acc[1][nb]); }
    }
#pragma unroll
    for (int kb = 0; kb < 4; ++kb) {
        bf16x8 af[2];
#pragma unroll
        for (int rk = 0; rk < 2; ++rk) af[rk] = *(const bf16x8*)(HC + ((size_t)(wave * 32 + rk * 16 + r16) * 32 + g) * 128 + kb * 32 + quad * 8);
#pragma unroll
        for (int nb = 0; nb < 4; ++nb) { const bf16x8 bf = *(const bf16x8*)(MCT + ((size_t)g * 1024 + (cb * 4 + nb) * 16 + r16) * 128 + kb * 32 + quad * 8);
            acc[0][nb] = mfma16(af[0], bf, acc[0][nb]); acc[1][nb] = mfma16(af[1], bf, acc[1][nb]); }
    }
#pragma unroll
    for (int rk = 0; rk < 2; ++rk)
#pragma unroll
        for (int nb = 0; nb < 4; ++nb)
#pragma unroll
            for (int i = 0; i < 4; ++i) { const int chunk = wave * 32 + rk * 16 + quad * 4 + i, t = chunk * 64 + cb * 4 + nb;
                YS[(size_t)t * 512 + g * 16 + r16] = (bf16_t)f2bf(gelu_tanh_f(acc[rk][nb][i])); }
}

__device__ __forceinline__ void phase_final(const Args& a, int G) {
    const int tid = otid(), lane = tid & 63, wave = tid >> 6;
    const int gw = blockIdx.x * 8 + wave, NGW = G * 8;
    const unsigned long long* rss = (const unsigned long long*)(a.ws + WS_RSS) + (size_t)6 * T; const float* gf = a.in[I_FINN];
    for (int row = gw; row < T; row += NGW) {
        const float rinv = rsqrtf((float)rss[row] * (1.f / (16777216.f * DM)) + EPS);
        f32x4* xr = (f32x4*)(a.out + (size_t)row * DM) + lane; const f32x4* gr = (const f32x4*)gf + lane;
#pragma unroll
        for (int i = 0; i < 8; ++i) { f32x4 v = xr[64 * i]; const f32x4 gg = gr[64 * i]; v = v * rinv * gg; xr[64 * i] = v; }
    }
}


#define XB_TMO      128
#define XB_XCNT(j)  (256  + 64 * (j))
#define XB_XSUB(j)  (1280 + 64 * (j))
#define XB_XGEN(j)  (2304 + 64 * (j))
#define XB_TOP      3328
#define XB_TOPGEN   3392
#define XCD_BAR_WORDS 3456
#define XB_SPIN_CAP (1u << 18)
__device__ __forceinline__ unsigned xb_ld(unsigned* p)              { return __hip_atomic_load(p, __ATOMIC_RELAXED, __HIP_MEMORY_SCOPE_AGENT); }
__device__ __forceinline__ unsigned xb_add(unsigned* p, unsigned v) { return __hip_atomic_fetch_add(p, v, __ATOMIC_RELAXED, __HIP_MEMORY_SCOPE_AGENT); }
__device__ __forceinline__ unsigned xb_xcc_id() { return (unsigned)__builtin_amdgcn_s_getreg((3 << 11) | 20) & 0xFu; }
#define XB_SPIN(cond, bar) do { unsigned _sp = 0; while (cond) { __builtin_amdgcn_s_sleep(1); \
    if ((++_sp & 255u) == 0u) { if (xb_ld(&(bar)[XB_TMO])) break; if (_sp > XB_SPIN_CAP) { atomicAdd(&(bar)[XB_TMO], 1u); break; } } } } while (0)
struct XcdBarrier { unsigned* bar; unsigned x; volatile LAS unsigned* st; };
__device__ __forceinline__ XcdBarrier xcd_barrier_post(unsigned* bar, volatile LAS unsigned* st) {
    XcdBarrier b; b.bar = bar; b.x = xb_xcc_id(); b.st = st;
    if (threadIdx.x == 0) (void)xb_add(&bar[XB_XCNT(b.x)], 1u);
    return b;
}
__device__ __forceinline__ void xcd_barrier_complete(unsigned* bar, unsigned x, unsigned& nloc, unsigned& nx) {
    const unsigned G = gridDim.x * gridDim.y * gridDim.z;
    unsigned sum, cnt, mine, sp = 0u;
    for (;;) {
        sum = 0u; cnt = 0u; mine = 0u;
#pragma unroll
        for (unsigned j = 0; j < 16; ++j) { const unsigned c = xb_ld(&bar[XB_XCNT(j)]); sum += c; cnt += (c > 0u) ? 1u : 0u; mine = (j == x) ? c : mine; }
        if (sum == G) break;
        __builtin_amdgcn_s_sleep(1);
        if ((++sp & 255u) == 0u) { if (xb_ld(&bar[XB_TMO])) break; if (sp > XB_SPIN_CAP) { atomicAdd(&bar[XB_TMO], 1u); break; } }
    }
    nloc = mine > 0u ? mine : 1u; nx = cnt > 0u ? cnt : 1u;
}
__device__ __forceinline__ void xcd_barrier(const XcdBarrier& b) {
    asm volatile("s_waitcnt vmcnt(0)" ::: "memory");
    __syncthreads();
    if (threadIdx.x == 0) {
        unsigned* bar = b.bar;
        __builtin_amdgcn_s_waitcnt(0);
        unsigned nloc = b.st[0], nx = b.st[1];
        if (nloc == 0u) { xcd_barrier_complete(bar, b.x, nloc, nx); b.st[0] = nloc; b.st[1] = nx; }
        const unsigned old = xb_add(&bar[XB_XSUB(b.x)], 1u);
        const unsigned gen = old / nloc;
        if (old + 1u == (gen + 1u) * nloc) {
            __builtin_amdgcn_fence(__ATOMIC_RELEASE, "agent");
            asm volatile("s_waitcnt vmcnt(0)" ::: "memory");
            const unsigned og = xb_add(&bar[XB_TOP], 1u);
            const unsigned tg = og / nx;
            if (og + 1u == (tg + 1u) * nx) xb_add(&bar[XB_TOPGEN], 1u);
            else XB_SPIN(xb_ld(&bar[XB_TOPGEN]) == tg, bar);
            __builtin_amdgcn_fence(__ATOMIC_ACQUIRE, "agent");
            xb_add(&bar[XB_XGEN(b.x)], 1u);
            asm volatile("s_waitcnt vmcnt(0)" ::: "memory");
        } else {
            XB_SPIN(xb_ld(&bar[XB_XGEN(b.x)]) == gen, bar);
            __builtin_amdgcn_fence(__ATOMIC_ACQUIRE, "agent");
            asm volatile("s_waitcnt vmcnt(0)" ::: "memory");
        }
    }
    __syncthreads();
}

constexpr int PH_PER_LAYER = 12, N_PHASES = 2 * PH_PER_LAYER + 1;

__global__ void __launch_bounds__(512, 2) mega_fwd(Args a) {
    extern __shared__ __attribute__((aligned(16))) unsigned char lds[];
    cg::grid_group grid = cg::this_grid();
    constexpr int G = 256;
    unsigned char* ws = a.ws;
    LAS unsigned char* ldsl = (LAS unsigned char*)lds;
    unsigned long long* rssb = (unsigned long long*)(ws + WS_RSS);
    volatile LAS unsigned* bst = (volatile LAS unsigned*)(ldsl + (LDS_BYTES - 64));
    if (threadIdx.x < 2) bst[threadIdx.x] = 0u;
    __syncthreads();
    XcdBarrier bar = xcd_barrier_post((unsigned*)(ws + WS_BAR), bst);
#if !MK_MULTI_LAUNCH
    if (a.ph_hi - a.ph_lo > 1) grid.sync();
#endif
    for (int ph = a.ph_lo; ph < a.ph_hi; ++ph) {
        if (ph != a.ph_lo) {
            xcd_barrier(bar);
#ifdef PROBE_SYNC
            for (int q = 0; q < 4; ++q) xcd_barrier(bar);
#endif
        }
        if (ph == N_PHASES - 1) { phase_final(a, G); continue; }
        const int l = ph / PH_PER_LAYER, k = ph % PH_PER_LAYER;
#ifdef PROBE_K
        for (int rep = 0; rep < ((k == PROBE_K) ? 2 : 1); ++rep) {
        if (rep) xcd_barrier(bar);
#endif
        if (k == 0) {
#ifndef NO_PREP
            phase_prep(a, l, lds, G);
#endif
        } else if (k == 1 || k == 10) {
            const int second = (k == 10);
            pg8::Gemm g{(const bf16_t*)(ws + WS_XB), (const bf16_t*)(ws + (second ? WS_W2U : WS_W1U)), T, 2 * FF, DM, DM, DM};
            pg8::StaticOrder S; S.init(T, 2 * FF, G, (int)blockIdx.x);
            pg8::EpiFfnUp E{(bf16_t*)(ws + WS_Z), rssb + (size_t)(3 * l + (second ? 2 : 0)) * T};
            pg8::gemm_phase(ldsl, g, S, E);
#ifdef PROBE_FFNUP
            if (!second) { xcd_barrier(bar); pg8::Gemm g2 = g; g2.fix = PROBE_FFNUP - 1; pg8::EpiFfnUp E2{(bf16_t*)(ws + WS_Y), E.rss}; pg8::gemm_phase(ldsl, g2, S, E2); }
#endif
        } else if (k == 2 || k == 11) {
            const int second = (k == 11);
            pg8::Gemm g{(const bf16_t*)(ws + WS_Z), (const bf16_t*)(ws + (second ? WS_W2D : WS_W1D)), T, DM, FF, FF, FF};
            pg8::StaticOrder S; S.init(T, DM, G, (int)blockIdx.x);
            const float* xin = (l == 0 && !second) ? a.in[I_X] : a.out;
            pg8::EpiResid E{xin, a.out, (bf16_t*)(ws + WS_XB), rssb + (size_t)(3 * l + (second ? 3 : 1)) * T, 0.5f, !(l == 1 && second)};
            pg8::gemm_phase(ldsl, g, S, E);
        } else if (k == 3) {
            pg8::Gemm g{(const bf16_t*)(ws + WS_XB), (const bf16_t*)(ws + WS_WIN), T, ZW, DM, DM, DM};
            pg8::StaticOrder S; S.init(T, ZW, G, (int)blockIdx.x);
            pg8::EpiWin E{(bf16_t*)(ws + WS_Z), rssb + (size_t)(3 * l + 1) * T, (bf16_t*)(ws + WS_XS)};
            pg8::gemm_phase(ldsl, g, S, E);
#ifndef NO_GLR
            phase_glr(a, rssb + (size_t)(3 * l + 1) * T, G);
#endif
        } else if (k == 4) {
#ifndef NO_GLA
            {
                const int tid = otid(), hh = ((int)blockIdx.x >> 6) & 3;
                const float* w2 = a.in[I_GW2] + (size_t)l * 16 * 512; const float* gb = a.in[I_GB] + (size_t)l * 512;
                float w[16];
#pragma unroll
                for (int r = 0; r < 16; ++r) w[r] = w2[r * 512 + hh * 128 + (tid & 127)];
                const float bias = gb[hh * 128 + (tid & 127)];
                KvIn in; gla_kv_load(a, (int)blockIdx.x, tid, in);
                for (int u = blockIdx.x; u < 1024; u += G) gla_kv_unit(a, lds, u, (u + G < 1024) ? u + G : -1, tid, in, w, bias);
            }
#endif
#ifndef NO_SSM
            ssm_end_unit(a, (int)blockIdx.x);
#endif
#ifndef NO_POOL
            phase_pool(a, G);
#endif
        } else if (k == 5) {
#ifndef NO_GLA
#ifdef PROBE_SCAN
            gla_scan(a, G, WS_MB);
#endif
            gla_scan(a, G);
#endif
#ifndef NO_SSM
            { const int id = (G - 1 - (int)blockIdx.x) * 512 + otid(); if (id < 8192) ssm_scan(a, id); }
#endif
        } else if (k == 6) {
#ifndef NO_GLA
            {
                const int tid = otid();
                OutIn in; gla_out_load(a, (int)blockIdx.x, tid, in);
                for (int u = blockIdx.x; u < 768; u += G) gla_out_unit(a, l, lds, u, (u + G < 768) ? u + G : -1, tid, in);
            }
#endif
#ifndef NO_SSM
            ssm_out_unit(a, (int)blockIdx.x); ssm_out_unit(a, 256 + ((int)blockIdx.x ^ 15));
#ifdef PROBE_SSM3
            for (int u = blockIdx.x; u < 512; u += G) ssm_out_unit(a, u);
#endif
#endif
        } else if (k == 7) {
            pg8::Gemm g{(const bf16_t*)(ws + WS_YS), (const bf16_t*)(ws + WS_WGLU), T, 512, 512, 512, 512};
            pg8::StaticOrder S; S.init(T, 512, G, (int)blockIdx.x);
            pg8::EpiGlu E{(const bf16_t*)(ws + WS_YS), (bf16_t*)(ws + WS_Y)};
            pg8::gemm_phase(ldsl, g, S, E);
#ifndef NO_GLA
            if (blockIdx.x >= 128) {
                const int tid = otid(), u0 = 768 + ((int)blockIdx.x - 128) * 2;
                OutIn in; gla_out_load(a, u0, tid, in);
                gla_out_unit(a, l, lds, u0, u0 + 1, tid, in); gla_out_unit(a, l, lds, u0 + 1, -1, tid, in);
            }
#endif
        } else if (k == 8) {
            const bf16_t* Y = (const bf16_t*)(ws + WS_Y); const bf16_t* Wb = (const bf16_t*)(ws + WS_WBR); const bf16_t* Zg = (const bf16_t*)(ws + WS_Z) + ZC_G;
            pg8::BranchOrder S; S.init(T, DM, G, (int)blockIdx.x);
            pg8::Gemm g{Y, Wb, T, DM, DM, DM, DM}; pg8::EpiBranch E{Zg, (bf16_t*)(ws + WS_MB)};
            pg8::gemm_phase(ldsl, g, S, E);
        } else if (k == 9) {
            pg8::Gemm g{(const bf16_t*)(ws + WS_MB), (const bf16_t*)(ws + WS_WO), T, DM, DM, DM, DM};
            pg8::StaticOrder S; S.init(T, DM, G, (int)blockIdx.x);
            pg8::EpiResid E{a.out, a.out, (bf16_t*)(ws + WS_XB), rssb + (size_t)(3 * l + 2) * T, 1.0f, 1};
            pg8::gemm_phase(ldsl, g, S, E);
        }
#ifdef PROBE_K
        }
#endif
    }
}

extern "C" void kernel_launch(void* const* d_in, const int* in_sizes, int n_in, void* d_out, int out_size, void* d_ws, size_t ws_size, hipStream_t stream) {
    static int grid = 0;
    if (grid == 0) {
        if (n_in != 28 || in_sizes[0] != T * DM || out_size != T * DM || ws_size < WS_END) {
            fprintf(stderr, "kernel_launch: unexpected problem (n_in %d, in0 %d, out %d, ws %zu, need %zu)\n", n_in, n_in > 0 ? in_sizes[0] : -1, out_size, ws_size, (size_t)WS_END);
            grid = -1; return;
        }
        int dev = 0, cus = 0, per_cu = 0;
        hipGetDevice(&dev);
        hipDeviceGetAttribute(&cus, hipDeviceAttributeMultiprocessorCount, dev);
        hipFuncSetAttribute((const void*)mega_fwd, hipFuncAttributeMaxDynamicSharedMemorySize, LDS_BYTES);
        hipOccupancyMaxActiveBlocksPerMultiprocessor(&per_cu, (const void*)mega_fwd, 512, LDS_BYTES);
        if (per_cu < 1) per_cu = 1;
        if (per_cu > 1) per_cu = 1;
        grid = 256;
        if (cus * per_cu < 256) { fprintf(stderr, "kernel_launch: needs 256 co-resident workgroups (have %d x %d)\n", cus, per_cu); grid = -1; return; }
        (void)hipGetLastError();
    }
    if (grid < 0) return;
    Args a{};
    for (int i = 0; i < 28; ++i) a.in[i] = (const float*)d_in[i];
    a.out = (float*)d_out; a.ws = (unsigned char*)d_ws;
    (void)hipMemsetAsync((char*)d_ws + WS_BAR, 0, 16384, stream);
#if MK_MULTI_LAUNCH
    for (int ph = 0; ph < N_PHASES; ++ph) {
        a.ph_lo = ph; a.ph_hi = ph + 1;
        hipLaunchKernelGGL(mega_fwd, dim3(grid), dim3(512), LDS_BYTES, stream, a);
    }
#else
    a.ph_lo = 0; a.ph_hi = N_PHASES;
    void* args[] = {&a};
    hipError_t e = hipLaunchCooperativeKernel((const void*)mega_fwd, dim3(grid), dim3(512), args, LDS_BYTES, stream);
    if (e != hipSuccess) fprintf(stderr, "cooperative launch failed: %s (grid %d)\n", hipGetErrorString(e), grid);
#endif
}
```
